# Optimizing an MI355X kernel written in HIP

```python
import math
import jax, jax.numpy as jnp
from jax import lax
import numpy as np

D_MODEL = 4096
BATCH = 4
SEQ = 2048
DEPTH = 1

GRID_W = 64
CTX_LEN = 256
D_FF = 11008
D_A = 1024
S5_H = 16
S5_G = D_A // S5_H
S5_P = 64
D_B = 2048
HG_DK = 128
HG_HEADS = D_B // HG_DK
HG_DV = D_B // HG_HEADS
CHUNK = 64
N_MOD = 9
N_IN = D_A + 5 * D_B + 2 * D_MODEL
EPS = 1e-6
DT_MIN = 1e-3
DT_MAX = 1e-1

kernel_name = "hybrid_s5_hgrn2_macaron_dit"


def rms_norm(z, gain):
    zf = z.astype(jnp.float32)
    var = jnp.mean(zf * zf, axis=-1, keepdims=True)
    return (zf * lax.rsqrt(var + EPS) * gain.astype(jnp.float32)).astype(z.dtype)


def modulate(z, shift, scale):
    return z * (1.0 + scale) + shift


def swiglu(z, w1, w3, w2):
    return (jax.nn.silu(z @ w1) * (z @ w3)) @ w2


def seg_flip(z, n_ctx):
    return jnp.concatenate([z[:, :n_ctx][:, ::-1], z[:, n_ctx:][:, ::-1]], axis=1)


def to_colmajor(z, rows):
    b, rest = z.shape[0], z.shape[2:]
    return z.reshape((b, rows, GRID_W) + rest).swapaxes(1, 2).reshape((b, rows * GRID_W) + rest)


def from_colmajor(z, rows):
    b, rest = z.shape[0], z.shape[2:]
    return z.reshape((b, GRID_W, rows) + rest).swapaxes(1, 2).reshape((b, rows * GRID_W) + rest)


def _complex_affine_combine(e1, e2):
    a1r, a1i, b1r, b1i = e1
    a2r, a2i, b2r, b2i = e2
    ar = a1r * a2r - a1i * a2i
    ai = a1r * a2i + a1i * a2r
    br = a2r * b1r - a2i * b1i + b2r
    bi = a2r * b1i + a2i * b1r + b2i
    return ar, ai, br, bi


def s5_direction(bu_re, bu_im, lam_re, lam_im, log_dt):
    dt = jnp.exp(log_dt.astype(jnp.float32))[:, None]
    lr, li = lam_re.astype(jnp.float32), lam_im.astype(jnp.float32)
    mag = jnp.exp(lr * dt)
    ab_re, ab_im = mag * jnp.cos(li * dt), mag * jnp.sin(li * dt)
    den = lr * lr + li * li
    nr = ab_re - 1.0
    kr = (nr * lr + ab_im * li) / den
    ki = (ab_im * lr - nr * li) / den
    e_re = kr * bu_re - ki * bu_im
    e_im = kr * bu_im + ki * bu_re
    t_len = bu_re.shape[1]
    a_re = jnp.broadcast_to(ab_re, (1, t_len) + ab_re.shape)
    a_im = jnp.broadcast_to(ab_im, (1, t_len) + ab_im.shape)
    _, _, s_re, s_im = lax.associative_scan(_complex_affine_combine, (a_re, a_im, e_re, e_im), axis=1)
    return s_re, s_im


def s5_mixer(u, n_ctx, lam_re, lam_im, log_dt, b_re, b_im, c_re, c_im, d_skip, w_glu):
    bsz, t_len, _ = u.shape
    ug = u.reshape(bsz, t_len, S5_G, S5_H).astype(jnp.float32)
    bu_re = jnp.einsum("btgh,gph->btgp", ug, b_re.astype(jnp.float32))
    bu_im = jnp.einsum("btgh,gph->btgp", ug, b_im.astype(jnp.float32))
    sf_re, sf_im = s5_direction(bu_re, bu_im, lam_re[0], lam_im[0], log_dt[0])
    sb_re, sb_im = s5_direction(seg_flip(bu_re, n_ctx), seg_flip(bu_im, n_ctx),
                                lam_re[1], lam_im[1], log_dt[1])
    x_re = sf_re + seg_flip(sb_re, n_ctx)
    x_im = sf_im + seg_flip(sb_im, n_ctx)
    y = (jnp.einsum("btgp,ghp->btgh", x_re, c_re.astype(jnp.float32))
         - jnp.einsum("btgp,ghp->btgh", x_im, c_im.astype(jnp.float32))
         + d_skip.reshape(S5_G, S5_H).astype(jnp.float32) * ug)
    y = jax.nn.gelu(y.reshape(bsz, t_len, D_A))
    return (y * jax.nn.sigmoid(y @ w_glu.astype(jnp.float32))).astype(u.dtype)


def hgrn2_chunk(q, k, v, log_f):
    bsz, t_len, n_h, dk = q.shape
    dv = v.shape[-1]
    n_ch = t_len // CHUNK
    rs = lambda z: z.reshape(bsz, n_ch, CHUNK, n_h, z.shape[-1]).astype(jnp.float32)
    q, k, v, log_f = rs(q), rs(k), rs(v), rs(log_f)
    b = jnp.cumsum(log_f, axis=2)
    ref = b[:, :, CHUNK // 2 - 1:CHUNK // 2]
    b_last = b[:, :, -1:]
    scores = jnp.einsum("bnthk,bnshk->bnhts", q * jnp.exp(b - ref), k * jnp.exp(ref - b))
    mask = jnp.tril(jnp.ones((CHUNK, CHUNK), dtype=bool))
    scores = jnp.where(mask, scores, 0.0)
    o_intra = jnp.einsum("bnhts,bnshv->bnthv", scores, v)
    kv = jnp.einsum("bnshk,bnshv->bnhkv", k * jnp.exp(b_last - b), v)
    decay = jnp.exp(b_last[:, :, 0])

    def step(state, inp):
        dec, kv_n = inp
        return dec[..., None] * state + kv_n, state

    init = jnp.zeros((bsz, n_h, dk, dv), jnp.float32)
    _, s_prev = lax.scan(step, init, (jnp.moveaxis(decay, 1, 0), jnp.moveaxis(kv, 1, 0)))
    s_prev = jnp.moveaxis(s_prev, 0, 1)
    o_inter = jnp.einsum("bnthk,bnhkv->bnthv", q * jnp.exp(b), s_prev)
    return (o_intra + o_inter).reshape(bsz, t_len, n_h, dv)


def hgrn2_mixer(q, v, f_pre_fwd, f_pre_bwd, og, n_ctx, rows, lb, g_norm):
    bsz, t_len, _ = q.shape

    def order(z):
        return jnp.concatenate([z[:, :n_ctx], to_colmajor(z[:, n_ctx:], rows)], axis=1)

    def heads(z):
        return z.reshape(bsz, t_len, HG_HEADS, -1)

    q_h, v_h = heads(order(q)), heads(order(v))
    f_fwd = lb[0] + (1.0 - lb[0]) * jax.nn.sigmoid(f_pre_fwd.astype(jnp.float32))
    f_bwd = lb[1] + (1.0 - lb[1]) * jax.nn.sigmoid(f_pre_bwd.astype(jnp.float32))
    f_fwd, f_bwd = heads(order(f_fwd)), heads(order(f_bwd))
    o_fwd = hgrn2_chunk(q_h, 1.0 - f_fwd, v_h, jnp.log(f_fwd))
    o_bwd = hgrn2_chunk(seg_flip(q_h, n_ctx), seg_flip(1.0 - f_bwd, n_ctx),
                        seg_flip(v_h, n_ctx), seg_flip(jnp.log(f_bwd), n_ctx))
    o = o_fwd + seg_flip(o_bwd, n_ctx)
    o = jnp.concatenate([o[:, :n_ctx], from_colmajor(o[:, n_ctx:], rows)], axis=1)
    o = o * lax.rsqrt(jnp.mean(o * o, axis=-1, keepdims=True) + EPS)
    o = o * g_norm.reshape(HG_HEADS, HG_DV).astype(jnp.float32) * jax.nn.silu(heads(og).astype(jnp.float32))
    return o.reshape(bsz, t_len, D_B).astype(q.dtype)


def token_mixer(u_ctx, u_lat, rows, with_ctx_out, w_in, s5_lam_re, s5_lam_im, s5_log_dt,
                s5_b_re, s5_b_im, s5_c_re, s5_c_im, s5_d, s5_w_glu, lb, hg_norm,
                w_proj_a, w_proj_b, w_out):
    n_ctx = u_ctx.shape[1]
    z = jnp.concatenate([u_ctx, u_lat], axis=1) @ w_in
    splits = np.cumsum([D_A, D_B, D_B, D_B, D_B, D_B, D_MODEL]).tolist()
    u_a, q, v, f_fw, f_bw, og, g_a, g_b = jnp.split(z, splits, axis=-1)
    y_a = s5_mixer(u_a, n_ctx, s5_lam_re, s5_lam_im, s5_log_dt, s5_b_re, s5_b_im,
                   s5_c_re, s5_c_im, s5_d, s5_w_glu)
    y_b = hgrn2_mixer(q, v, f_fw, f_bw, og, n_ctx, rows, lb, hg_norm)
    start = 0 if with_ctx_out else n_ctx
    merged = (jax.nn.sigmoid(g_a[:, start:]) * (y_a[:, start:] @ w_proj_a)
              + jax.nn.sigmoid(g_b[:, start:]) * (y_b[:, start:] @ w_proj_b))
    y = merged @ w_out
    if with_ctx_out:
        return y[:, :n_ctx], y[:, n_ctx:]
    return None, y


def setup_inputs(seed: int = 0) -> dict:
    key = jax.random.key(seed)
    ks = iter(jax.random.split(key, 40))

    def nrm(shape, scale):
        return jax.random.normal(next(ks), shape, jnp.float32) * scale

    def gain(shape):
        return 1.0 + nrm(shape, 0.02)

    L = DEPTH
    n_idx = jnp.arange(S5_P, dtype=jnp.float32)
    return {
        "x": nrm((BATCH, SEQ, D_MODEL), 1.0),
        "c": nrm((BATCH, D_MODEL), 1.0),
        "ctx": nrm((BATCH, CTX_LEN, D_MODEL), 1.0),
        "c_ctx": nrm((D_MODEL,), 1.0),
        "w_ada": nrm((L, D_MODEL, N_MOD * D_MODEL), 0.5 * D_MODEL ** -0.5),
        "b_ada": nrm((L, N_MOD * D_MODEL), 0.01),
        "norm_ffn1": gain((L, D_MODEL)),
        "w1_ffn1": nrm((L, D_MODEL, D_FF), D_MODEL ** -0.5),
        "w3_ffn1": nrm((L, D_MODEL, D_FF), D_MODEL ** -0.5),
        "w2_ffn1": nrm((L, D_FF, D_MODEL), D_FF ** -0.5),
        "norm_mix": gain((L, D_MODEL)),
        "w_in": nrm((L, D_MODEL, N_IN), D_MODEL ** -0.5),
        "s5_lam_re": -0.5 + nrm((L, 2, S5_G, S5_P), 0.01),
        "s5_lam_im": math.pi * n_idx + nrm((L, 2, S5_G, S5_P), 0.01),
        "s5_log_dt": jax.random.uniform(next(ks), (L, 2, S5_G), jnp.float32,
                                        math.log(DT_MIN), math.log(DT_MAX)),
        "s5_b_re": nrm((L, S5_G, S5_P, S5_H), (2 * S5_H) ** -0.5),
        "s5_b_im": nrm((L, S5_G, S5_P, S5_H), (2 * S5_H) ** -0.5),
        "s5_c_re": nrm((L, S5_G, S5_H, S5_P), S5_P ** -0.5),
        "s5_c_im": nrm((L, S5_G, S5_H, S5_P), S5_P ** -0.5),
        "s5_d": nrm((L, D_A), 1.0),
        "s5_w_glu": nrm((L, D_A, D_A), D_A ** -0.5),
        "hg_lb_logits": nrm((2, DEPTH + 1, D_B), 0.1),
        "hg_norm": gain((L, D_B)),
        "w_proj_a": nrm((L, D_A, D_MODEL), D_A ** -0.5),
        "w_proj_b": nrm((L, D_B, D_MODEL), D_B ** -0.5),
        "w_out": nrm((L, D_MODEL, D_MODEL), D_MODEL ** -0.5),
        "norm_ffn2": gain((L, D_MODEL)),
        "w1_ffn2": nrm((L, D_MODEL, D_FF), D_MODEL ** -0.5),
        "w3_ffn2": nrm((L, D_MODEL, D_FF), D_MODEL ** -0.5),
        "w2_ffn2": nrm((L, D_FF, D_MODEL), D_FF ** -0.5),
        "norm_final": gain((D_MODEL,)),
    }


def reference(x, c, ctx, c_ctx, w_ada, b_ada, norm_ffn1, w1_ffn1, w3_ffn1, w2_ffn1,
              norm_mix, w_in, s5_lam_re, s5_lam_im, s5_log_dt, s5_b_re, s5_b_im,
              s5_c_re, s5_c_im, s5_d, s5_w_glu, hg_lb_logits, hg_norm, w_proj_a, w_proj_b,
              w_out, norm_ffn2, w1_ffn2, w3_ffn2, w2_ffn2, norm_final):
    rows = x.shape[1] // GRID_W
    lb_table = jnp.cumsum(jax.nn.softmax(hg_lb_logits.astype(jnp.float32), axis=1), axis=1)
    h, hc = x, ctx
    for layer in range(DEPTH):
        last = layer == DEPTH - 1
        mod = jax.nn.silu(c) @ w_ada[layer] + b_ada[layer]
        mod_c = jax.nn.silu(c_ctx) @ w_ada[layer] + b_ada[layer]
        ml = jnp.split(mod[:, None, :], N_MOD, axis=-1)
        mc = jnp.split(mod_c, N_MOD, axis=-1)

        def ffn1(z, m):
            return swiglu(modulate(rms_norm(z, norm_ffn1[layer]), m[0], m[1]),
                          w1_ffn1[layer], w3_ffn1[layer], w2_ffn1[layer])

        def ffn2(z, m):
            return swiglu(modulate(rms_norm(z, norm_ffn2[layer]), m[6], m[7]),
                          w1_ffn2[layer], w3_ffn2[layer], w2_ffn2[layer])

        h = h + 0.5 * ml[2] * ffn1(h, ml)
        hc = hc + 0.5 * mc[2] * ffn1(hc, mc)
        u_lat = modulate(rms_norm(h, norm_mix[layer]), ml[3], ml[4])
        u_ctx = modulate(rms_norm(hc, norm_mix[layer]), mc[3], mc[4])
        y_ctx, y_lat = token_mixer(u_ctx, u_lat, rows, not last, w_in[layer],
                                   s5_lam_re[layer], s5_lam_im[layer], s5_log_dt[layer],
                                   s5_b_re[layer], s5_b_im[layer], s5_c_re[layer], s5_c_im[layer],
                                   s5_d[layer], s5_w_glu[layer], lb_table[:, layer],
                                   hg_norm[layer], w_proj_a[layer], w_proj_b[layer], w_out[layer])
        h = h + ml[5] * y_lat
        h = h + 0.5 * ml[8] * ffn2(h, ml)
        if not last:
            hc = hc + mc[5] * y_ctx
            hc = hc + 0.5 * mc[8] * ffn2(hc, mc)
    return rms_norm(h, norm_final)
```

```cpp
#include <hip/hip_runtime.h>
#include <cstdio>
#include <cstdint>

namespace pg8 {
#define PG8_LAS __attribute__((address_space(3)))
typedef unsigned short bf16_t;
typedef short bf16x8 __attribute__((ext_vector_type(8)));
typedef float f32x4 __attribute__((ext_vector_type(4)));
typedef unsigned u32x4 __attribute__((ext_vector_type(4)));
constexpr int BM = 256, BK = 64, HALF = 128, HTB = HALF * BK * 2  , STAGE_BYTES = 8 * HTB, NXCD = 8, WGM = 8;

__host__ __device__ __forceinline__ int lds_byte(int r, int c) { const int st = (r >> 4) * 2 + (c >> 5), rr = r & 15, cc = c & 31, ob = rr * 64 + cc * 2; return st * 1024 + (ob ^ (((ob >> 9) & 1) << 5)); }
__host__ __device__ __forceinline__ void stage_rc(int b, int& R, int& C) { const int st = b / 1024, sb = b % 1024, swz = sb ^ (((sb >> 9) & 1) << 5); R = (st >> 1) * 16 + swz / 64; C = (st & 1) * 32 + (swz % 64) / 2; }
__host__ __device__ __forceinline__ int perm32(int rho) { const int n = rho >> 4, i = rho & 15; return 8 * (i >> 2) + 4 * n + (i & 3); }

struct Unit { int pm, pn; };
struct Gemm { const bf16_t* A; const bf16_t* Bt; int M, N, K, LD = 0; };

struct StaticOrder {
    static constexpr bool SPLITK = false;
    int nM, nN, nwg, G, c;
    __host__ __device__ void init(int M, int N, int G_, int c_) { nM = M / BM; nN = N / BM; nwg = nM * nN; G = G_; c = c_; }
    __host__ __device__ bool next(int i, Unit& u) const {
        const long L = (long)i * G + c; if (L >= nwg) return false;
        int wgid = (int)L; { const int q = nwg / NXCD, r = nwg % NXCD, xcd = wgid % NXCD, off = wgid / NXCD; wgid = (xcd < r ? xcd * (q + 1) : r * (q + 1) + (xcd - r) * q) + off; }
        const int nig = WGM * nN, gid = wgid / nig, fm = gid * WGM, gsz = (nM - fm) < WGM ? (nM - fm) : WGM;
        u.pm = fm + ((wgid % nig) % gsz); u.pn = (wgid % nig) / gsz; return true;
    }
    __device__ __forceinline__ void a_ready(const Unit&) const {}
    __device__ __forceinline__ void done(const Unit&) const {}
};


struct TileOrder2 {
    static constexpr bool SPLITK = false;
    int n1c, n2c, nwg1, nwg, G, c;
    __host__ __device__ void init(int n1c_, int n2c_, int G_, int c_) { n1c = n1c_; n2c = n2c_; nwg1 = 36 * n1c; nwg = nwg1 + 32 * n2c; G = G_; c = c_; }
    __host__ __device__ static void map(int L, int nM, int nN, int& pm, int& pn) {
        const int nwg = nM * nN; int wgid = L; { const int q = nwg / NXCD, r = nwg % NXCD, xcd = wgid % NXCD, off = wgid / NXCD; wgid = (xcd < r ? xcd * (q + 1) : r * (q + 1) + (xcd - r) * q) + off; }
        const int nig = WGM * nN, gid = wgid / nig, fm = gid * WGM, gsz = (nM - fm) < WGM ? (nM - fm) : WGM;
        pm = fm + ((wgid % nig) % gsz); pn = (wgid % nig) / gsz; }
    __host__ __device__ bool next(int i, Unit& u) const {
        const long L = (long)i * G + c; if (L >= nwg) return false;
        int pm, pn;
        if (L < nwg1) map((int)L, 36, n1c, pm, pn);
        else { map((int)L - nwg1, 32, n2c, pm, pn); pm = (pm >> 3) * 9 + 1 + (pm & 7); pn += n1c; }
        u.pm = pm; u.pn = pn; return true;
    }
    __device__ __forceinline__ void a_ready(const Unit&) const {}
    __device__ __forceinline__ void done(const Unit&) const {}
};
struct TileOrder {
    static constexpr bool SPLITK = false;
    int nM, nN, nwg, G, c, lat_only;
    __host__ __device__ void init(int nM_, int nN_, int G_, int c_, int lat_only_) { nM = nM_; nN = nN_; nwg = nM * nN; G = G_; c = c_; lat_only = lat_only_; }
    __host__ __device__ bool next(int i, Unit& u) const {
        const long L = (long)i * G + c; if (L >= nwg) return false;
        int wgid = (int)L; { const int q = nwg / NXCD, r = nwg % NXCD, xcd = wgid % NXCD, off = wgid / NXCD; wgid = (xcd < r ? xcd * (q + 1) : r * (q + 1) + (xcd - r) * q) + off; }
        const int nig = WGM * nN, gid = wgid / nig, fm = gid * WGM, gsz = (nM - fm) < WGM ? (nM - fm) : WGM;
        int pm = fm + ((wgid % nig) % gsz); u.pn = (wgid % nig) / gsz;
        if (lat_only) pm = (pm >> 3) * 9 + 1 + (pm & 7);
        u.pm = pm; return true;
    }
    __device__ __forceinline__ void a_ready(const Unit&) const {}
    __device__ __forceinline__ void done(const Unit&) const {}
};

struct HalfRowsOrder {
    static constexpr bool SPLITK = false, STAGGER = false;
    TileOrder fb; int G, c;
    __host__ __device__ void init(int G_, int c_) { fb.init(32, 16, G_, c_, 1); G = G_; c = c_; }
    __host__ __device__ bool next(int i, Unit& u) const {
        if (G != 256) return fb.next(i, u);
        if (i >= 2) return false;
        const int x = c & 7, j = c >> 3, pl = 16 * i + 4 * (x >> 1) + (j & 3);
        u.pm = (pl >> 3) * 9 + 1 + (pl & 7); u.pn = 8 * (x & 1) + (j >> 2); return true;
    }
    __device__ __forceinline__ void a_ready(const Unit&) const {}
    __device__ __forceinline__ void done(const Unit&) const {}
};
struct DownSplitOrder {
    static constexpr bool SPLITK = true;
    HalfRowsOrder lat; int G, c;
    __host__ __device__ void init(int G_, int c_) { lat.init(G_, c_); G = G_; c = c_; }
    __host__ __device__ bool next(int i, Unit& u) const {
        const long L = (long)i * G + c; if (L >= 512 + 256) return false;
        if (L < 512) return lat.next(i, u);
        const int idx = (int)L - 512;
        u.pm = 9 * (idx >> 6); u.pn = ((idx >> 2) & 15) | (((idx & 3) + 1) << 8); return true;
    }
    __host__ __device__ static int kt0(const Unit& u) { const int q = u.pn >> 8; return q == 0 ? 0 : (q - 1) * 44 - (q == 4 ? 2 : 0); }
    __host__ __device__ static int cnt(const Unit& u, int full) { const int q = u.pn >> 8; return q == 0 ? full : (q <= 2 ? 44 : 42); }
    __device__ __forceinline__ void a_ready(const Unit&) const {}
    __device__ __forceinline__ void done(const Unit&) const {}
};

typedef float f32x2_cv __attribute__((ext_vector_type(2)));
typedef __bf16 bf16x2_cv __attribute__((ext_vector_type(2)));
__device__ __forceinline__ unsigned cvt_pk_bf16(float lo, float hi) { const f32x2_cv v = {lo, hi}; const bf16x2_cv b = __builtin_convertvector(v, bf16x2_cv); return __builtin_bit_cast(unsigned, b); }
typedef _Float16 h16x2_cv __attribute__((ext_vector_type(2)));
typedef unsigned short h16_t;
__device__ __forceinline__ unsigned cvt_pk_f16(float lo, float hi) { const f32x2_cv v = {lo, hi}; const h16x2_cv h = __builtin_convertvector(v, h16x2_cv); return __builtin_bit_cast(unsigned, h); }
__device__ __forceinline__ f32x2_cv unpk_f16(unsigned w) { const h16x2_cv h = __builtin_bit_cast(h16x2_cv, w); return __builtin_convertvector(h, f32x2_cv); }
__device__ __forceinline__ float bf_lo(unsigned w) { return __uint_as_float(w << 16); }
__device__ __forceinline__ float bf_hi(unsigned w) { return __uint_as_float(w & 0xffff0000u); }
__device__ __forceinline__ float sigmoid_f(float x) { return __builtin_amdgcn_rcpf(1.0f + __builtin_amdgcn_exp2f(-1.4426950408889634f * x)); }
__device__ __forceinline__ float silu_f(float x) { return x * sigmoid_f(x); }

constexpr int TOK_ROWS = 9216, ROWS_PER_B = 2304, CTXR = 256, LATR = 2048, DM = 4096, NMODC = 36864, DY = 3072;


#define EPI_PIN(x) do { asm volatile("" : "+v"(x)); __builtin_amdgcn_sched_barrier(0); } while (0)
struct EpiSwiGLU {
    static constexpr bool PERM = true, AFTER_DRAIN = false;
    bf16_t* H; int ldh;
    __device__ __forceinline__ void operator()(const f32x4 (&acc)[2][2][4][2], const Unit& u, int wr, int wc, int fr, int fq) const {
        size_t off = (size_t)(u.pm * BM + wr * 64 + fr) * ldh + u.pn * HALF + wc * 32 + 8 * fq;
#pragma unroll
        for (int ai = 0; ai < 2; ++ai) {
#pragma unroll
            for (int m = 0; m < 4; ++m) { EPI_PIN(off);
                const f32x4 a0 = acc[ai][0][m][0], a1 = acc[ai][0][m][1], b0 = acc[ai][1][m][0], b1 = acc[ai][1][m][1];
                u32x4 w; w.x = cvt_pk_bf16(silu_f(a0[0]) * b0[0], silu_f(a0[1]) * b0[1]); w.y = cvt_pk_bf16(silu_f(a0[2]) * b0[2], silu_f(a0[3]) * b0[3]);
                w.z = cvt_pk_bf16(silu_f(a1[0]) * b1[0], silu_f(a1[1]) * b1[1]); w.w = cvt_pk_bf16(silu_f(a1[2]) * b1[2], silu_f(a1[3]) * b1[3]);
                *(u32x4*)(H + off) = w; off += (size_t)16 * ldh; }
            off += (size_t)64 * ldh; }
    }
};

template <int BASE_MODE, int OUT_MODE> struct EpiResid {
    static constexpr bool PERM = true, AFTER_DRAIN = false;
    const float* x; const float* ctx; h16_t* hbuf; float* dout; const float* mod; int mchunk; float coef;
    __device__ __forceinline__ void operator()(const f32x4 (&acc)[2][2][4][2], const Unit& u, int wr, int wc, int fr, int fq) const {
        const int b = u.pm / 9, tt = u.pm - 9 * b; const bool isctx = (tt == 0);
        const float* basep = nullptr; const h16_t* baseh = nullptr; float* outp = nullptr; h16_t* outh = nullptr;
        if (BASE_MODE == 0) basep = isctx ? ctx + (size_t)b * CTXR * DM : x + ((size_t)b * LATR + (size_t)(tt - 1) * BM) * DM; else baseh = hbuf + (size_t)u.pm * BM * DM;
        if (OUT_MODE == 0) outh = hbuf + (size_t)u.pm * BM * DM; else outp = dout + ((size_t)b * LATR + (size_t)(tt - 1) * BM) * DM;
        const float* mv = mod + (size_t)(isctx ? 4 : b) * NMODC + (size_t)mchunk * DM;
        const int col0 = u.pn * BM + wc * 32 + 8 * fq;
        f32x4 g[2][2];
#pragma unroll
        for (int bj = 0; bj < 2; ++bj)
#pragma unroll
            for (int n = 0; n < 2; ++n) g[bj][n] = *(const f32x4*)(mv + col0 + bj * HALF + 4 * n) * coef;
        const size_t off0 = (size_t)(wr * 64 + fr) * DM + col0;
        f32x4 bs[4][2][2][2]; u32x4 bh[4][2][2];
#define ERES_LOAD(bt) _Pragma("unroll") for (int mm = 0; mm < 2; ++mm) { const size_t o = off0 + (size_t)(((bt) >> 1) * HALF + (((bt) & 1) * 2 + mm) * 16) * DM; \
            _Pragma("unroll") for (int bj = 0; bj < 2; ++bj) { if constexpr (BASE_MODE == 0) { _Pragma("unroll") for (int n = 0; n < 2; ++n) bs[bt][mm][bj][n] = *(const f32x4*)(basep + o + bj * HALF + 4 * n); } \
                else bh[bt][mm][bj] = *(const u32x4*)(baseh + o + bj * HALF); } }
#define ERES_DONE(bt) _Pragma("unroll") for (int mm = 0; mm < 2; ++mm) { const size_t o = off0 + (size_t)(((bt) >> 1) * HALF + (((bt) & 1) * 2 + mm) * 16) * DM; \
            _Pragma("unroll") for (int bj = 0; bj < 2; ++bj) { f32x4 b0, b1; \
                if constexpr (BASE_MODE == 0) { b0 = bs[bt][mm][bj][0]; b1 = bs[bt][mm][bj][1]; } \
                else { const u32x4 w = bh[bt][mm][bj]; const f32x2_cv p0 = unpk_f16(w.x), p1 = unpk_f16(w.y), p2 = unpk_f16(w.z), p3 = unpk_f16(w.w); b0 = (f32x4){p0.x, p0.y, p1.x, p1.y}; b1 = (f32x4){p2.x, p2.y, p3.x, p3.y}; } \
                const f32x4 r0 = b0 + g[bj][0] * acc[(bt) >> 1][bj][((bt) & 1) * 2 + mm][0], r1 = b1 + g[bj][1] * acc[(bt) >> 1][bj][((bt) & 1) * 2 + mm][1]; \
                if constexpr (OUT_MODE == 0) { u32x4 w; w.x = cvt_pk_f16(r0[0], r0[1]); w.y = cvt_pk_f16(r0[2], r0[3]); w.z = cvt_pk_f16(r1[0], r1[1]); w.w = cvt_pk_f16(r1[2], r1[3]); *(u32x4*)(outh + o + bj * HALF) = w; } \
                else { *(f32x4*)(outp + o + bj * HALF) = r0; *(f32x4*)(outp + o + bj * HALF + 4) = r1; } } }
        ERES_LOAD(0) __builtin_amdgcn_sched_barrier(0);
        ERES_LOAD(1) __builtin_amdgcn_sched_barrier(0);
        ERES_DONE(0) __builtin_amdgcn_sched_barrier(0);
        ERES_LOAD(2) __builtin_amdgcn_sched_barrier(0);
        ERES_DONE(1) __builtin_amdgcn_sched_barrier(0);
        ERES_LOAD(3) __builtin_amdgcn_sched_barrier(0);
        ERES_DONE(2) __builtin_amdgcn_sched_barrier(0);
        ERES_DONE(3)
#undef ERES_LOAD
#undef ERES_DONE
    }
};

struct EpiDown1 {
    static constexpr bool PERM = true, AFTER_DRAIN = false;
    EpiResid<0, 0> R; h16_t* part;
    __device__ __forceinline__ void operator()(const f32x4 (&acc)[2][2][4][2], const Unit& u, int wr, int wc, int fr, int fq) const {
        const int q = u.pn >> 8;
        if (q == 0) { R(acc, u, wr, wc, fr, fq); return; }
        size_t off = ((size_t)(q - 1) * 1024 + (size_t)(u.pm / 9) * CTXR + wr * 64 + fr) * DM + (u.pn & 255) * BM + wc * 32 + 8 * fq;
#pragma unroll
        for (int ai = 0; ai < 2; ++ai) {
#pragma unroll
            for (int m = 0; m < 4; ++m) { EPI_PIN(off);
#pragma unroll
                for (int bj = 0; bj < 2; ++bj) { const f32x4 v0 = acc[ai][bj][m][0], v1 = acc[ai][bj][m][1];
                    u32x4 w; w.x = cvt_pk_f16(v0[0], v0[1]); w.y = cvt_pk_f16(v0[2], v0[3]); w.z = cvt_pk_f16(v1[0], v1[1]); w.w = cvt_pk_f16(v1[2], v1[3]);
                    *(u32x4*)(part + off + bj * HALF) = w; }
                off += (size_t)16 * DM; }
            off += (size_t)64 * DM; }
    }
};

struct EpiWin {
    static constexpr bool PERM = true, AFTER_DRAIN = false;
    h16_t* UA; bf16_t* Q; h16_t* LFF; bf16_t* SGA; const float* lbt;
    static constexpr size_t QSTRIDE = (size_t)36 * 1048576 / 2, LFSTRIDE = (size_t)72 * 1048576 / 2, SGSTRIDE = (size_t)72 * 1048576 / 2;
    __device__ __forceinline__ void operator()(const f32x4 (&acc)[2][2][4][2], const Unit& u, int wr, int wc, int fr, int fq) const {
        const int pn = u.pn, row0 = u.pm * BM + wr * 64 + fr, cl = wc * 32 + 8 * fq;
        if (pn < 4) {
            size_t off = (size_t)row0 * 1024 + pn * BM + cl;
#pragma unroll
            for (int ai = 0; ai < 2; ++ai) {
#pragma unroll
                for (int m = 0; m < 4; ++m) { EPI_PIN(off);
#pragma unroll
                    for (int bj = 0; bj < 2; ++bj) { const f32x4 v0 = acc[ai][bj][m][0], v1 = acc[ai][bj][m][1];
                        u32x4 w; w.x = cvt_pk_f16(v0[0], v0[1]); w.y = cvt_pk_f16(v0[2], v0[3]); w.z = cvt_pk_f16(v1[0], v1[1]); w.w = cvt_pk_f16(v1[2], v1[3]);
                        *(u32x4*)(UA + off + bj * HALF) = w; }
                    off += (size_t)16 * 1024; }
                off += (size_t)64 * 1024; }
        } else if (pn < 12 || (pn >= 28 && pn < 44)) {
            const int sel = (pn < 12) ? 1 : ((pn >= 36) ? 2 : 0), cb = (pn - (sel == 1 ? 4 : (sel == 2 ? 36 : 28))) * BM;
            size_t off = (size_t)sel * QSTRIDE + (size_t)row0 * 2048 + cb + cl;
#pragma unroll
            for (int ai = 0; ai < 2; ++ai) {
#pragma unroll
                for (int m = 0; m < 4; ++m) { EPI_PIN(off);
#pragma unroll
                    for (int bj = 0; bj < 2; ++bj) { const f32x4 v0 = acc[ai][bj][m][0], v1 = acc[ai][bj][m][1];
                        u32x4 w; w.x = cvt_pk_bf16(v0[0], v0[1]); w.y = cvt_pk_bf16(v0[2], v0[3]); w.z = cvt_pk_bf16(v1[0], v1[1]); w.w = cvt_pk_bf16(v1[2], v1[3]);
                        *(u32x4*)(Q + off + bj * HALF) = w; }
                    off += (size_t)16 * 2048; }
                off += (size_t)64 * 2048; }
        } else if (pn < 28) {
            const int dirb = (pn >= 20) ? 1 : 0, cb = (pn - (dirb ? 20 : 12)) * BM;
            const float* lb = lbt + dirb * 2048 + cb + cl;
            f32x4 l[2][2];
#pragma unroll
            for (int bj = 0; bj < 2; ++bj)
#pragma unroll
                for (int n = 0; n < 2; ++n) l[bj][n] = *(const f32x4*)(lb + bj * HALF + 4 * n);
            size_t off = (size_t)dirb * LFSTRIDE + (size_t)row0 * 2048 + cb + cl;
#pragma unroll
            for (int ai = 0; ai < 2; ++ai) {
#pragma unroll
                for (int m = 0; m < 4; ++m) { EPI_PIN(off);
#pragma unroll
                    for (int bj = 0; bj < 2; ++bj) { f32x4 o[2];
#pragma unroll
                        for (int n = 0; n < 2; ++n) { f32x4 a = acc[ai][bj][m][n]; asm volatile("" : "+v"(a));
#pragma unroll
                            for (int j = 0; j < 4; ++j) { const float lbv = l[bj][n][j]; o[n][j] = __logf(lbv + (1.0f - lbv) * sigmoid_f(a[j])); } }
                        u32x4 w; w.x = cvt_pk_f16(o[0][0], o[0][1]); w.y = cvt_pk_f16(o[0][2], o[0][3]); w.z = cvt_pk_f16(o[1][0], o[1][1]); w.w = cvt_pk_f16(o[1][2], o[1][3]);
                        *(u32x4*)(LFF + off + bj * HALF) = w; }
                    off += (size_t)16 * 2048; }
                off += (size_t)64 * 2048; }
        } else {
            size_t off = (size_t)row0 * DM + (pn - 44) * HALF + cl;
#pragma unroll
            for (int ai = 0; ai < 2; ++ai) {
#pragma unroll
                for (int m = 0; m < 4; ++m) { EPI_PIN(off);
                    const f32x4 a0 = acc[ai][0][m][0], a1 = acc[ai][0][m][1], b0 = acc[ai][1][m][0], b1 = acc[ai][1][m][1];
                    u32x4 wa; wa.x = cvt_pk_bf16(sigmoid_f(a0[0]), sigmoid_f(a0[1])); wa.y = cvt_pk_bf16(sigmoid_f(a0[2]), sigmoid_f(a0[3]));
                    wa.z = cvt_pk_bf16(sigmoid_f(a1[0]), sigmoid_f(a1[1])); wa.w = cvt_pk_bf16(sigmoid_f(a1[2]), sigmoid_f(a1[3]));
                    *(u32x4*)(SGA + off) = wa;
#define GRATIO(bv, gw_) (sigmoid_f(bv) * __builtin_amdgcn_rcpf(fmaxf(gw_, 1e-20f)))
                    u32x4 wb; wb.x = cvt_pk_bf16(GRATIO(b0[0], bf_lo(wa.x)), GRATIO(b0[1], bf_hi(wa.x))); wb.y = cvt_pk_bf16(GRATIO(b0[2], bf_lo(wa.y)), GRATIO(b0[3], bf_hi(wa.y)));
                    wb.z = cvt_pk_bf16(GRATIO(b1[0], bf_lo(wa.z)), GRATIO(b1[1], bf_hi(wa.z))); wb.w = cvt_pk_bf16(GRATIO(b1[2], bf_lo(wa.w)), GRATIO(b1[3], bf_hi(wa.w)));
#undef GRATIO
                    *(u32x4*)(SGA + SGSTRIDE + off) = wb;
                    off += (size_t)16 * DM; }
                off += (size_t)64 * DM; }
        }
    }
};

struct EpiGlu {
    static constexpr bool PERM = true, AFTER_DRAIN = false;
    const bf16_t* GA; bf16_t* YA;
    __device__ __forceinline__ void operator()(const f32x4 (&acc)[2][2][4][2], const Unit& u, int wr, int wc, int fr, int fq) const {
        size_t off = (size_t)(u.pm * BM + wr * 64 + fr) * 1024 + u.pn * BM + wc * 32 + 8 * fq, offy = (size_t)(u.pm * BM + wr * 64 + fr) * DY + u.pn * BM + wc * 32 + 8 * fq;
#pragma unroll
        for (int ai = 0; ai < 2; ++ai) {
#pragma unroll
            for (int m = 0; m < 4; ++m) { EPI_PIN(off); EPI_PIN(offy);
#pragma unroll
                for (int bj = 0; bj < 2; ++bj) { const size_t o = off + bj * HALF;
                    const u32x4 gq = *(const u32x4*)(GA + o); const f32x4 v0 = acc[ai][bj][m][0], v1 = acc[ai][bj][m][1];
                    u32x4 w; w.x = cvt_pk_bf16(bf_lo(gq.x) * sigmoid_f(v0[0]), bf_hi(gq.x) * sigmoid_f(v0[1])); w.y = cvt_pk_bf16(bf_lo(gq.y) * sigmoid_f(v0[2]), bf_hi(gq.y) * sigmoid_f(v0[3]));
                    w.z = cvt_pk_bf16(bf_lo(gq.z) * sigmoid_f(v1[0]), bf_hi(gq.z) * sigmoid_f(v1[1])); w.w = cvt_pk_bf16(bf_lo(gq.w) * sigmoid_f(v1[2]), bf_hi(gq.w) * sigmoid_f(v1[3]));
                    *(u32x4*)(YA + offy + bj * HALF) = w; }
                off += (size_t)16 * 1024; offy += (size_t)16 * DY; }
            off += (size_t)64 * 1024; offy += (size_t)64 * DY; }
    }
};

struct EpiMerge {
    static constexpr bool PERM = true, AFTER_DRAIN = false; static constexpr int MID_T = 32;
    const bf16_t* SGA; const bf16_t* SGB; bf16_t* MRG;
    __device__ __forceinline__ void mid(f32x4 (&acc)[2][2][4][2], const Unit& u, int wr, int wc, int fr, int fq) const {
        size_t off = (size_t)(u.pm * BM + wr * 64 + fr) * DM + u.pn * BM + wc * 32 + 8 * fq;
#pragma unroll
        for (int ai = 0; ai < 2; ++ai) {
#pragma unroll
            for (int m = 0; m < 4; ++m) { EPI_PIN(off);
#pragma unroll
                for (int bj = 0; bj < 2; ++bj) { const size_t o = off + bj * HALF;
                    const u32x4 rq = *(const u32x4*)(SGB + o);
                    f32x4 r0, r1; r0[0] = bf_lo(rq.x); r0[1] = bf_hi(rq.x); r0[2] = bf_lo(rq.y); r0[3] = bf_hi(rq.y); r1[0] = bf_lo(rq.z); r1[1] = bf_hi(rq.z); r1[2] = bf_lo(rq.w); r1[3] = bf_hi(rq.w);
                    acc[ai][bj][m][0] *= r0; acc[ai][bj][m][1] *= r1; }
                off += (size_t)16 * DM; }
            off += (size_t)64 * DM; }
    }
    __device__ __forceinline__ void operator()(const f32x4 (&acc)[2][2][4][2], const Unit& u, int wr, int wc, int fr, int fq) const {
        size_t off = (size_t)(u.pm * BM + wr * 64 + fr) * DM + u.pn * BM + wc * 32 + 8 * fq;
#pragma unroll
        for (int ai = 0; ai < 2; ++ai) {
#pragma unroll
            for (int m = 0; m < 4; ++m) { EPI_PIN(off);
#pragma unroll
                for (int bj = 0; bj < 2; ++bj) { const size_t o = off + bj * HALF;
                    const u32x4 ga = *(const u32x4*)(SGA + o);
                    const f32x4 v0 = acc[ai][bj][m][0], v1 = acc[ai][bj][m][1];
                    u32x4 w; w.x = cvt_pk_bf16(fmaxf(bf_lo(ga.x), 1e-20f) * v0[0], fmaxf(bf_hi(ga.x), 1e-20f) * v0[1]); w.y = cvt_pk_bf16(fmaxf(bf_lo(ga.y), 1e-20f) * v0[2], fmaxf(bf_hi(ga.y), 1e-20f) * v0[3]);
                    w.z = cvt_pk_bf16(fmaxf(bf_lo(ga.z), 1e-20f) * v1[0], fmaxf(bf_hi(ga.z), 1e-20f) * v1[1]); w.w = cvt_pk_bf16(fmaxf(bf_lo(ga.w), 1e-20f) * v1[2], fmaxf(bf_hi(ga.w), 1e-20f) * v1[3]);
                    *(u32x4*)(MRG + o) = w; }
                off += (size_t)16 * DM; }
            off += (size_t)64 * DM; }
    }
};
template <class E, class = void> struct HasInplace { static constexpr bool value = false; };
template <class E> struct HasInplace<E, decltype((void)E::INPLACE)> { static constexpr bool value = true; };
template <class E, class = void> struct HasMid { static constexpr bool value = false; };
template <class E> struct HasMid<E, decltype((void)E::MID_T)> { static constexpr bool value = true; };

template <size_t OFF_HB, size_t OFF_MOD, size_t OFF_X, size_t OFF_CNT, size_t OFF_TMO> struct EpiFinalNorm {
    static constexpr bool PERM = true, AFTER_DRAIN = false, INPLACE = true; static constexpr int mchunk = 8; static constexpr float coef = 0.5f;
    unsigned char* wsb; float* dout; const float* gain; PG8_LAS unsigned char* tab;
    __device__ __forceinline__ void operator()(const f32x4 (&)[2][2][4][2], const Unit&, int, int, int, int) const {}
    __device__ __forceinline__ void inplace(f32x4 (&acc)[2][2][4][2], const Unit& u, int wr, int wc, int fr, int fq) const {
        int t_ = threadIdx.x; asm volatile("" : "+v"(t_)); const int wid = __builtin_amdgcn_readfirstlane(t_ >> 6), lane = t_ & 63; PG8_LAS unsigned char* lds = tab;
        const int b = u.pm / 9, tt = u.pm - 9 * b, pl = b * 8 + (tt - 1);
        const h16_t* hb = (const h16_t*)(wsb + OFF_HB); const float* mod = (const float*)(wsb + OFF_MOD); unsigned* xbuf = (unsigned*)(wsb + OFF_X); unsigned* cnt = (unsigned*)(wsb + OFF_CNT); unsigned* tmo = (unsigned*)(wsb + OFF_TMO);
        const h16_t* baseh = hb + (size_t)u.pm * BM * DM;
        float* outp = dout + ((size_t)b * LATR + (size_t)(tt - 1) * BM) * DM;
        const float* mv = mod + (size_t)b * NMODC + (size_t)mchunk * DM;
        const int col0 = u.pn * BM + wc * 32 + 8 * fq;
        PG8_LAS float* P = (PG8_LAS float*)lds; PG8_LAS float* S = (PG8_LAS float*)(lds + 8192); PG8_LAS unsigned* flag = (PG8_LAS unsigned*)(lds + 8192 + 2048);
        { f32x4 g[2][2];
#pragma unroll
          for (int bj = 0; bj < 2; ++bj)
#pragma unroll
              for (int n = 0; n < 2; ++n) g[bj][n] = *(const f32x4*)(mv + col0 + bj * HALF + 4 * n) * coef;
          const size_t off0 = (size_t)(wr * 64 + fr) * DM + col0;
          u32x4 bh[2][4][2];
#pragma unroll
          for (int ai = 0; ai < 2; ++ai)
#pragma unroll
              for (int m = 0; m < 4; ++m)
#pragma unroll
                  for (int bj = 0; bj < 2; ++bj) bh[ai][m][bj] = *(const u32x4*)(baseh + off0 + (size_t)(ai * HALF + m * 16) * DM + bj * HALF);
          __builtin_amdgcn_sched_barrier(0);
#pragma unroll
          for (int ai = 0; ai < 2; ++ai)
#pragma unroll
              for (int m = 0; m < 4; ++m) { float sq = 0.f;
#pragma unroll
                  for (int bj = 0; bj < 2; ++bj) { const u32x4 w = bh[ai][m][bj]; const f32x2_cv p0 = unpk_f16(w.x), p1 = unpk_f16(w.y), p2 = unpk_f16(w.z), p3 = unpk_f16(w.w);
                      const f32x4 r0 = (f32x4){p0.x, p0.y, p1.x, p1.y} + g[bj][0] * acc[ai][bj][m][0], r1 = (f32x4){p2.x, p2.y, p3.x, p3.y} + g[bj][1] * acc[ai][bj][m][1];
                      acc[ai][bj][m][0] = r0; acc[ai][bj][m][1] = r1;
                      sq += ((r0[0] * r0[0] + r0[1] * r0[1]) + (r0[2] * r0[2] + r0[3] * r0[3])) + ((r1[0] * r1[0] + r1[1] * r1[1]) + (r1[2] * r1[2] + r1[3] * r1[3])); }
                  sq += __shfl_xor(sq, 16); sq += __shfl_xor(sq, 32);
                  if (fq == 0) P[(ai * HALF + wr * 64 + m * 16 + fr) * 4 + wc] = sq; } }
        asm volatile("s_waitcnt lgkmcnt(0)" ::: "memory"); __builtin_amdgcn_s_barrier(); asm volatile("" ::: "memory");
        const int row = wid * 32 + (lane & 31);
        if (lane < 32) { const float t = (P[row * 4 + 0] + P[row * 4 + 1]) + (P[row * 4 + 2] + P[row * 4 + 3]);
            __hip_atomic_store(xbuf + ((size_t)(pl * 256 + row)) * 16 + u.pn, __float_as_uint(t), __ATOMIC_RELAXED, __HIP_MEMORY_SCOPE_AGENT); }
        asm volatile("s_waitcnt vmcnt(0)" ::: "memory");
        if (lane == 0) (void)__hip_atomic_fetch_add(cnt + 64 * pl, 1u, __ATOMIC_RELAXED, __HIP_MEMORY_SCOPE_AGENT);
        if (wid == 0) { unsigned dead = 0u, sp = 0u;
            while (__hip_atomic_load(cnt + 64 * pl, __ATOMIC_RELAXED, __HIP_MEMORY_SCOPE_AGENT) < 128u) { __builtin_amdgcn_s_sleep(2);
                if ((++sp & 255u) == 0u) { if (__hip_atomic_load(tmo, __ATOMIC_RELAXED, __HIP_MEMORY_SCOPE_AGENT)) { dead = 1u; break; } if (sp > (1u << 22)) { atomicAdd(tmo, 1u); dead = 1u; break; } } }
            if (__hip_atomic_load(tmo, __ATOMIC_RELAXED, __HIP_MEMORY_SCOPE_AGENT)) dead = 1u;
            __builtin_amdgcn_fence(__ATOMIC_ACQUIRE, "agent");
            if (lane == 0) flag[0] = dead; }
        asm volatile("s_waitcnt vmcnt(0) lgkmcnt(0)" ::: "memory"); __builtin_amdgcn_s_barrier(); asm volatile("" ::: "memory");
        const bool bad = flag[0] != 0u;
        if (lane < 32) { float q = 0.f;
#pragma unroll
            for (int t = 0; t < 16; ++t) q += __uint_as_float(__hip_atomic_load(xbuf + ((size_t)(pl * 256 + row)) * 16 + t, __ATOMIC_RELAXED, __HIP_MEMORY_SCOPE_AGENT));
            S[row] = 1.0f / sqrtf(q * (1.0f / DM) + 1e-6f); }
        asm volatile("s_waitcnt lgkmcnt(0)" ::: "memory"); __builtin_amdgcn_s_barrier(); asm volatile("" ::: "memory");
        f32x4 gv[2][2];
#pragma unroll
        for (int bj = 0; bj < 2; ++bj)
#pragma unroll
            for (int n = 0; n < 2; ++n) gv[bj][n] = *(const f32x4*)(gain + col0 + bj * HALF + 4 * n);
        size_t off = (size_t)(wr * 64 + fr) * DM + col0;
#pragma unroll
        for (int ai = 0; ai < 2; ++ai) {
#pragma unroll
            for (int m = 0; m < 4; ++m) { EPI_PIN(off);
                const float rs = bad ? 0.f : S[ai * HALF + wr * 64 + m * 16 + fr];
#pragma unroll
                for (int bj = 0; bj < 2; ++bj)
#pragma unroll
                    for (int n = 0; n < 2; ++n) { f32x4 o = acc[ai][bj][m][n] * rs * gv[bj][n]; if (bad) o = (f32x4){1e30f, 1e30f, 1e30f, 1e30f}; *(f32x4*)(outp + off + bj * HALF + 4 * n) = o; }
                off += (size_t)16 * DM; }
            off += (size_t)64 * DM; }
        asm volatile("s_waitcnt lgkmcnt(0)" ::: "memory"); __builtin_amdgcn_s_barrier(); asm volatile("" ::: "memory");
    }
};
struct HalfRowsSlice {
    static constexpr bool SPLITK = false, STAGGER = false;
    int c, r;
    __host__ __device__ bool next(int i, Unit& u) const { if (i != 0) return false;
        const int x = c & 7, j = c >> 3, pl = 16 * r + 4 * (x >> 1) + (j & 3);
        u.pm = (pl >> 3) * 9 + 1 + (pl & 7); u.pn = 8 * (x & 1) + (j >> 2); return true; }
    __device__ __forceinline__ void a_ready(const Unit&) const {}
    __device__ __forceinline__ void done(const Unit&) const {}
};

template <class Epi, class Sched, bool ALIGN_EPI = false, bool SP2 = false>
__device__ __forceinline__ void gemm_phase(PG8_LAS unsigned char* lds, const Gemm g, const Sched& S, const Epi& E) {
    int tid_ = threadIdx.x; asm volatile("" : "+v"(tid_));
    const int tid = tid_, wid = __builtin_amdgcn_readfirstlane(tid >> 6), lane = tid & 63, wr = wid >> 2, wc = wid & 3, fr = lane & 15, fq = lane >> 4;
    const int K = g.K, nt = K / BK, LD = g.LD ? g.LD : g.K;
    unsigned voffA[2], voffB[2];
#pragma unroll
    for (int i = 0; i < 2; ++i) { int R, C; stage_rc(tid * 16 + i * 8192, R, C); const int Rb = Epi::PERM ? ((R & ~31) + perm32(R & 31)) : R;
        voffA[i] = (unsigned)(R * LD + C) * 2u; voffB[i] = (unsigned)(Rb * LD + C) * 2u; }
    const size_t kstep = (size_t)(BK * 2);
    const size_t hstep = (size_t)HALF * LD * 2;
    const size_t tstep = 2 * hstep;
    const unsigned ldsw = (unsigned)wid * 1024u;
    const int aoff = lds_byte(wr * 64 + fr, fq * 8), boff = lds_byte(wc * 32 + fr, fq * 8);
#define PG8_SA(b, h) (((b) * 2 + (h)) * HTB)
#define PG8_SB(b, h) ((4 + (b) * 2 + (h)) * HTB)
#define PG8_STAGE(bufoff, gbase, voff) do { _Pragma("unroll") for (int _i = 0; _i < 2; ++_i) \
        __builtin_amdgcn_global_load_lds((const unsigned*)((const char*)(gbase) + (voff)[_i]), (PG8_LAS unsigned*)(lds + (bufoff) + ldsw + _i * 8192), 16, 0, 0); } while (0)
#define PG8_LDA(dst, b, h) do { _Pragma("unroll") for (int m = 0; m < 4; ++m) _Pragma("unroll") for (int k = 0; k < 2; ++k) dst[m][k] = *(const PG8_LAS bf16x8*)(lds + PG8_SA(b, h) + aoff + m * 2048 + k * 1024); } while (0)
#define PG8_LDB(dst, b, h) do { _Pragma("unroll") for (int n = 0; n < 2; ++n) _Pragma("unroll") for (int k = 0; k < 2; ++k) dst[n][k] = *(const PG8_LAS bf16x8*)(lds + PG8_SB(b, h) + boff + n * 2048 + k * 1024); } while (0)
#define PG8_MMA(ai, bj, At, Bt) do { __builtin_amdgcn_s_setprio(1); _Pragma("unroll") for (int m = 0; m < 4; ++m) _Pragma("unroll") for (int n = 0; n < 2; ++n) _Pragma("unroll") for (int k = 0; k < 2; ++k) \
        acc[ai][bj][m][n] = __builtin_amdgcn_mfma_f32_16x16x32_bf16(Bt[n][k], At[m][k], acc[ai][bj][m][n], 0, 0, 0); __builtin_amdgcn_s_setprio(0); } while (0)
#define PG8_WAIT_V(n) asm volatile("s_waitcnt vmcnt(" #n ")" ::: "memory")
#define PG8_WAIT_L(n) asm volatile("s_waitcnt lgkmcnt(" #n ")" ::: "memory")
#define PG8_BAR __builtin_amdgcn_s_barrier()
#define PG8_SCHED __builtin_amdgcn_sched_barrier(0)
    Unit cur, nxt; int ui = 0;
    if (!S.next(0, cur)) return;
    f32x4 acc[2][2][4][2];
#pragma unroll
    for (int a = 0; a < 2; ++a)
#pragma unroll
        for (int b = 0; b < 2; ++b)
#pragma unroll
            for (int m = 0; m < 4; ++m)
#pragma unroll
                for (int n = 0; n < 2; ++n) acc[a][b][m][n] = (f32x4){0.f, 0.f, 0.f, 0.f};
    bf16x8 At[4][2], B0[2][2], B1[2][2];
    const char* cA = (const char*)g.A + (size_t)cur.pm * tstep; const char* cB;
    if constexpr (Sched::SPLITK) { cA += (size_t)Sched::kt0(cur) * kstep; cB = (const char*)g.Bt + (size_t)(cur.pn & 255) * tstep + (size_t)Sched::kt0(cur) * kstep; } else cB = (const char*)g.Bt + (size_t)cur.pn * tstep;
    S.a_ready(cur);
    if constexpr (SP2) {
        PG8_STAGE(PG8_SB(0, 0), cB, voffB); PG8_STAGE(PG8_SB(0, 1), cB + hstep, voffB); PG8_STAGE(PG8_SA(0, 0), cA, voffA); PG8_STAGE(PG8_SA(0, 1), cA + hstep, voffA);
        if (wr == 1) PG8_BAR;
        PG8_WAIT_V(2); PG8_BAR;
        PG8_STAGE(PG8_SB(1, 0), cB + kstep, voffB); PG8_STAGE(PG8_SA(1, 0), cA + kstep, voffA); PG8_STAGE(PG8_SB(1, 1), cB + hstep + kstep, voffB);
        PG8_WAIT_V(6); PG8_BAR;
    } else {
        PG8_STAGE(PG8_SB(0, 0), cB, voffB); PG8_STAGE(PG8_SA(0, 0), cA, voffA); PG8_STAGE(PG8_SB(0, 1), cB + hstep, voffB); PG8_STAGE(PG8_SA(0, 1), cA + hstep, voffA);
        if (wr == 1) PG8_BAR;
        PG8_WAIT_V(4); PG8_BAR;
        PG8_STAGE(PG8_SB(1, 0), cB + kstep, voffB); PG8_STAGE(PG8_SA(1, 0), cA + kstep, voffA); PG8_STAGE(PG8_SB(1, 1), cB + hstep + kstep, voffB);
        PG8_WAIT_V(6); PG8_BAR;
    }
    for (;;) {
        const bool has_next = S.next(ui + 1, nxt);
        const char* nA = cA; const char* nB = cB; int cnt = nt;
        if constexpr (Sched::SPLITK) { if (has_next) { nA = (const char*)g.A + (size_t)nxt.pm * tstep + (size_t)Sched::kt0(nxt) * kstep; nB = (const char*)g.Bt + (size_t)(nxt.pn & 255) * tstep + (size_t)Sched::kt0(nxt) * kstep; } cnt = Sched::cnt(cur, nt); }
        else { if (has_next) { nA = (const char*)g.A + (size_t)nxt.pm * tstep; nB = (const char*)g.Bt + (size_t)nxt.pn * tstep; } }
        for (int t = 0; t < cnt; t += 2) {
            if constexpr (HasMid<Epi>::value) { if (t == Epi::MID_T) E.mid(acc, cur, wr, wc, fr, fq); }
            const bool last = (t == cnt - 2);
            const char* a1 = cA + (size_t)(t + 1) * kstep;
            const char* a2 = last ? nA : cA + (size_t)(t + 2) * kstep; const char* b2 = last ? nB : cB + (size_t)(t + 2) * kstep;
            const char* a3 = a2 + kstep; const char* b3 = b2 + kstep;
            if (last && has_next) S.a_ready(nxt);
            if constexpr (SP2) {
            PG8_LDB(B0, 0, 0); PG8_LDB(B1, 0, 1); PG8_SCHED; PG8_LDA(At, 0, 0); PG8_STAGE(PG8_SA(1, 1), a1 + hstep, voffA);
            PG8_WAIT_V(8); PG8_WAIT_L(0); PG8_BAR; PG8_MMA(0, 0, At, B0); PG8_MMA(0, 1, At, B1); PG8_BAR; PG8_SCHED;
            PG8_LDA(At, 0, 1); PG8_STAGE(PG8_SB(0, 0), b2, voffB); PG8_STAGE(PG8_SB(0, 1), b2 + hstep, voffB); PG8_STAGE(PG8_SA(0, 0), a2, voffA);
            PG8_WAIT_V(8); PG8_WAIT_L(0); PG8_BAR; PG8_MMA(1, 0, At, B0); PG8_MMA(1, 1, At, B1); PG8_BAR; PG8_SCHED;
            PG8_LDB(B0, 1, 0); PG8_LDB(B1, 1, 1); PG8_SCHED; PG8_LDA(At, 1, 0); PG8_STAGE(PG8_SA(0, 1), a2 + hstep, voffA);
            PG8_WAIT_V(8); PG8_WAIT_L(0); PG8_BAR; PG8_MMA(0, 0, At, B0); PG8_MMA(0, 1, At, B1); PG8_BAR; PG8_SCHED;
            PG8_LDA(At, 1, 1); PG8_STAGE(PG8_SB(1, 0), b3, voffB); PG8_STAGE(PG8_SB(1, 1), b3 + hstep, voffB); PG8_STAGE(PG8_SA(1, 0), a3, voffA);
            PG8_WAIT_V(8); PG8_WAIT_L(0); PG8_BAR; PG8_MMA(1, 0, At, B0); PG8_MMA(1, 1, At, B1); PG8_BAR; PG8_SCHED;
            } else {
            PG8_LDB(B0, 0, 0); PG8_SCHED; PG8_LDA(At, 0, 0); PG8_STAGE(PG8_SA(1, 1), a1 + hstep, voffA);
            PG8_WAIT_L(8); PG8_BAR; PG8_WAIT_L(0); PG8_MMA(0, 0, At, B0); PG8_BAR; PG8_SCHED;
            PG8_LDB(B1, 0, 1); PG8_STAGE(PG8_SB(0, 0), b2, voffB);
            PG8_BAR; PG8_WAIT_L(0); PG8_MMA(0, 1, At, B1); PG8_BAR;
            PG8_LDA(At, 0, 1); PG8_STAGE(PG8_SA(0, 0), a2, voffA);
            PG8_BAR; PG8_WAIT_L(0); PG8_MMA(1, 0, At, B0); PG8_BAR; PG8_SCHED;
            PG8_STAGE(PG8_SB(0, 1), b2 + hstep, voffB);
            PG8_WAIT_V(6); PG8_BAR; PG8_MMA(1, 1, At, B1); PG8_BAR;
            PG8_LDB(B0, 1, 0); PG8_SCHED; PG8_LDA(At, 1, 0); PG8_STAGE(PG8_SA(0, 1), a2 + hstep, voffA);
            PG8_WAIT_L(8); PG8_BAR; PG8_WAIT_L(0); PG8_MMA(0, 0, At, B0); PG8_BAR; PG8_SCHED;
            PG8_LDB(B1, 1, 1); PG8_STAGE(PG8_SB(1, 0), b3, voffB);
            PG8_BAR; PG8_WAIT_L(0); PG8_MMA(0, 1, At, B1); PG8_BAR;
            PG8_LDA(At, 1, 1); PG8_STAGE(PG8_SA(1, 0), a3, voffA);
            PG8_BAR; PG8_WAIT_L(0); PG8_MMA(1, 0, At, B0); PG8_BAR; PG8_SCHED;
            PG8_STAGE(PG8_SB(1, 1), b3 + hstep, voffB);
            PG8_WAIT_V(6); PG8_BAR; PG8_MMA(1, 1, At, B1); PG8_BAR;
            }
        }
        if constexpr (ALIGN_EPI) { if (wr == 0) PG8_BAR; }
        if constexpr (!Epi::AFTER_DRAIN) { if constexpr (HasInplace<Epi>::value) E.inplace(acc, cur, wr, wc, fr, fq); else E(acc, cur, wr, wc, fr, fq); S.done(cur); }
        if (!has_next) break;
#pragma unroll
        for (int a = 0; a < 2; ++a)
#pragma unroll
            for (int b = 0; b < 2; ++b)
#pragma unroll
                for (int m = 0; m < 4; ++m)
#pragma unroll
                    for (int n = 0; n < 2; ++n) acc[a][b][m][n] = (f32x4){0.f, 0.f, 0.f, 0.f};
        cur = nxt; cA = nA; cB = nB; ++ui;
        if constexpr (ALIGN_EPI) { if (wr == 1) PG8_BAR; }
    }
    PG8_WAIT_V(0);
    if constexpr (!ALIGN_EPI) { if (wr == 0) PG8_BAR; }
    PG8_BAR;
    if constexpr (Epi::AFTER_DRAIN) { E.fused(acc, cur, wr, wc, fr, fq, lds, wid, lane); S.done(cur); }
#undef PG8_SA
#undef PG8_SB
#undef PG8_STAGE
#undef PG8_LDA
#undef PG8_LDB
#undef PG8_MMA
#undef PG8_WAIT_V
#undef PG8_WAIT_L
#undef PG8_BAR
#undef PG8_SCHED
}
}


constexpr int NWAVES = 8;
constexpr int D_MODEL = 4096, BATCH = 4, SEQ = 2048, CTX_LEN = 256, D_FF = 11008, D_A = 1024, D_B = 2048, N_IN = 19456, N_MOD = 9;
constexpr int D_FFP = D_FF + 64;
constexpr int RT = 9216;
constexpr int RPB = 2304;
constexpr int S5_G = 64, S5_P = 64, S5_H = 16, NCHUNK = 36;
constexpr float EPS = 1e-6f;
constexpr int ADA_KS = 8, NMODC_ = 36864;

constexpr size_t MiB = 1u << 20;
constexpr size_t WS_CTL = 0, CTL_ZERO_BYTES = 1 * MiB;
constexpr size_t WS_MODP = 2 * MiB;
constexpr size_t WS_MOD = 14 * MiB;
constexpr size_t WS_TAB = 15 * MiB;
constexpr size_t WS_Y = 188 * MiB  , WS_WP = 656 * MiB  ;
constexpr size_t WS_W13A = 16 * MiB, WS_W2A = 814 * MiB, WS_WIN = 274 * MiB, WS_WGLU = 426 * MiB, WS_WPA = 428 * MiB, WS_WPB = 436 * MiB, WS_WOUT = 452 * MiB, WS_W13B = 484 * MiB, WS_W2B = 901 * MiB;
constexpr size_t WS_ZN = 742 * MiB, WS_HID = 2026 * MiB, WS_H = 1008 * MiB, WS_UA = 1152 * MiB, WS_Q = 1188 * MiB, WS_V = 1224 * MiB, WS_OG = 1260 * MiB, WS_LFF = 1296 * MiB, WS_LFB = 1368 * MiB;
constexpr size_t WS_SGA = 1440 * MiB, WS_SGB = 1512 * MiB, WS_XEND = 1584 * MiB, WS_GA = 1594 * MiB, WS_YA = 1612 * MiB, WS_OHG = 1630 * MiB, WS_YB = 1774 * MiB, WS_PT = 1810 * MiB, WS_MRG = 1954 * MiB, WS_END = 2221 * MiB;
static_assert(WS_W13A + (size_t)2 * D_FF * D_MODEL * 2 <= WS_WIN && WS_W2A + (size_t)D_MODEL * D_FFP * 2 <= WS_W2B && WS_W2B + (size_t)D_MODEL * D_FFP * 2 <= WS_H && WS_WIN + (size_t)N_IN * D_MODEL * 2 <= WS_WGLU, "ws map 1");
static_assert(WS_W13B + (size_t)2 * D_FF * D_MODEL * 2 <= WS_ZN && WS_ZN + (size_t)RT * D_MODEL * 2 <= WS_W2A && WS_MRG + (size_t)RT * D_MODEL * 2 <= WS_HID && WS_HID + (size_t)RT * D_FFP * 2 <= WS_END, "ws map 2");
static_assert(WS_H + (size_t)RT * D_MODEL * 4 <= WS_UA && WS_UA + (size_t)RT * D_A * 4 <= WS_Q && WS_Q + (size_t)RT * D_B * 2 <= WS_V && WS_LFF + (size_t)RT * D_B * 4 <= WS_LFB && WS_SGA + (size_t)RT * D_MODEL * 2 <= WS_SGB, "ws map 3");
static_assert(WS_XEND + (size_t)BATCH * 2 * S5_G * NCHUNK * S5_P * 8 <= WS_GA && WS_OHG + (size_t)2 * RT * D_B * 4 <= WS_YB && WS_PT + (size_t)RT * D_MODEL * 4 <= WS_MRG && WS_MRG + (size_t)RT * D_MODEL * 2 <= WS_END, "ws map 4");
static_assert(WS_MODP + (size_t)ADA_KS * 5 * 36864 * 4 <= WS_MOD, "ws map 5");
constexpr int CW_BAR = 4096;
constexpr int CW_QUEUE = 8192, CW_DONE = 8192 + 64, CW_QUEUE2 = 8192 + 128, CW_QUEUE3 = 8192 + 192, CW_PANEL = 12288  ;

constexpr int RING_OFF = 0, RING_BYTES = 131072;
constexpr int LDSCTL_OFF = RING_BYTES, MISC_OFF = LDSCTL_OFF + 320;
constexpr int LDS_BYTES = 147456;
static_assert(MISC_OFF + 128 <= LDS_BYTES, "LDS map");

#define GAS __attribute__((address_space(1)))
#define LAS __attribute__((address_space(3)))
typedef unsigned short bf16;
typedef unsigned v4u __attribute__((ext_vector_type(4)));
typedef unsigned v2u __attribute__((ext_vector_type(2)));
typedef float f32x4 __attribute__((ext_vector_type(4)));
typedef float f32x2 __attribute__((ext_vector_type(2)));
typedef short bf16x8 __attribute__((ext_vector_type(8)));
typedef GAS unsigned gu32;
#define RLX_AGENT __ATOMIC_RELAXED, __HIP_MEMORY_SCOPE_AGENT
#define LDS_WAIT() asm volatile("s_waitcnt lgkmcnt(0)" ::: "memory")
#define VM_WAIT() asm volatile("s_waitcnt vmcnt(0)" ::: "memory")
using pg8::cvt_pk_bf16; using pg8::bf_lo; using pg8::bf_hi; using pg8::sigmoid_f; using pg8::silu_f;
__device__ __forceinline__ float wave_sum(float v) {
#pragma unroll
    for (int o = 1; o < 64; o <<= 1) v += __shfl_xor(v, o);
    return v;
}

#define XB_TMO      128
#define XB_XCNT(j)  (256  + 64 * (j))
#define XB_XSUB(j)  (1280 + 64 * (j))
#define XB_XGEN(j)  (2304 + 64 * (j))
#define XB_TOP      3328
#define XB_TOPGEN   3392
#define XCD_BAR_WORDS 3456
#define XB_SPIN_CAP (1u << 18)

__device__ __forceinline__ unsigned xb_ld(unsigned* p)              { return __hip_atomic_load(p, __ATOMIC_RELAXED, __HIP_MEMORY_SCOPE_AGENT); }
__device__ __forceinline__ unsigned xb_add(unsigned* p, unsigned v) { return __hip_atomic_fetch_add(p, v, __ATOMIC_RELAXED, __HIP_MEMORY_SCOPE_AGENT); }
__device__ __forceinline__ unsigned xb_xcc_id() { return (unsigned)__builtin_amdgcn_s_getreg((3 << 11) | 20) & 0xFu; }
#define XB_SPIN(cond, bar) do { unsigned _sp = 0; while (cond) { __builtin_amdgcn_s_sleep(1); \
    if ((++_sp & 255u) == 0u) { if (xb_ld(&(bar)[XB_TMO])) break; if (_sp > XB_SPIN_CAP) { atomicAdd(&(bar)[XB_TMO], 1u); break; } } } } while (0)

struct XcdBarrier {
    unsigned* bar; unsigned x;
    volatile LAS unsigned* st;
};

__device__ __forceinline__ XcdBarrier xcd_barrier_post(unsigned* bar, volatile LAS unsigned* st) {
    XcdBarrier b; b.bar = bar; b.x = xb_xcc_id(); b.st = st;
    if (threadIdx.x == 0) (void)xb_add(&bar[XB_XCNT(b.x)], 1u);
    return b;
}
__device__ __forceinline__ void xcd_barrier_complete(unsigned* bar, unsigned x, unsigned& nloc, unsigned& nx) {
    const unsigned G = gridDim.x * gridDim.y * gridDim.z;
    unsigned sum, cnt, mine, sp = 0u;
    for (;;) {
        sum = 0u; cnt = 0u; mine = 0u;
#pragma unroll
        for (unsigned j = 0; j < 16; ++j) { const unsigned c = xb_ld(&bar[XB_XCNT(j)]); sum += c; cnt += (c > 0u) ? 1u : 0u; mine = (j == x) ? c : mine; }
        if (sum == G) break;
        __builtin_amdgcn_s_sleep(1);
        if ((++sp & 255u) == 0u) { if (xb_ld(&bar[XB_TMO])) break; if (sp > XB_SPIN_CAP) { atomicAdd(&bar[XB_TMO], 1u); break; } }
    }
    nloc = mine > 0u ? mine : 1u; nx = cnt > 0u ? cnt : 1u;
}

__device__ __forceinline__ void xcd_barrier(const XcdBarrier& b) {
    asm volatile("s_waitcnt vmcnt(0)" ::: "memory");
    __syncthreads();
    if (threadIdx.x == 0) {
        unsigned* bar = b.bar;
        __builtin_amdgcn_s_waitcnt(0);
        unsigned nloc = b.st[0], nx = b.st[1];
        if (nloc == 0u) { xcd_barrier_complete(bar, b.x, nloc, nx); b.st[0] = nloc; b.st[1] = nx; }
        const unsigned old = xb_add(&bar[XB_XSUB(b.x)], 1u);
        const unsigned gen = old / nloc;
        if (old + 1u == (gen + 1u) * nloc) {
            __builtin_amdgcn_fence(__ATOMIC_RELEASE, "agent");
            asm volatile("s_waitcnt vmcnt(0)" ::: "memory");
            const unsigned og = xb_add(&bar[XB_TOP], 1u);
            const unsigned tg = og / nx;
            if (og + 1u == (tg + 1u) * nx) xb_add(&bar[XB_TOPGEN], 1u);
            else XB_SPIN(xb_ld(&bar[XB_TOPGEN]) == tg, bar);
            __builtin_amdgcn_fence(__ATOMIC_ACQUIRE, "agent");
            xb_add(&bar[XB_XGEN(b.x)], 1u);
            asm volatile("s_waitcnt vmcnt(0)" ::: "memory");
        } else {
            XB_SPIN(xb_ld(&bar[XB_XGEN(b.x)]) == gen, bar);
            __builtin_amdgcn_fence(__ATOMIC_ACQUIRE, "agent");
            asm volatile("s_waitcnt vmcnt(0)" ::: "memory");
        }
    }
    __syncthreads();
}


struct Args { const float* in[31]; float* out; unsigned char* ws; };
enum { I_X = 0, I_C, I_CTX, I_CCTX, I_WADA, I_BADA, I_NORM1, I_W1A, I_W3A, I_W2A, I_NORMMIX, I_WIN, I_LAMRE, I_LAMIM, I_LOGDT, I_BRE, I_BIM, I_CRE, I_CIM, I_S5D, I_WGLU,
       I_LBLOG, I_HGNORM, I_WPA, I_WPB, I_WOUT, I_NORM2, I_W1B, I_W3B, I_W2B, I_NORMF };

struct ItemDesc { const float* src; bf16* dst; int N, K; };
__device__ __forceinline__ ItemDesc make_item(const float* W, int K, int N, bf16* WT, int kind, int item, int ld = 0) {
    if (ld) K = ld;
    const int nblk = N / 32, kb = item / nblk, nb = item - kb * nblk, k0 = 64 * kb, n0 = 32 * nb;
    int drow = (kind == 0) ? n0 : ((n0 >> 7) * 256 + (n0 & 127) + (kind == 2 ? 128 : 0));
    if (kind == 3) { const int st = n0 >> 8; const int dt = (st < 4) ? st : (st < 12) ? st + 24 : (st < 36) ? st - 8 : st;
        drow = dt * 256 + (n0 & 255);
        if (st >= 44) { const int isb = (st >= 60) ? 1 : 0, c = (st - 44 - 16 * isb) * 256 + (n0 & 255); drow = (44 + (c >> 7)) * 256 + (c & 127) + 128 * isb; } }
    ItemDesc d; d.src = W + (size_t)k0 * N + n0; d.dst = WT + (size_t)drow * K + k0; d.N = N; d.K = K; return d;
}
__device__ __forceinline__ void item_load(const ItemDesc& d, f32x4 (&v)[8], int lane) {
    const float* p = d.src + (size_t)(lane >> 3) * d.N + 4 * (lane & 7);
#pragma unroll
    for (int i = 0; i < 8; ++i) v[i] = __builtin_nontemporal_load((const GAS f32x4*)(p + (size_t)(8 * i) * d.N));
}
__device__ __forceinline__ void item_store(const ItemDesc& d, const f32x4 (&v)[8], LAS float* scr, int lane) {
#pragma unroll
    for (int i = 0; i < 8; ++i) { LAS float* s = scr + (8 * i + (lane >> 3)) * 33 + 4 * (lane & 7); s[0] = v[i].x; s[1] = v[i].y; s[2] = v[i].z; s[3] = v[i].w; }
    LDS_WAIT(); asm volatile("" ::: "memory");
    const int c = lane & 7;
#pragma unroll
    for (int j = 0; j < 4; ++j) { const int n = (lane >> 3) + 8 * j; const LAS float* s = scr + (8 * c) * 33 + n;
        v4u o; o.x = cvt_pk_bf16(s[0 * 33], s[1 * 33]); o.y = cvt_pk_bf16(s[2 * 33], s[3 * 33]); o.z = cvt_pk_bf16(s[4 * 33], s[5 * 33]); o.w = cvt_pk_bf16(s[6 * 33], s[7 * 33]);
        *(GAS v4u*)(d.dst + (size_t)n * d.K + 8 * c) = o; }
    LDS_WAIT(); asm volatile("" ::: "memory");
}
constexpr int IT_FF = (D_MODEL / 64) * (D_FF / 32), IT_WIN = (D_MODEL / 64) * (N_IN / 32), IT_GLU = (D_A / 64) * (D_A / 32), IT_PA = (D_A / 64) * (D_MODEL / 32), IT_PB = (D_B / 64) * (D_MODEL / 32), IT_OUT = (D_MODEL / 64) * (D_MODEL / 32);
constexpr int T_ITEMS = 6 * IT_FF + IT_WIN + IT_GLU + IT_PA + IT_PB + IT_OUT;
constexpr int ADA_TASKS = 144 * ADA_KS, ADA_KLEN = D_MODEL / ADA_KS;

__device__ __forceinline__ void p0_ada_task(const float* cvec, const float* cctx, const float* wada, float* modp, int task, LAS float* scr, int lane) {
    const int cg = task % 144, ks = task / 144, k0 = ks * ADA_KLEN, n0 = cg * 256 + lane * 4;
#pragma unroll
    for (int i = 0; i < 5; ++i)
        for (int kk = lane; kk < ADA_KLEN; kk += 64) { const float v = (i < 4) ? cvec[i * D_MODEL + k0 + kk] : cctx[k0 + kk]; scr[kk * 8 + i] = silu_f(v); }
    LDS_WAIT(); asm volatile("" ::: "memory");
    f32x4 a0 = {0.f, 0.f, 0.f, 0.f}, a1 = a0, a2 = a0, a3 = a0, a4 = a0;
    const float* wp = wada + (size_t)k0 * NMODC_ + n0;
#pragma unroll 16
    for (int k = 0; k < ADA_KLEN; ++k) {
        const f32x4 w = __builtin_nontemporal_load((const GAS f32x4*)(wp + (size_t)k * NMODC_));
        const f32x4 s = *(const LAS f32x4*)(scr + k * 8); const float s4 = scr[k * 8 + 4];
        a0 += w * s[0]; a1 += w * s[1]; a2 += w * s[2]; a3 += w * s[3]; a4 += w * s4;
    }
    float* o = modp + (size_t)ks * 5 * NMODC_ + n0;
    *(f32x4*)(o) = a0; *(f32x4*)(o + NMODC_) = a1; *(f32x4*)(o + 2 * NMODC_) = a2; *(f32x4*)(o + 3 * NMODC_) = a3; *(f32x4*)(o + 4 * NMODC_) = a4;
    LDS_WAIT(); asm volatile("" ::: "memory");
}

__device__ __forceinline__ void norm_mod_row(const float* src, const float* gain, const float* shift, const float* scale, bf16* dst, int lane) {
    const GAS f32x4* xr = (const GAS f32x4*)src + lane;
    f32x4 v[16]; float s = 0.f;
#pragma unroll
    for (int j = 0; j < 16; ++j) { v[j] = xr[64 * j]; s += (v[j].x * v[j].x + v[j].y * v[j].y) + (v[j].z * v[j].z + v[j].w * v[j].w); }
    const float rstd = 1.0f / sqrtf(wave_sum(s) * (1.f / D_MODEL) + EPS);
    const GAS f32x4* gp = (const GAS f32x4*)gain + lane; const GAS f32x4* hp = (const GAS f32x4*)shift + lane; const GAS f32x4* cp = (const GAS f32x4*)scale + lane;
    GAS v2u* o8 = (GAS v2u*)dst + lane;
#pragma unroll
    for (int j = 0; j < 16; ++j) { const f32x4 g = gp[64 * j], sh = hp[64 * j], sc = cp[64 * j]; const f32x4 y = (v[j] * rstd * g) * (sc + 1.0f) + sh;
        v2u w; w.x = cvt_pk_bf16(y.x, y.y); w.y = cvt_pk_bf16(y.z, y.w); o8[64 * j] = w; }
}
__device__ __forceinline__ void norm_mod_row_h(const pg8::h16_t* src, const float* gain, const float* shift, const float* scale, bf16* dst, int lane) {
    const GAS v2u* xr = (const GAS v2u*)src + lane;
    f32x4 v[16]; float s = 0.f;
#pragma unroll
    for (int j = 0; j < 16; ++j) { const v2u w = xr[64 * j]; const f32x2 a = pg8::unpk_f16(w.x), c = pg8::unpk_f16(w.y); v[j] = (f32x4){a.x, a.y, c.x, c.y};
        s += (v[j].x * v[j].x + v[j].y * v[j].y) + (v[j].z * v[j].z + v[j].w * v[j].w); }
    const float rstd = 1.0f / sqrtf(wave_sum(s) * (1.f / D_MODEL) + EPS);
    const GAS f32x4* gp = (const GAS f32x4*)gain + lane; const GAS f32x4* hp = (const GAS f32x4*)shift + lane; const GAS f32x4* cp = (const GAS f32x4*)scale + lane;
    GAS v2u* o8 = (GAS v2u*)dst + lane;
#pragma unroll
    for (int j = 0; j < 16; ++j) { const f32x4 g = gp[64 * j], sh = hp[64 * j], sc = cp[64 * j]; const f32x4 y = (v[j] * rstd * g) * (sc + 1.0f) + sh;
        v2u w; w.x = cvt_pk_bf16(y.x, y.y); w.y = cvt_pk_bf16(y.z, y.w); o8[64 * j] = w; }
}
__device__ __forceinline__ void norm_mod_row_part(const float* base, const pg8::h16_t* part, const float* m2, const float* gain, const float* shift, const float* scale, bf16* dst, int lane) {
    const GAS f32x4* xr = (const GAS f32x4*)base + lane; const GAS v2u* pr = (const GAS v2u*)part + lane; const GAS f32x4* mr = (const GAS f32x4*)m2 + lane;
    constexpr size_t QS = (size_t)BATCH * CTX_LEN * D_MODEL / 4;
    f32x4 v[16]; float s = 0.f;
#pragma unroll
    for (int j = 0; j < 16; ++j) { f32x4 p = (f32x4){0.f, 0.f, 0.f, 0.f};
#pragma unroll
        for (int k = 0; k < 4; ++k) { const v2u w = pr[k * QS + 64 * j]; const f32x2 a = pg8::unpk_f16(w.x), c = pg8::unpk_f16(w.y); p += (f32x4){a.x, a.y, c.x, c.y}; }
        v[j] = xr[64 * j] + (mr[64 * j] * 0.5f) * p; s += (v[j].x * v[j].x + v[j].y * v[j].y) + (v[j].z * v[j].z + v[j].w * v[j].w);
        if ((j & 3) == 3) asm volatile("" ::: "memory"); }
    const float rstd = 1.0f / sqrtf(wave_sum(s) * (1.f / D_MODEL) + EPS);
    const GAS f32x4* gp = (const GAS f32x4*)gain + lane; const GAS f32x4* hp = (const GAS f32x4*)shift + lane; const GAS f32x4* cp = (const GAS f32x4*)scale + lane;
    GAS v2u* o8 = (GAS v2u*)dst + lane;
#pragma unroll
    for (int j = 0; j < 16; ++j) { const f32x4 g = gp[64 * j], sh = hp[64 * j], sc = cp[64 * j]; const f32x4 y = (v[j] * rstd * g) * (sc + 1.0f) + sh;
        v2u w; w.x = cvt_pk_bf16(y.x, y.y); w.y = cvt_pk_bf16(y.z, y.w); o8[64 * j] = w; }
}
__device__ __forceinline__ void norm_final_row_h(const pg8::h16_t* src, float* dst, const float* gain, int lane) {
    const GAS v2u* xr = (const GAS v2u*)src + lane; GAS f32x4* o = (GAS f32x4*)dst + lane;
    f32x4 v[16]; float s = 0.f;
#pragma unroll
    for (int j = 0; j < 16; ++j) { const v2u w = xr[64 * j]; const f32x2 a = pg8::unpk_f16(w.x), c = pg8::unpk_f16(w.y); v[j] = (f32x4){a.x, a.y, c.x, c.y};
        s += (v[j].x * v[j].x + v[j].y * v[j].y) + (v[j].z * v[j].z + v[j].w * v[j].w); }
    const float rstd = 1.0f / sqrtf(wave_sum(s) * (1.f / D_MODEL) + EPS);
    const GAS f32x4* gp = (const GAS f32x4*)gain + lane;
#pragma unroll
    for (int j = 0; j < 16; ++j) o[64 * j] = v[j] * rstd * gp[64 * j];
}
__device__ __forceinline__ void norm_final_row(float* io, const float* gain, int lane) {
    GAS f32x4* xr = (GAS f32x4*)io + lane;
    f32x4 v[16]; float s = 0.f;
#pragma unroll
    for (int j = 0; j < 16; ++j) { v[j] = xr[64 * j]; s += (v[j].x * v[j].x + v[j].y * v[j].y) + (v[j].z * v[j].z + v[j].w * v[j].w); }
    const float rstd = 1.0f / sqrtf(wave_sum(s) * (1.f / D_MODEL) + EPS);
    const GAS f32x4* gp = (const GAS f32x4*)gain + lane;
#pragma unroll
    for (int j = 0; j < 16; ++j) xr[64 * j] = v[j] * rstd * gp[64 * j];
}

__device__ __forceinline__ void s5_table_entry(const float* lam_re, const float* lam_im, const float* log_dt, float* TAB, int idx) {
    const int dg = idx >> 6;
    const double dt = exp((double)log_dt[dg]);
    const double lr = (double)lam_re[idx], li = (double)lam_im[idx];
    const double mag = exp(lr * dt), th = li * dt;
    const double TWO_PI = 6.283185307179586476925286766559;
    const double rr = th - TWO_PI * rint(th * (1.0 / TWO_PI));
    const double abr = mag * cos(rr), abi = mag * sin(rr);
    const double den = lr * lr + li * li, nr = abr - 1.0;
    const double kr = (nr * lr + abi * li) / den, ki = (abi * lr - nr * li) / den;
    double pr = abr, pi = abi;
#pragma unroll
    for (int i = 0; i < 6; ++i) { const double tr = pr * pr - pi * pi, ti = 2.0 * pr * pi; pr = tr; pi = ti; }
    float* o = TAB + (size_t)idx * 8;
    o[0] = (float)abr; o[1] = (float)abi; o[2] = (float)kr; o[3] = (float)ki; o[4] = (float)pr; o[5] = (float)pi; o[6] = 0.f; o[7] = 0.f;
}
#define S5_LOAD_BK(d_, g_, p_) \
    float ar, ai, a64r, a64i; f32x2 bk2[16]; \
    { const f32x4 t0 = *(const f32x4*)(TAB + ((size_t)(((d_) * 64 + (g_)) * 64 + (p_))) * 8), t1 = *(const f32x4*)(TAB + ((size_t)(((d_) * 64 + (g_)) * 64 + (p_))) * 8 + 4); \
      ar = t0[0]; ai = t0[1]; a64r = t1[0]; a64i = t1[1]; const float kr = t0[2], ki = t0[3]; \
      const f32x4* br = (const f32x4*)(b_re + ((size_t)((g_) * 64 + (p_))) * 16); const f32x4* bi = (const f32x4*)(b_im + ((size_t)((g_) * 64 + (p_))) * 16); \
      _Pragma("unroll") for (int q = 0; q < 4; ++q) { const f32x4 x = br[q], y = bi[q]; \
          _Pragma("unroll") for (int j = 0; j < 4; ++j) { bk2[4 * q + j] = (f32x2){kr * x[j] - ki * y[j], kr * y[j] + ki * x[j]}; } } }
#define S5_STEP(tl_) { const f32x4 u0 = UL[(tl_) * 4 + 0], u1 = UL[(tl_) * 4 + 1], u2 = UL[(tl_) * 4 + 2], u3 = UL[(tl_) * 4 + 3]; \
        f32x2 e0 = bk2[0] * u0[0], e1 = bk2[1] * u0[1]; \
        e0 += bk2[2] * u0[2]; e1 += bk2[3] * u0[3]; e0 += bk2[4] * u1[0]; e1 += bk2[5] * u1[1]; e0 += bk2[6] * u1[2]; e1 += bk2[7] * u1[3]; \
        e0 += bk2[8] * u2[0]; e1 += bk2[9] * u2[1]; e0 += bk2[10] * u2[2]; e1 += bk2[11] * u2[3]; e0 += bk2[12] * u3[0]; e1 += bk2[13] * u3[1]; e0 += bk2[14] * u3[2]; e1 += bk2[15] * u3[3]; \
        e0 += e1; \
        const float nr_ = ar * xr - ai * xi + e0.x, ni_ = ar * xi + ai * xr + e0.y; xr = nr_; xi = ni_; }

typedef float f32x16 __attribute__((ext_vector_type(16)));
__device__ __forceinline__ void s5_make_ef(bf16x8 (&Ef)[4], const float* TAB, const float* b_re, const float* b_im, int d, int g, int lane) {
    const int half = lane >> 5, l31 = lane & 31;
#pragma unroll
    for (int s2 = 0; s2 < 2; ++s2) { const int ps = 32 * s2 + l31;
        const f32x4 tt = *(const f32x4*)(TAB + ((size_t)((d * 64 + g) * 64 + ps)) * 8); const float kr = tt[2], ki = tt[3];
        const float* brp = b_re + ((size_t)(g * 64 + ps)) * 16 + 8 * half; const float* bip = b_im + ((size_t)(g * 64 + ps)) * 16 + 8 * half;
        const f32x4 r0 = *(const f32x4*)brp, r1 = *(const f32x4*)(brp + 4), i0 = *(const f32x4*)bip, i1 = *(const f32x4*)(bip + 4);
        v4u wr_, wi_;
        wr_.x = cvt_pk_bf16(kr * r0[0] - ki * i0[0], kr * r0[1] - ki * i0[1]); wr_.y = cvt_pk_bf16(kr * r0[2] - ki * i0[2], kr * r0[3] - ki * i0[3]);
        wr_.z = cvt_pk_bf16(kr * r1[0] - ki * i1[0], kr * r1[1] - ki * i1[1]); wr_.w = cvt_pk_bf16(kr * r1[2] - ki * i1[2], kr * r1[3] - ki * i1[3]);
        wi_.x = cvt_pk_bf16(kr * i0[0] + ki * r0[0], kr * i0[1] + ki * r0[1]); wi_.y = cvt_pk_bf16(kr * i0[2] + ki * r0[2], kr * i0[3] + ki * r0[3]);
        wi_.z = cvt_pk_bf16(kr * i1[0] + ki * r1[0], kr * i1[1] + ki * r1[1]); wi_.w = cvt_pk_bf16(kr * i1[2] + ki * r1[2], kr * i1[3] + ki * r1[3]);
        Ef[s2] = __builtin_bit_cast(bf16x8, wr_); Ef[2 + s2] = __builtin_bit_cast(bf16x8, wi_); }
}
#define S5_E_TILES(blk_) \
    const int tk_ = 16 * (blk_) + (l31 & 3) + 4 * (l31 >> 3); \
    const f32x4 ua_ = UL[tk_ * 4 + 2 * half], ub_ = UL[tk_ * 4 + 2 * half + 1]; \
    v4u aw_; aw_.x = cvt_pk_bf16(ua_[0], ua_[1]); aw_.y = cvt_pk_bf16(ua_[2], ua_[3]); aw_.z = cvt_pk_bf16(ub_[0], ub_[1]); aw_.w = cvt_pk_bf16(ub_[2], ub_[3]); \
    const bf16x8 Af_ = __builtin_bit_cast(bf16x8, aw_); \
    f32x16 zero16_; _Pragma("unroll") for (int q_ = 0; q_ < 16; ++q_) zero16_[q_] = 0.f; \
    const f32x16 D0 = __builtin_amdgcn_mfma_f32_32x32x16_bf16(Af_, Ef[0], zero16_, 0, 0, 0), D1 = __builtin_amdgcn_mfma_f32_32x32x16_bf16(Af_, Ef[1], zero16_, 0, 0, 0); \
    const f32x16 D2 = __builtin_amdgcn_mfma_f32_32x32x16_bf16(Af_, Ef[2], zero16_, 0, 0, 0), D3 = __builtin_amdgcn_mfma_f32_32x32x16_bf16(Af_, Ef[3], zero16_, 0, 0, 0);

__device__ __forceinline__ void s5_pass_a(LAS unsigned char* scr, int task, const float* TAB, const float* b_re, const float* b_im, const pg8::h16_t* UA, float* XEND, int lane) {
    const int c = task % NCHUNK; int r = task / NCHUNK; const int g = r & 63; r >>= 6; const int d = r & 1; const int b = r >> 1;
    const int half = lane >> 5, l31 = lane & 31;
    const f32x4 t0 = *(const f32x4*)(TAB + ((size_t)((d * 64 + g) * 64 + lane)) * 8); const float ar = t0[0], ai = t0[1];
    bf16x8 Ef[4]; s5_make_ef(Ef, TAB, b_re, b_im, d, g, lane);
    const int j0 = 64 * c;
    const int trow = (d == 0) ? (j0 + lane) : ((j0 < CTX_LEN ? 255 - j0 : 2559 - j0) - lane);
    const v4u* up = (const v4u*)(UA + ((size_t)(b * RPB + trow)) * D_A + g * 16);
    LAS f32x4* UL = (LAS f32x4*)scr;
#pragma unroll
    for (int q = 0; q < 2; ++q) { const v4u w = up[q]; const f32x2 p0 = pg8::unpk_f16(w.x), p1 = pg8::unpk_f16(w.y), p2 = pg8::unpk_f16(w.z), p3 = pg8::unpk_f16(w.w);
        UL[lane * 4 + 2 * q] = (f32x4){p0.x, p0.y, p1.x, p1.y}; UL[lane * 4 + 2 * q + 1] = (f32x4){p2.x, p2.y, p3.x, p3.y}; }
    LDS_WAIT(); asm volatile("" ::: "memory");
    float xr = 0.f, xi = 0.f;
#pragma unroll
    for (int i = 0; i < 4; ++i) {
        S5_E_TILES(i)
#pragma unroll
        for (int ss = 0; ss < 16; ++ss) { const float er = half ? D1[ss] : D0[ss], ei = half ? D3[ss] : D2[ss];
            const float nr_ = ar * xr - ai * xi + er, ni_ = ar * xi + ai * xr + ei; xr = nr_; xi = ni_; }
    }
    __hip_atomic_store((unsigned long long*)(XEND + ((size_t)task * 64 + lane) * 2), ((unsigned long long)__float_as_uint(xi) << 32) | (unsigned long long)__float_as_uint(xr), __ATOMIC_RELAXED, __HIP_MEMORY_SCOPE_AGENT);
    LDS_WAIT(); asm volatile("" ::: "memory");
}

__device__ __forceinline__ float gelu_tanh_f(float y) { const float z = 1.5957691216057308f * (y + 0.044715f * y * y * y); return y * sigmoid_f(z); }
__device__ __forceinline__ unsigned short f2bf_rne(float f) { unsigned u = __float_as_uint(f); return (unsigned short)((u + 0x7fffu + ((u >> 16) & 1u)) >> 16); }

__device__ __forceinline__ void s5_pass_c(LAS unsigned char* scr, int task, const float* TAB, const float* b_re, const float* b_im, const float* c_re, const float* c_im, const float* dskip,
                                          const pg8::h16_t* UA, const float* XEND, bf16* GA, int lane) {
    const int c = 4 + (task & 31), g = (task >> 5) & 63, b = task >> 11;
    const int r16 = lane & 15, q4 = lane >> 4;
    LAS f32x4* UL = (LAS f32x4*)scr;
    LAS unsigned char* XB = scr + 4096;
    const int row0 = b * RPB + 64 * c;
    { const v4u* up = (const v4u*)(UA + ((size_t)(row0 + lane)) * D_A + g * 16);
#pragma unroll
      for (int q = 0; q < 2; ++q) { const v4u w = up[q]; const f32x2 p0 = pg8::unpk_f16(w.x), p1 = pg8::unpk_f16(w.y), p2 = pg8::unpk_f16(w.z), p3 = pg8::unpk_f16(w.w);
          UL[lane * 4 + 2 * q] = (f32x4){p0.x, p0.y, p1.x, p1.y}; UL[lane * 4 + 2 * q + 1] = (f32x4){p2.x, p2.y, p3.x, p3.y}; } }
    bf16x8 Cf[4];
#pragma unroll
    for (int ks = 0; ks < 4; ++ks) { const int k0 = 32 * ks + 8 * q4; const bool im = (ks >= 2);
        const float* src = (im ? c_im : c_re) + ((size_t)(g * 16 + r16)) * 64 + (k0 & 63); const float sg = im ? -1.f : 1.f;
        const f32x4 a = *(const f32x4*)src, bb = *(const f32x4*)(src + 4);
        v4u w; w.x = cvt_pk_bf16(sg * a[0], sg * a[1]); w.y = cvt_pk_bf16(sg * a[2], sg * a[3]); w.z = cvt_pk_bf16(sg * bb[0], sg * bb[1]); w.w = cvt_pk_bf16(sg * bb[2], sg * bb[3]);
        Cf[ks] = __builtin_bit_cast(bf16x8, w); }
    f32x4 ya[4];
#pragma unroll
    for (int i = 0; i < 4; ++i) ya[i] = (f32x4){0.f, 0.f, 0.f, 0.f};
    LDS_WAIT(); asm volatile("" ::: "memory");
    const int half = lane >> 5, l31 = lane & 31;
#pragma unroll
    for (int d = 0; d < 2; ++d) {
        float ar, ai, a64r, a64i;
        { const f32x4 t0 = *(const f32x4*)(TAB + ((size_t)((d * 64 + g) * 64 + lane)) * 8), t1 = *(const f32x4*)(TAB + ((size_t)((d * 64 + g) * 64 + lane)) * 8 + 4);
          ar = t0[0]; ai = t0[1]; a64r = t1[0]; a64i = t1[1]; }
        bf16x8 Ef[4]; s5_make_ef(Ef, TAB, b_re, b_im, d, g, lane);
        const int nprev = (d == 0) ? c : (39 - c);
        const f32x2* xe = (const f32x2*)(XEND + ((size_t)(((b * 2 + d) * 64 + g) * NCHUNK)) * 128) + lane;
        float xr = 0.f, xi = 0.f;
#pragma unroll 8
        for (int cc = 0; cc < nprev; ++cc) { const f32x2 e = xe[cc * 64]; const float nr_ = a64r * xr - a64i * xi + e.x, ni_ = a64r * xi + a64i * xr + e.y; xr = nr_; xi = ni_; }
#pragma unroll
        for (int ii = 0; ii < 4; ++ii) {
            const int i = (d == 0) ? ii : (3 - ii);
            S5_E_TILES(i)
#pragma unroll
            for (int ss = 0; ss < 16; ++ss) {
                const int s16 = (d == 0) ? ss : (15 - ss);
                const float er = half ? D1[s16] : D0[s16], ei = half ? D3[s16] : D2[s16];
                const float nr_ = ar * xr - ai * xi + er, ni_ = ar * xi + ai * xr + ei; xr = nr_; xi = ni_;
                *(LAS unsigned short*)(XB + s16 * 272 + 2 * lane) = f2bf_rne(xr);
                *(LAS unsigned short*)(XB + s16 * 272 + 128 + 2 * lane) = f2bf_rne(xi);
            }
            LDS_WAIT(); asm volatile("" ::: "memory");
#pragma unroll
            for (int ks = 0; ks < 4; ++ks) { const bf16x8 Bf = *(const LAS bf16x8*)(XB + r16 * 272 + 64 * ks + 16 * q4);
                ya[i] = __builtin_amdgcn_mfma_f32_16x16x32_bf16(Cf[ks], Bf, ya[i], 0, 0, 0); }
            LDS_WAIT(); asm volatile("" ::: "memory");
        }
    }
    const f32x4 dk = *(const f32x4*)(dskip + g * 16 + 4 * q4);
#pragma unroll
    for (int i = 0; i < 4; ++i) { const int tl = 16 * i + r16; const f32x4 u4 = UL[tl * 4 + q4];
        const f32x4 y = ya[i] + dk * u4;
        v2u w; w.x = cvt_pk_bf16(gelu_tanh_f(y[0]), gelu_tanh_f(y[1])); w.y = cvt_pk_bf16(gelu_tanh_f(y[2]), gelu_tanh_f(y[3]));
        *(GAS v2u*)(GA + ((size_t)(row0 + tl)) * D_A + g * 16 + 4 * q4) = w; }
    LDS_WAIT(); asm volatile("" ::: "memory");
}

__device__ __forceinline__ int hg_row(int b, int dir, int j) {
    const int jf = dir ? (j < CTX_LEN ? (CTX_LEN - 1 - j) : (2559 - j)) : j;
    int t = jf; if (jf >= CTX_LEN) { const int jj = jf - CTX_LEN; t = CTX_LEN + (jj & 31) * 64 + (jj >> 5); }
    return b * RPB + t;
}
constexpr int HG_TOT = 0, HG_DEC = 8192, HG_ROWS = 8704, HG_QS = 9216, HG_KS = 26624, HG_QB = 44032, HG_K2T = 61440, HG_VT = 79872, HG_P = 98304;
__device__ __forceinline__ void hgrn2_unit(LAS unsigned char* lds, int unit, const bf16* Q, const bf16* V, const pg8::h16_t* LFF, const pg8::h16_t* LFB, bf16* OHG, int tid) {
    const int b = unit >> 5, head = (unit >> 1) & 15, dir = unit & 1;
    const pg8::h16_t* LF = dir ? LFB : LFF;
    bf16* O = OHG + (size_t)dir * RT * D_B;
    const int lane = tid & 63, w = __builtin_amdgcn_readfirstlane(tid >> 6), kp = lane, tq = w, r16 = lane & 15, q4 = lane >> 4;
    const int colb = head * 128;
    LAS float* TOT = (LAS float*)(lds + HG_TOT); LAS float* DEC = (LAS float*)(lds + HG_DEC); LAS int* ROWS = (LAS int*)(lds + HG_ROWS); LAS float* EREF = (LAS float*)(lds + HG_QB);
    f32x4 S[8];
#pragma unroll
    for (int i = 0; i < 8; ++i) S[i] = (f32x4){0.f, 0.f, 0.f, 0.f};
    f32x2 lf[8]; unsigned qv[8], vv[8]; int rows[8];
#pragma unroll
    for (int i = 0; i < 8; ++i) { rows[i] = hg_row(b, dir, 8 * tq + i); const size_t o = (size_t)rows[i] * D_B + colb + 2 * kp;
        lf[i] = pg8::unpk_f16(*(const GAS unsigned*)(LF + o)); qv[i] = *(const GAS unsigned*)(Q + o); vv[i] = *(const GAS unsigned*)(V + o); }
    { float s0 = 0.f, s1 = 0.f;
#pragma unroll
      for (int i = 0; i < 8; ++i) { s0 += lf[i].x; s1 += lf[i].y; }
      *(LAS f32x2*)(TOT + tq * 128 + 2 * kp) = (f32x2){s0, s1}; }
    LDS_WAIT(); __builtin_amdgcn_s_barrier(); asm volatile("" ::: "memory");
    for (int c = 0; c < NCHUNK; ++c) {
        const LAS float* TC = TOT + (c & 1) * 1024;
        float off0 = 0.f, off1 = 0.f, ref0 = 0.f, ref1 = 0.f, all0 = 0.f, all1 = 0.f;
#pragma unroll
        for (int t2 = 0; t2 < 8; ++t2) { const f32x2 tt = *(const LAS f32x2*)(TC + t2 * 128 + 2 * kp);
            if (t2 < tq) { off0 += tt.x; off1 += tt.y; } if (t2 < 4) { ref0 += tt.x; ref1 += tt.y; } all0 += tt.x; all1 += tt.y; }
        const bool outp = (c >= 4);
        float k20[8], k21[8];
        { float b0 = off0, b1 = off1; const float ca0 = __expf(all0 - ref0), ca1 = __expf(all1 - ref1);
#pragma unroll
          for (int i = 0; i < 8; ++i) {
            b0 += lf[i].x; b1 += lf[i].y;
            const float kk0 = 1.0f - __expf(lf[i].x), kk1 = 1.0f - __expf(lf[i].y);
            const float ks0 = kk0 * __expf(ref0 - b0), ks1 = kk1 * __expf(ref1 - b1);
            k20[i] = ks0 * ca0; k21[i] = ks1 * ca1;
            if (outp) { const float q0 = bf_lo(qv[i]), q1 = bf_hi(qv[i]); const int t = 8 * tq + i;
                *(LAS unsigned*)(lds + HG_QS + t * 272 + 4 * kp) = cvt_pk_bf16(q0 * __expf(b0 - ref0), q1 * __expf(b1 - ref1));
                *(LAS unsigned*)(lds + HG_KS + t * 272 + 4 * kp) = cvt_pk_bf16(ks0, ks1); }
          } }
        { v4u a, bq; a.x = cvt_pk_bf16(k20[0], k20[1]); a.y = cvt_pk_bf16(k20[2], k20[3]); a.z = cvt_pk_bf16(k20[4], k20[5]); a.w = cvt_pk_bf16(k20[6], k20[7]);
          bq.x = cvt_pk_bf16(k21[0], k21[1]); bq.y = cvt_pk_bf16(k21[2], k21[3]); bq.z = cvt_pk_bf16(k21[4], k21[5]); bq.w = cvt_pk_bf16(k21[6], k21[7]);
          *(LAS v4u*)(lds + HG_K2T + (2 * kp) * 144 + 16 * tq) = a; *(LAS v4u*)(lds + HG_K2T + (2 * kp + 1) * 144 + 16 * tq) = bq;
          v4u lo, hi;
          lo.x = __builtin_amdgcn_perm(vv[1], vv[0], 0x05040100u); lo.y = __builtin_amdgcn_perm(vv[3], vv[2], 0x05040100u); lo.z = __builtin_amdgcn_perm(vv[5], vv[4], 0x05040100u); lo.w = __builtin_amdgcn_perm(vv[7], vv[6], 0x05040100u);
          hi.x = __builtin_amdgcn_perm(vv[1], vv[0], 0x07060302u); hi.y = __builtin_amdgcn_perm(vv[3], vv[2], 0x07060302u); hi.z = __builtin_amdgcn_perm(vv[5], vv[4], 0x07060302u); hi.w = __builtin_amdgcn_perm(vv[7], vv[6], 0x07060302u);
          *(LAS v4u*)(lds + HG_VT + (2 * kp) * 144 + 16 * tq) = lo; *(LAS v4u*)(lds + HG_VT + (2 * kp + 1) * 144 + 16 * tq) = hi; }
        if (tq == 0) { *(LAS f32x2*)(DEC + 2 * kp) = (f32x2){__expf(all0), __expf(all1)}; *(LAS f32x2*)(EREF + 2 * kp) = (f32x2){__expf(ref0), __expf(ref1)}; }
        if (kp == 0) {
#pragma unroll
            for (int i = 0; i < 8; ++i) ROWS[8 * tq + i] = rows[i]; }
        if (c + 1 < NCHUNK) {
#pragma unroll
            for (int i = 0; i < 8; ++i) { rows[i] = hg_row(b, dir, 64 * (c + 1) + 8 * tq + i); const size_t o = (size_t)rows[i] * D_B + colb + 2 * kp;
                lf[i] = pg8::unpk_f16(*(const GAS unsigned*)(LF + o)); qv[i] = *(const GAS unsigned*)(Q + o); vv[i] = *(const GAS unsigned*)(V + o); } }
        LDS_WAIT(); __builtin_amdgcn_s_barrier(); asm volatile("" ::: "memory");
        bf16x8 Vf[2];
#pragma unroll
        for (int ks2 = 0; ks2 < 2; ++ks2) Vf[ks2] = *(const LAS bf16x8*)(lds + HG_VT + (16 * w + r16) * 144 + 64 * ks2 + 16 * q4);
        f32x4 oacc[4]; int orow[4][4];
#pragma unroll
        for (int ti = 0; ti < 4; ++ti) oacc[ti] = (f32x4){0.f, 0.f, 0.f, 0.f};
        if (outp) {
            bf16x8 Af[4], Bf[2][4];
#pragma unroll
            for (int ks = 0; ks < 4; ++ks) Af[ks] = *(const LAS bf16x8*)(lds + HG_KS + (16 * (w >> 1) + r16) * 272 + 64 * ks + 16 * q4);
#pragma unroll
            for (int tsel = 0; tsel < 2; ++tsel) { const int ti = 2 * (w & 1) + tsel;
#pragma unroll
                for (int ks = 0; ks < 4; ++ks) Bf[tsel][ks] = *(const LAS bf16x8*)(lds + HG_QS + (16 * ti + r16) * 272 + 64 * ks + 16 * q4); }
#pragma unroll
            for (int ti = 0; ti < 4; ++ti) { typedef int i32x4 __attribute__((ext_vector_type(4))); const i32x4 rr = *(const LAS i32x4*)(ROWS + 16 * ti + 4 * q4);
                orow[ti][0] = rr.x; orow[ti][1] = rr.y; orow[ti][2] = rr.z; orow[ti][3] = rr.w; }
#pragma unroll
            for (int tsel = 0; tsel < 2; ++tsel) { const int idx = 2 * w + tsel, si = idx >> 2, ti = idx & 3;
                f32x4 dacc = (f32x4){0.f, 0.f, 0.f, 0.f};
#pragma unroll
                for (int ks = 0; ks < 4; ++ks) dacc = __builtin_amdgcn_mfma_f32_16x16x32_bf16(Af[ks], Bf[tsel][ks], dacc, 0, 0, 0);
                const int t = 16 * ti + r16, s0 = 16 * si + 4 * q4;
#pragma unroll
                for (int j = 0; j < 4; ++j) if (s0 + j > t) dacc[j] = 0.f;
                v2u pw; pw.x = cvt_pk_bf16(dacc[0], dacc[1]); pw.y = cvt_pk_bf16(dacc[2], dacc[3]);
                *(LAS v2u*)(lds + HG_P + t * 144 + 2 * s0) = pw; }
            v2u alo[4][4], ahi[4][4]; f32x4 er[8];
#pragma unroll
            for (int kt = 0; kt < 8; ++kt) er[kt] = *(const LAS f32x4*)(EREF + 16 * kt + 4 * q4);
#pragma unroll
            for (int ks = 0; ks < 4; ++ks)
#pragma unroll
                for (int ti = 0; ti < 4; ++ti) { alo[ks][ti] = *(const LAS v2u*)(lds + HG_QS + (16 * ti + r16) * 272 + 64 * ks + 8 * q4);
                    ahi[ks][ti] = *(const LAS v2u*)(lds + HG_QS + (16 * ti + r16) * 272 + 64 * ks + 32 + 8 * q4); }
#pragma unroll
            for (int ks = 0; ks < 4; ++ks) { const f32x4 s0 = S[2 * ks] * er[2 * ks], s1 = S[2 * ks + 1] * er[2 * ks + 1];
                v4u sw; sw.x = cvt_pk_bf16(s0[0], s0[1]); sw.y = cvt_pk_bf16(s0[2], s0[3]); sw.z = cvt_pk_bf16(s1[0], s1[1]); sw.w = cvt_pk_bf16(s1[2], s1[3]);
                const bf16x8 Sf = __builtin_bit_cast(bf16x8, sw);
#pragma unroll
                for (int ti = 0; ti < 4; ++ti) { v4u aw; aw.x = alo[ks][ti].x; aw.y = alo[ks][ti].y; aw.z = ahi[ks][ti].x; aw.w = ahi[ks][ti].y;
                    oacc[ti] = __builtin_amdgcn_mfma_f32_16x16x32_bf16(__builtin_bit_cast(bf16x8, aw), Sf, oacc[ti], 0, 0, 0); } }
        }
        { bf16x8 Kf[8][2]; f32x4 dc[8];
#pragma unroll
          for (int kt = 0; kt < 8; ++kt) { dc[kt] = *(const LAS f32x4*)(DEC + 16 * kt + 4 * q4);
#pragma unroll
              for (int ks2 = 0; ks2 < 2; ++ks2) Kf[kt][ks2] = *(const LAS bf16x8*)(lds + HG_K2T + (16 * kt + r16) * 144 + 64 * ks2 + 16 * q4); }
#pragma unroll
          for (int kt = 0; kt < 8; ++kt) { S[kt] = S[kt] * dc[kt];
#pragma unroll
              for (int ks2 = 0; ks2 < 2; ++ks2) S[kt] = __builtin_amdgcn_mfma_f32_16x16x32_bf16(Kf[kt][ks2], Vf[ks2], S[kt], 0, 0, 0); } }
        if (c + 1 < NCHUNK) { float s0 = 0.f, s1 = 0.f;
#pragma unroll
            for (int i = 0; i < 8; ++i) { s0 += lf[i].x; s1 += lf[i].y; }
            *(LAS f32x2*)(TOT + ((c + 1) & 1) * 1024 + tq * 128 + 2 * kp) = (f32x2){s0, s1}; }
        LDS_WAIT(); __builtin_amdgcn_s_barrier(); asm volatile("" ::: "memory");
        if (outp) {
            bf16x8 Pf[4][2];
#pragma unroll
            for (int ti = 0; ti < 4; ++ti)
#pragma unroll
                for (int ks2 = 0; ks2 < 2; ++ks2) Pf[ti][ks2] = *(const LAS bf16x8*)(lds + HG_P + (16 * ti + r16) * 144 + 64 * ks2 + 16 * q4);
#pragma unroll
            for (int ti = 0; ti < 4; ++ti)
#pragma unroll
                for (int ks2 = 0; ks2 < 2; ++ks2) oacc[ti] = __builtin_amdgcn_mfma_f32_16x16x32_bf16(Pf[ti][ks2], Vf[ks2], oacc[ti], 0, 0, 0);
#pragma unroll
            for (int ti = 0; ti < 4; ++ti)
#pragma unroll
                for (int j = 0; j < 4; ++j) O[(size_t)orow[ti][j] * D_B + colb + 16 * w + r16] = (bf16)(cvt_pk_bf16(oacc[ti][j], 0.f) & 0xffffu);
        }
    }
    LDS_WAIT(); __builtin_amdgcn_s_barrier(); asm volatile("" ::: "memory");
}
__device__ __forceinline__ void hg_finalize_row(int lr, const bf16* OHG, const bf16* OG, const float* gn, bf16* YB, int lane) {
    const int row = (lr >> 11) * RPB + CTX_LEN + (lr & 2047);
    const size_t o = (size_t)row * D_B + 2 * lane;
    unsigned a[16], bq[16], og[16];
#pragma unroll
    for (int h = 0; h < 16; ++h) { a[h] = *(const GAS unsigned*)(OHG + o + h * 128); bq[h] = *(const GAS unsigned*)(OHG + (size_t)RT * D_B + o + h * 128); og[h] = *(const GAS unsigned*)(OG + o + h * 128); }
#pragma unroll
    for (int h = 0; h < 16; ++h) { const float o0 = bf_lo(a[h]) + bf_lo(bq[h]), o1 = bf_hi(a[h]) + bf_hi(bq[h]);
        const float r = 1.0f / sqrtf(wave_sum(o0 * o0 + o1 * o1) * (1.f / 128.f) + EPS);
        const f32x2 g = *(const GAS f32x2*)(gn + h * 128 + 2 * lane);
        *(GAS unsigned*)(YB + (size_t)row * pg8::DY + 2 * lane + h * 128) = cvt_pk_bf16(o0 * r * g.x * silu_f(bf_lo(og[h])), o1 * r * g.y * silu_f(bf_hi(og[h])));
    }
}

constexpr int ITB_WIN = 3 * IT_FF, ITB_GLU = ITB_WIN + IT_WIN, ITB_FF2 = ITB_GLU + IT_GLU + IT_PA + IT_PB + IT_OUT;
constexpr int TAIL2_ITEMS = 30912, TAIL5_ITEMS = 3000;
constexpr int CONV6_ITEMS = 24000;
constexpr int P0_HOLE = ITB_WIN, P0_ITEMS = T_ITEMS - IT_FF - TAIL2_ITEMS - CONV6_ITEMS;
static_assert(ITB_FF2 + 3 * IT_FF == T_ITEMS, "item list");
__device__ __forceinline__ ItemDesc item_desc(const Args& args, unsigned char* ws, int it) {
    int r = it;
    if (r < IT_FF) return make_item(args.in[I_W1A], D_MODEL, D_FF, (bf16*)(ws + WS_W13A), 1, r); r -= IT_FF;
    if (r < IT_FF) return make_item(args.in[I_W3A], D_MODEL, D_FF, (bf16*)(ws + WS_W13A), 2, r); r -= IT_FF;
    if (r < IT_FF) return make_item(args.in[I_W2A], D_FF, D_MODEL, (bf16*)(ws + WS_W2A), 0, r, D_FFP); r -= IT_FF;
    if (r < IT_WIN) return make_item(args.in[I_WIN], D_MODEL, N_IN, (bf16*)(ws + WS_WIN), 3, r); r -= IT_WIN;
    if (r < IT_GLU) return make_item(args.in[I_WGLU], D_A, D_A, (bf16*)(ws + WS_WGLU), 0, r); r -= IT_GLU;
    if (r < IT_PA) return make_item(args.in[I_WPA], D_A, D_MODEL, (bf16*)(ws + WS_WP) + D_B, 0, r, pg8::DY); r -= IT_PA;
    if (r < IT_PB) return make_item(args.in[I_WPB], D_B, D_MODEL, (bf16*)(ws + WS_WP), 0, r, pg8::DY); r -= IT_PB;
    if (r < IT_OUT) return make_item(args.in[I_WOUT], D_MODEL, D_MODEL, (bf16*)(ws + WS_WOUT), 0, r); r -= IT_OUT;
    if (r < IT_FF) return make_item(args.in[I_W1B], D_MODEL, D_FF, (bf16*)(ws + WS_W13B), 1, r); r -= IT_FF;
    if (r < IT_FF) return make_item(args.in[I_W3B], D_MODEL, D_FF, (bf16*)(ws + WS_W13B), 2, r); r -= IT_FF;
    return make_item(args.in[I_W2B], D_FF, D_MODEL, (bf16*)(ws + WS_W2B), 0, r, D_FFP);
}
__device__ __forceinline__ void convert_range(const Args& args, unsigned char* ws, int first, int end, int step, LAS float* s, int lane, int hole_at = 0x7fffffff, int hole_len = 0) {
    if (first >= end) return;
    ItemDesc d0 = item_desc(args, ws, first < hole_at ? first : first + hole_len); f32x4 va[8]; item_load(d0, va, lane);
    for (int it = first; it < end; it += step) {
        const int nx = it + step; ItemDesc d1 = d0; f32x4 vb[8];
        if (nx < end) { d1 = item_desc(args, ws, nx < hole_at ? nx : nx + hole_len); item_load(d1, vb, lane); }
        else {
#pragma unroll
            for (int i = 0; i < 8; ++i) vb[i] = va[i]; }
        item_store(d0, va, s, lane);
        d0 = d1;
#pragma unroll
        for (int i = 0; i < 8; ++i) va[i] = vb[i];
    }
}
__device__ __forceinline__ void tail_convert(const Args& args, unsigned char* ws, int begin, int end, int first_block, int G, int bx, int wave, LAS float* s) {
    int tl = threadIdx.x; asm volatile("" : "+v"(tl));
    if (first_block >= G) { convert_range(args, ws, begin + bx * NWAVES + wave, end, G * NWAVES, s, tl & 63); return; }
    if (bx < first_block) return;
    convert_range(args, ws, begin + (bx - first_block) * NWAVES + wave, end, (G - first_block) * NWAVES, s, tl & 63);
}

__global__ void __launch_bounds__(NWAVES * 64, 2) fwd_kernel(Args args) {
    extern __shared__ __attribute__((aligned(16))) unsigned char lds_raw[];
    LAS unsigned char* lds = (LAS unsigned char*)lds_raw;
    volatile LAS unsigned* MISC = (volatile LAS unsigned*)(lds + MISC_OFF);
    const int tid = threadIdx.x, wave = __builtin_amdgcn_readfirstlane(tid >> 6);
#define PHASE_LANE() int tidp = threadIdx.x; asm volatile("" : "+v"(tidp)); const int lane = tidp & 63; (void)lane
    const int G = gridDim.x, bx = blockIdx.x;
    const int vcu = (G % 8 == 0) ? (bx % 8) * (G / 8) + bx / 8 : bx;
    const int gw = vcu * NWAVES + wave, NGW = G * NWAVES;
    unsigned char* ws = args.ws;
    gu32* ctl = (gu32*)(ws + WS_CTL);
    for (int u = tid; u < (LDS_BYTES - LDSCTL_OFF) / 4; u += NWAVES * 64) ((LAS unsigned*)(lds + LDSCTL_OFF))[u] = 0u;
    __syncthreads();
    XcdBarrier bar = xcd_barrier_post((unsigned*)(ctl + CW_BAR), MISC + 8);
    LAS unsigned char* scr = lds + RING_OFF + wave * 16384;

    float* MODP = (float*)(ws + WS_MODP); float* MOD = (float*)(ws + WS_MOD); float* TAB = (float*)(ws + WS_TAB); float* LBT = (float*)(ws + WS_TAB + 512 * 1024);
    bf16* W13A = (bf16*)(ws + WS_W13A); bf16* W2A = (bf16*)(ws + WS_W2A); bf16* WIN = (bf16*)(ws + WS_WIN); bf16* WGLU = (bf16*)(ws + WS_WGLU); bf16* WPA = (bf16*)(ws + WS_WPA);
    bf16* WPB = (bf16*)(ws + WS_WPB); bf16* WOUT = (bf16*)(ws + WS_WOUT); bf16* W13B = (bf16*)(ws + WS_W13B); bf16* W2B = (bf16*)(ws + WS_W2B);
    bf16* ZN = (bf16*)(ws + WS_ZN); bf16* HID = (bf16*)(ws + WS_HID); pg8::h16_t* HB = (pg8::h16_t*)(ws + WS_H); pg8::h16_t* UA = (pg8::h16_t*)(ws + WS_UA);
    bf16* QB_ = (bf16*)(ws + WS_Q); bf16* VB_ = (bf16*)(ws + WS_V); bf16* OGB = (bf16*)(ws + WS_OG); pg8::h16_t* LFF = (pg8::h16_t*)(ws + WS_LFF); pg8::h16_t* LFB = (pg8::h16_t*)(ws + WS_LFB);
    bf16* SGA = (bf16*)(ws + WS_SGA); bf16* SGB = (bf16*)(ws + WS_SGB); float* XEND = (float*)(ws + WS_XEND); bf16* GA = (bf16*)(ws + WS_GA); bf16* YY = (bf16*)(ws + WS_Y); bf16* WP = (bf16*)(ws + WS_WP);
    bf16* OHG = (bf16*)(ws + WS_OHG); float* PT = (float*)(ws + WS_PT); bf16* MRG = (bf16*)(ws + WS_MRG);

    {
        PHASE_LANE();
        for (int idx = bx * (NWAVES * 64) + tidp; idx < 8192 + 4096; idx += G * NWAVES * 64) {
            if (idx < 8192) s5_table_entry(args.in[I_LAMRE], args.in[I_LAMIM], args.in[I_LOGDT], TAB, idx);
            else { const int j = idx - 8192, d = j >> 11, cc = j & 2047; const float l0 = args.in[I_LBLOG][(d * 2 + 0) * D_B + cc], l1 = args.in[I_LBLOG][(d * 2 + 1) * D_B + cc]; LBT[j] = 1.0f / (1.0f + expf(l1 - l0)); }
        }
        if (NGW > ADA_TASKS) {
            int per = (P0_ITEMS + ADA_TASKS * 64 + NGW - 1) / NGW; if (per < 64) per = 64;
            const int a = per - 64, s1 = (a * NGW < P0_ITEMS) ? a * NGW : P0_ITEMS;
            convert_range(args, ws, gw, s1, NGW, (LAS float*)scr, lane, P0_HOLE, TAIL2_ITEMS);
            if (gw < ADA_TASKS) p0_ada_task(args.in[I_C], args.in[I_CCTX], args.in[I_WADA], MODP, gw, (LAS float*)scr, lane);
            else convert_range(args, ws, s1 + (gw - ADA_TASKS), P0_ITEMS, NGW - ADA_TASKS, (LAS float*)scr, lane, P0_HOLE, TAIL2_ITEMS);
        } else {
            for (int t = gw; t < ADA_TASKS; t += NGW) p0_ada_task(args.in[I_C], args.in[I_CCTX], args.in[I_WADA], MODP, t, (LAS float*)scr, lane);
            convert_range(args, ws, gw, P0_ITEMS, NGW, (LAS float*)scr, lane, P0_HOLE, TAIL2_ITEMS);
        }
    }
    xcd_barrier(bar);
    { PHASE_LANE();
    for (int idx = bx * (NWAVES * 64) + tidp; idx < 5 * NMODC_; idx += G * NWAVES * 64) {
        float s = args.in[I_BADA][idx % NMODC_];
#pragma unroll
        for (int k = 0; k < ADA_KS; ++k) s += MODP[(size_t)k * 5 * NMODC_ + idx];
        MOD[idx] = s;
    } }
    xcd_barrier(bar);
    { PHASE_LANE();
    for (int m = gw; m < RT; m += NGW) { const int b = m / RPB, t = m - b * RPB; const bool isctx = t < CTX_LEN;
        const float* src = isctx ? args.in[I_CTX] + ((size_t)b * CTX_LEN + t) * D_MODEL : args.in[I_X] + ((size_t)b * SEQ + (t - CTX_LEN)) * D_MODEL;
        const float* mv = MOD + (size_t)(isctx ? 4 : b) * NMODC_;
        norm_mod_row(src, args.in[I_NORM1], mv + 0 * D_MODEL, mv + 1 * D_MODEL, ZN + (size_t)m * D_MODEL, lane); } }
    xcd_barrier(bar);
    { pg8::Gemm g{ZN, W13A, RT, 2 * D_FF, D_MODEL}; pg8::TileOrder S; S.init(36, 86, G, bx, 0); pg8::EpiSwiGLU E{HID, D_FFP};
      pg8::gemm_phase<pg8::EpiSwiGLU, pg8::TileOrder, true, true>(lds + RING_OFF, g, S, E); }
    tail_convert(args, ws, ITB_WIN, ITB_WIN + TAIL2_ITEMS, (36 * 86) % 256, G, bx, wave, (LAS float*)scr);
    xcd_barrier(bar);
    { pg8::Gemm g{HID, W2A, RT, D_MODEL, D_FF, D_FFP}; pg8::DownSplitOrder S; S.init(G, bx); pg8::EpiDown1 E{{args.in[I_X], args.in[I_CTX], HB, nullptr, MOD, 2, 0.5f}, (pg8::h16_t*)PT};
      pg8::gemm_phase<pg8::EpiDown1, pg8::DownSplitOrder, true, true>(lds + RING_OFF, g, S, E); }
    xcd_barrier(bar);
    { PHASE_LANE();
    for (int m = gw; m < RT; m += NGW) { const int b = m / RPB, t = m - b * RPB; const bool isctx = t < CTX_LEN;
        const float* mv = MOD + (size_t)(isctx ? 4 : b) * NMODC_;
        int ln = lane; asm volatile("" : "+v"(ln));
        if (isctx) norm_mod_row_part(args.in[I_CTX] + ((size_t)b * CTX_LEN + t) * D_MODEL, (const pg8::h16_t*)PT + ((size_t)b * CTX_LEN + t) * D_MODEL, mv + 2 * D_MODEL, args.in[I_NORMMIX], mv + 3 * D_MODEL, mv + 4 * D_MODEL, ZN + (size_t)m * D_MODEL, ln);
        else norm_mod_row_h(HB + (size_t)m * D_MODEL, args.in[I_NORMMIX], mv + 3 * D_MODEL, mv + 4 * D_MODEL, ZN + (size_t)m * D_MODEL, ln);
    } }
    xcd_barrier(bar);
    { pg8::Gemm g{ZN, WIN, RT, N_IN, D_MODEL}; pg8::TileOrder2 S; S.init(28, 48, G, bx); pg8::EpiWin E{UA, QB_, LFF, SGA, LBT};
      pg8::gemm_phase<pg8::EpiWin, pg8::TileOrder2, true, true>(lds + RING_OFF, g, S, E); }
    tail_convert(args, ws, T_ITEMS - IT_FF, T_ITEMS - IT_FF + TAIL5_ITEMS, (36 * 28 + 32 * 48) % 256, G, bx, wave, (LAS float*)scr);
    xcd_barrier(bar);
    { PHASE_LANE();
      constexpr int NTA = BATCH * 2 * S5_G * NCHUNK, NTC = BATCH * S5_G * 32;
      const bool hgblk = (G > 128) && (bx < 128);
      const unsigned nprod = (G > 128) ? (unsigned)(G - 128) : (unsigned)G;
      for (int u = bx; u < 128; u += G) hgrn2_unit(lds + RING_OFF, u, QB_, VB_, LFF, LFB, OHG, tidp);
      if (!hgblk) {
          for (;;) {
              int base = 0; if (lane == 0) base = (int)__hip_atomic_fetch_add((unsigned*)(ctl + CW_QUEUE), 4u, RLX_AGENT);
              base = __builtin_amdgcn_readfirstlane(base);
              if (base >= NTA) break;
#pragma unroll 1
              for (int t = base; t < base + 4; ++t) s5_pass_a(scr, t, TAB, args.in[I_BRE], args.in[I_BIM], UA, XEND, lane);
          }
          asm volatile("s_waitcnt vmcnt(0)" ::: "memory");
          __syncthreads();
          if (tidp == 0) (void)__hip_atomic_fetch_add((unsigned*)(ctl + CW_DONE), 1u, RLX_AGENT);
      }
      if (tidp == 0) { unsigned sp = 0;
          while (__hip_atomic_load((unsigned*)(ctl + CW_DONE), RLX_AGENT) < nprod) { __builtin_amdgcn_s_sleep(8);
              if ((++sp & 255u) == 0u) { if (xb_ld((unsigned*)(ctl + CW_BAR) + XB_TMO)) break; if (sp > (1u << 20)) { atomicAdd((unsigned*)(ctl + CW_BAR) + XB_TMO, 1u); break; } } }
          __builtin_amdgcn_fence(__ATOMIC_ACQUIRE, "agent");
          asm volatile("s_waitcnt vmcnt(0)" ::: "memory"); }
      __syncthreads();
      for (;;) {
          int base = 0; if (lane == 0) base = (int)__hip_atomic_fetch_add((unsigned*)(ctl + CW_QUEUE2), 2u, RLX_AGENT);
          base = __builtin_amdgcn_readfirstlane(base);
          if (base >= NTC) break;
#pragma unroll 1
          for (int t = base; t < base + 2; ++t) s5_pass_c(scr, t, TAB, args.in[I_BRE], args.in[I_BIM], args.in[I_CRE], args.in[I_CIM], args.in[I_S5D], UA, XEND, GA, lane);
      }
      for (;;) {
          int base = 0; if (lane == 0) base = (int)__hip_atomic_fetch_add((unsigned*)(ctl + CW_QUEUE3), 8u, RLX_AGENT);
          base = __builtin_amdgcn_readfirstlane(base);
          if (base >= CONV6_ITEMS) break;
          const int i0 = T_ITEMS - IT_FF - CONV6_ITEMS + base;
          convert_range(args, ws, i0, i0 + 8, 1, (LAS float*)scr, lane);
      }
    }
    xcd_barrier(bar);
    const bool glu_split = (G == 256);
    if (glu_split && bx < 128) {
      pg8::Gemm g{GA, WGLU, RT, D_A, D_A}; pg8::TileOrder S; S.init(32, 4, 128, bx, 1); pg8::EpiGlu E{GA, YY + D_B};
      pg8::gemm_phase<pg8::EpiGlu, pg8::TileOrder, true, true>(lds + RING_OFF, g, S, E);
    } else { PHASE_LANE();
    const int gw7 = glu_split ? (bx - 128) * NWAVES + wave : gw, ngw7 = glu_split ? NGW - 128 * NWAVES : NGW;
    for (int t = gw7; t < BATCH * SEQ; t += ngw7) hg_finalize_row(t, OHG, OGB, args.in[I_HGNORM], YY, lane);
    }
    xcd_barrier(bar);
    if (!glu_split) { pg8::Gemm g{GA, WGLU, RT, D_A, D_A}; pg8::TileOrder S; S.init(32, 4, G, bx, 1); pg8::EpiGlu E{GA, YY + D_B};
      pg8::gemm_phase<pg8::EpiGlu, pg8::TileOrder, true, true>(lds + RING_OFF, g, S, E); xcd_barrier(bar); }
    { pg8::Gemm g{YY, WP, RT, D_MODEL, D_B + D_A}; pg8::TileOrder S; S.init(32, 16, G, bx, 1); pg8::EpiMerge E{SGA, SGB, MRG};
      pg8::gemm_phase<pg8::EpiMerge, pg8::TileOrder, true, true>(lds + RING_OFF, g, S, E); }
    xcd_barrier(bar);
    { pg8::Gemm g{MRG, WOUT, RT, D_MODEL, D_MODEL}; pg8::TileOrder S; S.init(32, 16, G, bx, 1); pg8::EpiResid<1, 0> E{nullptr, nullptr, HB, nullptr, MOD, 5, 1.0f};
      pg8::gemm_phase<pg8::EpiResid<1, 0>, pg8::TileOrder, true, true>(lds + RING_OFF, g, S, E); }
    xcd_barrier(bar);
    { PHASE_LANE();
    for (int lr = gw; lr < BATCH * SEQ; lr += NGW) { const int b = lr >> 11, m = b * RPB + CTX_LEN + (lr & 2047);
        const float* mv = MOD + (size_t)b * NMODC_;
        norm_mod_row_h(HB + (size_t)m * D_MODEL, args.in[I_NORM2], mv + 6 * D_MODEL, mv + 7 * D_MODEL, ZN + (size_t)m * D_MODEL, lane); } }
    xcd_barrier(bar);
    { pg8::Gemm g{ZN, W13B, RT, 2 * D_FF, D_MODEL}; pg8::TileOrder S; S.init(32, 86, G, bx, 1); pg8::EpiSwiGLU E{HID, D_FFP};
      pg8::gemm_phase<pg8::EpiSwiGLU, pg8::TileOrder, true, true>(lds + RING_OFF, g, S, E); }
    tail_convert(args, ws, T_ITEMS - IT_FF + TAIL5_ITEMS, T_ITEMS, (32 * 86) % 256, G, bx, wave, (LAS float*)scr);
    xcd_barrier(bar);
    if (G == 256) {
      typedef pg8::EpiFinalNorm<WS_H, WS_MOD, WS_YA  , WS_CTL + (size_t)CW_PANEL * 4, WS_CTL + (size_t)(CW_BAR + XB_TMO) * 4> EpiFN;
      { pg8::Gemm g{HID, W2B, RT, D_MODEL, D_FF, D_FFP}; pg8::HalfRowsOrder S; S.init(G, bx);
        EpiFN E{ws, args.out, args.in[I_NORMF], lds + LDSCTL_OFF + 4096};
        pg8::gemm_phase<EpiFN, pg8::HalfRowsOrder, true, true>(lds + RING_OFF, g, S, E); }
      return;
    }
    { pg8::Gemm g{HID, W2B, RT, D_MODEL, D_FF, D_FFP}; pg8::HalfRowsOrder S; S.init(G, bx); pg8::EpiResid<1, 0> E{nullptr, nullptr, HB, nullptr, MOD, 8, 0.5f};
      pg8::gemm_phase<pg8::EpiResid<1, 0>, pg8::HalfRowsOrder, true, true>(lds + RING_OFF, g, S, E); }
    xcd_barrier(bar);
    { PHASE_LANE();
    const bool tmo_set = __hip_atomic_load((unsigned*)(ctl + CW_BAR) + XB_TMO, RLX_AGENT) != 0u;
    for (int lr = gw; lr < BATCH * SEQ; lr += NGW) { norm_final_row_h(HB + ((size_t)(lr >> 11) * RPB + CTX_LEN + (lr & 2047)) * D_MODEL, args.out + (size_t)lr * D_MODEL, args.in[I_NORMF], lane);
        if (tmo_set) { GAS f32x4* xr = (GAS f32x4*)(args.out + (size_t)lr * D_MODEL) + lane;
#pragma unroll
            for (int j = 0; j < 16; ++j) xr[64 * j] = (f32x4){1e30f, 1e30f, 1e30f, 1e30f}; } } }
}

extern "C" void kernel_launch(void* const* d_in, const int* in_sizes, int n_in, void* d_out, int out_size, void* d_ws, size_t ws_size, hipStream_t stream) {
    static int grid = 0;
    if (grid == 0) {
        if (n_in != 31 || out_size != BATCH * SEQ * D_MODEL || ws_size < WS_END) { fprintf(stderr, "kernel_launch: unexpected shapes (n_in %d, out %d, ws %zu)\n", n_in, out_size, ws_size); grid = -1; return; }
        int dev = 0, cus = 0, per_cu = 0;
        if (hipGetDevice(&dev) != hipSuccess || hipDeviceGetAttribute(&cus, hipDeviceAttributeMultiprocessorCount, dev) != hipSuccess) { grid = -1; return; }
        if (hipFuncSetAttribute((const void*)fwd_kernel, hipFuncAttributeMaxDynamicSharedMemorySize, LDS_BYTES) != hipSuccess) { fprintf(stderr, "kernel_launch: hipFuncSetAttribute failed\n"); grid = -1; return; }
        if (hipOccupancyMaxActiveBlocksPerMultiprocessor(&per_cu, (const void*)fwd_kernel, NWAVES * 64, LDS_BYTES) != hipSuccess || per_cu < 1)
            fprintf(stderr, "kernel_launch: note: occupancy query reports %d workgroups per CU\n", per_cu);
        (void)hipGetLastError();
        grid = cus;
    }
    if (grid < 0) return;
    if (hipMemsetAsync((char*)d_ws + WS_CTL, 0, CTL_ZERO_BYTES, stream) != hipSuccess) { fprintf(stderr, "kernel_launch: memset failed\n"); return; }
    Args a{};
    for (int i = 0; i < 31; ++i) a.in[i] = (const float*)d_in[i];
    a.out = (float*)d_out; a.ws = (unsigned char*)d_ws;
    hipLaunchKernelGGL(fwd_kernel, dim3(grid), dim3(NWAVES * 64), LDS_BYTES, stream, a);
    const hipError_t le = hipPeekAtLastError();
    if (le != hipSuccess) fprintf(stderr, "kernel_launch: launch failed: %s\n", hipGetErrorName(le));
}
```

```cpp
#include <hip/hip_runtime.h>
#include <cstdio>
#include <cstdint>

namespace pg8 {
#define PG8_LAS __attribute__((address_space(3)))
typedef unsigned short bf16_t;
typedef short bf16x8 __attribute__((ext_vector_type(8)));
typedef float f32x4 __attribute__((ext_vector_type(4)));
typedef unsigned u32x4 __attribute__((ext_vector_type(4)));
constexpr int BM = 256, BK = 64, HALF = 128, HTB = HALF * BK * 2  , STAGE_BYTES = 8 * HTB, NXCD = 8, WGM = 8;

__host__ __device__ __forceinline__ int lds_byte(int r, int c) { const int st = (r >> 4) * 2 + (c >> 5), rr = r & 15, cc = c & 31, ob = rr * 64 + cc * 2; return st * 1024 + (ob ^ (((ob >> 9) & 1) << 5)); }
__host__ __device__ __forceinline__ void stage_rc(int b, int& R, int& C) { const int st = b / 1024, sb = b % 1024, swz = sb ^ (((sb >> 9) & 1) << 5); R = (st >> 1) * 16 + swz / 64; C = (st & 1) * 32 + (swz % 64) / 2; }
__host__ __device__ __forceinline__ int perm32(int rho) { const int n = rho >> 4, i = rho & 15; return 8 * (i >> 2) + 4 * n + (i & 3); }

struct Unit { int pm, pn; };
struct Gemm { const bf16_t* A; const bf16_t* Bt; int M, N, K, LD = 0; };

struct StaticOrder {
    static constexpr bool SPLITK = false;
    int nM, nN, nwg, G, c;
    __host__ __device__ void init(int M, int N, int G_, int c_) { nM = M / BM; nN = N / BM; nwg = nM * nN; G = G_; c = c_; }
    __host__ __device__ bool next(int i, Unit& u) const {
        const long L = (long)i * G + c; if (L >= nwg) return false;
        int wgid = (int)L; { const int q = nwg / NXCD, r = nwg % NXCD, xcd = wgid % NXCD, off = wgid / NXCD; wgid = (xcd < r ? xcd * (q + 1) : r * (q + 1) + (xcd - r) * q) + off; }
        const int nig = WGM * nN, gid = wgid / nig, fm = gid * WGM, gsz = (nM - fm) < WGM ? (nM - fm) : WGM;
        u.pm = fm + ((wgid % nig) % gsz); u.pn = (wgid % nig) / gsz; return true;
    }
    __device__ __forceinline__ void a_ready(const Unit&) const {}
    __device__ __forceinline__ void done(const Unit&) const {}
};


struct TileOrder2 {
    static constexpr bool SPLITK = false;
    int n1c, n2c, nwg1, nwg, G, c;
    __host__ __device__ void init(int n1c_, int n2c_, int G_, int c_) { n1c = n1c_; n2c = n2c_; nwg1 = 36 * n1c; nwg = nwg1 + 32 * n2c; G = G_; c = c_; }
    __host__ __device__ static void map(int L, int nM, int nN, int& pm, int& pn) {
        const int nwg = nM * nN; int wgid = L; { const int q = nwg / NXCD, r = nwg % NXCD, xcd = wgid % NXCD, off = wgid / NXCD; wgid = (xcd < r ? xcd * (q + 1) : r * (q + 1) + (xcd - r) * q) + off; }
        const int nig = WGM * nN, gid = wgid / nig, fm = gid * WGM, gsz = (nM - fm) < WGM ? (nM - fm) : WGM;
        pm = fm + ((wgid % nig) % gsz); pn = (wgid % nig) / gsz; }
    __host__ __device__ bool next(int i, Unit& u) const {
        const long L = (long)i * G + c; if (L >= nwg) return false;
        int pm, pn;
        if (L < nwg1) map((int)L, 36, n1c, pm, pn);
        else { map((int)L - nwg1, 32, n2c, pm, pn); pm = (pm >> 3) * 9 + 1 + (pm & 7); pn += n1c; }
        u.pm = pm; u.pn = pn; return true;
    }
    __device__ __forceinline__ void a_ready(const Unit&) const {}
    __device__ __forceinline__ void done(const Unit&) const {}
};
struct TileOrder {
    static constexpr bool SPLITK = false;
    int nM, nN, nwg, G, c, lat_only;
    __host__ __device__ void init(int nM_, int nN_, int G_, int c_, int lat_only_) { nM = nM_; nN = nN_; nwg = nM * nN; G = G_; c = c_; lat_only = lat_only_; }
    __host__ __device__ bool next(int i, Unit& u) const {
        const long L = (long)i * G + c; if (L >= nwg) return false;
        int wgid = (int)L; { const int q = nwg / NXCD, r = nwg % NXCD, xcd = wgid % NXCD, off = wgid / NXCD; wgid = (xcd < r ? xcd * (q + 1) : r * (q + 1) + (xcd - r) * q) + off; }
        const int nig = WGM * nN, gid = wgid / nig, fm = gid * WGM, gsz = (nM - fm) < WGM ? (nM - fm) : WGM;
        int pm = fm + ((wgid % nig) % gsz); u.pn = (wgid % nig) / gsz;
        if (lat_only) pm = (pm >> 3) * 9 + 1 + (pm & 7);
        u.pm = pm; return true;
    }
    __device__ __forceinline__ void a_ready(const Unit&) const {}
    __device__ __forceinline__ void done(const Unit&) const {}
};

struct HalfRowsOrder {
    static constexpr bool SPLITK = false, STAGGER = false;
    TileOrder fb; int G, c;
    __host__ __device__ void init(int G_, int c_) { fb.init(32, 16, G_, c_, 1); G = G_; c = c_; }
    __host__ __device__ bool next(int i, Unit& u) const {
        if (G != 256) return fb.next(i, u);
        if (i >= 2) return false;
        const int x = c & 7, j = c >> 3, pl = 16 * i + 4 * (x >> 1) + (j & 3);
        u.pm = (pl >> 3) * 9 + 1 + (pl & 7); u.pn = 8 * (x & 1) + (j >> 2); return true;
    }
    __device__ __forceinline__ void a_ready(const Unit&) const {}
    __device__ __forceinline__ void done(const Unit&) const {}
};
struct DownSplitOrder {
    static constexpr bool SPLITK = true;
    HalfRowsOrder lat; int G, c;
    __host__ __device__ void init(int G_, int c_) { lat.init(G_, c_); G = G_; c = c_; }
    __host__ __device__ bool next(int i, Unit& u) const {
        const long L = (long)i * G + c; if (L >= 512 + 256) return false;
        if (L < 512) return lat.next(i, u);
        const int idx = (int)L - 512;
        u.pm = 9 * (idx >> 6); u.pn = ((idx >> 2) & 15) | (((idx & 3) + 1) << 8); return true;
    }
    __host__ __device__ static int kt0(const Unit& u) { const int q = u.pn >> 8; return q == 0 ? 0 : (q - 1) * 44 - (q == 4 ? 2 : 0); }
    __host__ __device__ static int cnt(const Unit& u, int full) { const int q = u.pn >> 8; return q == 0 ? full : (q <= 2 ? 44 : 42); }
    __device__ __forceinline__ void a_ready(const Unit&) const {}
    __device__ __forceinline__ void done(const Unit&) const {}
};

typedef float f32x2_cv __attribute__((ext_vector_type(2)));
typedef __bf16 bf16x2_cv __attribute__((ext_vector_type(2)));
__device__ __forceinline__ unsigned cvt_pk_bf16(float lo, float hi) { const f32x2_cv v = {lo, hi}; const bf16x2_cv b = __builtin_convertvector(v, bf16x2_cv); return __builtin_bit_cast(unsigned, b); }
typedef _Float16 h16x2_cv __attribute__((ext_vector_type(2)));
typedef unsigned short h16_t;
__device__ __forceinline__ unsigned cvt_pk_f16(float lo, float hi) { const f32x2_cv v = {lo, hi}; const h16x2_cv h = __builtin_convertvector(v, h16x2_cv); return __builtin_bit_cast(unsigned, h); }
__device__ __forceinline__ f32x2_cv unpk_f16(unsigned w) { const h16x2_cv h = __builtin_bit_cast(h16x2_cv, w); return __builtin_convertvector(h, f32x2_cv); }
__device__ __forceinline__ float bf_lo(unsigned w) { return __uint_as_float(w << 16); }
__device__ __forceinline__ float bf_hi(unsigned w) { return __uint_as_float(w & 0xffff0000u); }
__device__ __forceinline__ float sigmoid_f(float x) { return __builtin_amdgcn_rcpf(1.0f + __builtin_amdgcn_exp2f(-1.4426950408889634f * x)); }
__device__ __forceinline__ float silu_f(float x) { return x * sigmoid_f(x); }

constexpr int TOK_ROWS = 9216, ROWS_PER_B = 2304, CTXR = 256, LATR = 2048, DM = 4096, NMODC = 36864, DY = 3072;


#define EPI_PIN(x) do { asm volatile("" : "+v"(x)); __builtin_amdgcn_sched_barrier(0); } while (0)
struct EpiSwiGLU {
    static constexpr bool PERM = true, AFTER_DRAIN = false;
    bf16_t* H; int ldh;
    __device__ __forceinline__ void operator()(const f32x4 (&acc)[2][2][4][2], const Unit& u, int wr, int wc, int fr, int fq) const {
        size_t off = (size_t)(u.pm * BM + wr * 64 + fr) * ldh + u.pn * HALF + wc * 32 + 8 * fq;
#pragma unroll
        for (int ai = 0; ai < 2; ++ai) {
#pragma unroll
            for (int m = 0; m < 4; ++m) { EPI_PIN(off);
                const f32x4 a0 = acc[ai][0][m][0], a1 = acc[ai][0][m][1], b0 = acc[ai][1][m][0], b1 = acc[ai][1][m][1];
                u32x4 w; w.x = cvt_pk_bf16(silu_f(a0[0]) * b0[0], silu_f(a0[1]) * b0[1]); w.y = cvt_pk_bf16(silu_f(a0[2]) * b0[2], silu_f(a0[3]) * b0[3]);
                w.z = cvt_pk_bf16(silu_f(a1[0]) * b1[0], silu_f(a1[1]) * b1[1]); w.w = cvt_pk_bf16(silu_f(a1[2]) * b1[2], silu_f(a1[3]) * b1[3]);
                *(u32x4*)(H + off) = w; off += (size_t)16 * ldh; }
            off += (size_t)64 * ldh; }
    }
};

template <int BASE_MODE, int OUT_MODE> struct EpiResid {
    static constexpr bool PERM = true, AFTER_DRAIN = false;
    const float* x; const float* ctx; h16_t* hbuf; float* dout; const float* mod; int mchunk; float coef;
    __device__ __forceinline__ void operator()(const f32x4 (&acc)[2][2][4][2], const Unit& u, int wr, int wc, int fr, int fq) const {
        const int b = u.pm / 9, tt = u.pm - 9 * b; const bool isctx = (tt == 0);
        const float* basep = nullptr; const h16_t* baseh = nullptr; float* outp = nullptr; h16_t* outh = nullptr;
        if (BASE_MODE == 0) basep = isctx ? ctx + (size_t)b * CTXR * DM : x + ((size_t)b * LATR + (size_t)(tt - 1) * BM) * DM; else baseh = hbuf + (size_t)u.pm * BM * DM;
        if (OUT_MODE == 0) outh = hbuf + (size_t)u.pm * BM * DM; else outp = dout + ((size_t)b * LATR + (size_t)(tt - 1) * BM) * DM;
        const float* mv = mod + (size_t)(isctx ? 4 : b) * NMODC + (size_t)mchunk * DM;
        const int col0 = u.pn * BM + wc * 32 + 8 * fq;
        f32x4 g[2][2];
#pragma unroll
        for (int bj = 0; bj < 2; ++bj)
#pragma unroll
            for (int n = 0; n < 2; ++n) g[bj][n] = *(const f32x4*)(mv + col0 + bj * HALF + 4 * n) * coef;
        const size_t off0 = (size_t)(wr * 64 + fr) * DM + col0;
        f32x4 bs[4][2][2][2]; u32x4 bh[4][2][2];
#define ERES_LOAD(bt) _Pragma("unroll") for (int mm = 0; mm < 2; ++mm) { const size_t o = off0 + (size_t)(((bt) >> 1) * HALF + (((bt) & 1) * 2 + mm) * 16) * DM; \
            _Pragma("unroll") for (int bj = 0; bj < 2; ++bj) { if constexpr (BASE_MODE == 0) { _Pragma("unroll") for (int n = 0; n < 2; ++n) bs[bt][mm][bj][n] = *(const f32x4*)(basep + o + bj * HALF + 4 * n); } \
                else bh[bt][mm][bj] = *(const u32x4*)(baseh + o + bj * HALF); } }
#define ERES_DONE(bt) _Pragma("unroll") for (int mm = 0; mm < 2; ++mm) { const size_t o = off0 + (size_t)(((bt) >> 1) * HALF + (((bt) & 1) * 2 + mm) * 16) * DM; \
            _Pragma("unroll") for (int bj = 0; bj < 2; ++bj) { f32x4 b0, b1; \
                if constexpr (BASE_MODE == 0) { b0 = bs[bt][mm][bj][0]; b1 = bs[bt][mm][bj][1]; } \
                else { const u32x4 w = bh[bt][mm][bj]; const f32x2_cv p0 = unpk_f16(w.x), p1 = unpk_f16(w.y), p2 = unpk_f16(w.z), p3 = unpk_f16(w.w); b0 = (f32x4){p0.x, p0.y, p1.x, p1.y}; b1 = (f32x4){p2.x, p2.y, p3.x, p3.y}; } \
                const f32x4 r0 = b0 + g[bj][0] * acc[(bt) >> 1][bj][((bt) & 1) * 2 + mm][0], r1 = b1 + g[bj][1] * acc[(bt) >> 1][bj][((bt) & 1) * 2 + mm][1]; \
                if constexpr (OUT_MODE == 0) { u32x4 w; w.x = cvt_pk_f16(r0[0], r0[1]); w.y = cvt_pk_f16(r0[2], r0[3]); w.z = cvt_pk_f16(r1[0], r1[1]); w.w = cvt_pk_f16(r1[2], r1[3]); *(u32x4*)(outh + o + bj * HALF) = w; } \
                else { *(f32x4*)(outp + o + bj * HALF) = r0; *(f32x4*)(outp + o + bj * HALF + 4) = r1; } } }
        ERES_LOAD(0) __builtin_amdgcn_sched_barrier(0);
        ERES_LOAD(1) __builtin_amdgcn_sched_barrier(0);
        ERES_DONE(0) __builtin_amdgcn_sched_barrier(0);
        ERES_LOAD(2) __builtin_amdgcn_sched_barrier(0);
        ERES_DONE(1) __builtin_amdgcn_sched_barrier(0);
        ERES_LOAD(3) __builtin_amdgcn_sched_barrier(0);
        ERES_DONE(2) __builtin_amdgcn_sched_barrier(0);
        ERES_DONE(3)
#undef ERES_LOAD
#undef ERES_DONE
    }
};

struct EpiDown1 {
    static constexpr bool PERM = true, AFTER_DRAIN = false;
    EpiResid<0, 0> R; h16_t* part;
    __device__ __forceinline__ void operator()(const f32x4 (&acc)[2][2][4][2], const Unit& u, int wr, int wc, int fr, int fq) const {
        const int q = u.pn >> 8;
        if (q == 0) { R(acc, u, wr, wc, fr, fq); return; }
        size_t off = ((size_t)(q - 1) * 1024 + (size_t)(u.pm / 9) * CTXR + wr * 64 + fr) * DM + (u.pn & 255) * BM + wc * 32 + 8 * fq;
#pragma unroll
        for (int ai = 0; ai < 2; ++ai) {
#pragma unroll
            for (int m = 0; m < 4; ++m) { EPI_PIN(off);
#pragma unroll
                for (int bj = 0; bj < 2; ++bj) { const f32x4 v0 = acc[ai][bj][m][0], v1 = acc[ai][bj][m][1];
                    u32x4 w; w.x = cvt_pk_f16(v0[0], v0[1]); w.y = cvt_pk_f16(v0[2], v0[3]); w.z = cvt_pk_f16(v1[0], v1[1]); w.w = cvt_pk_f16(v1[2], v1[3]);
                    *(u32x4*)(part + off + bj * HALF) = w; }
                off += (size_t)16 * DM; }
            off += (size_t)64 * DM; }
    }
};

struct EpiWin {
    static constexpr bool PERM = true, AFTER_DRAIN = false;
    h16_t* UA; bf16_t* Q; h16_t* LFF; bf16_t* SGA; const float* lbt;
    static constexpr size_t QSTRIDE = (size_t)36 * 1048576 / 2, LFSTRIDE = (size_t)72 * 1048576 / 2, SGSTRIDE = (size_t)72 * 1048576 / 2;
    __device__ __forceinline__ void operator()(const f32x4 (&acc)[2][2][4][2], const Unit& u, int wr, int wc, int fr, int fq) const {
        const int pn = u.pn, row0 = u.pm * BM + wr * 64 + fr, cl = wc * 32 + 8 * fq;
        if (pn < 4) {
            size_t off = (size_t)row0 * 1024 + pn * BM + cl;
#pragma unroll
            for (int ai = 0; ai < 2; ++ai) {
#pragma unroll
                for (int m = 0; m < 4; ++m) { EPI_PIN(off);
#pragma unroll
                    for (int bj = 0; bj < 2; ++bj) { const f32x4 v0 = acc[ai][bj][m][0], v1 = acc[ai][bj][m][1];
                        u32x4 w; w.x = cvt_pk_f16(v0[0], v0[1]); w.y = cvt_pk_f16(v0[2], v0[3]); w.z = cvt_pk_f16(v1[0], v1[1]); w.w = cvt_pk_f16(v1[2], v1[3]);
                        *(u32x4*)(UA + off + bj * HALF) = w; }
                    off += (size_t)16 * 1024; }
                off += (size_t)64 * 1024; }
        } else if (pn < 12 || (pn >= 28 && pn < 44)) {
            const int sel = (pn < 12) ? 1 : ((pn >= 36) ? 2 : 0), cb = (pn - (sel == 1 ? 4 : (sel == 2 ? 36 : 28))) * BM;
            size_t off = (size_t)sel * QSTRIDE + (size_t)row0 * 2048 + cb + cl;
#pragma unroll
            for (int ai = 0; ai < 2; ++ai) {
#pragma unroll
                for (int m = 0; m < 4; ++m) { EPI_PIN(off);
#pragma unroll
                    for (int bj = 0; bj < 2; ++bj) { const f32x4 v0 = acc[ai][bj][m][0], v1 = acc[ai][bj][m][1];
                        u32x4 w; w.x = cvt_pk_bf16(v0[0], v0[1]); w.y = cvt_pk_bf16(v0[2], v0[3]); w.z = cvt_pk_bf16(v1[0], v1[1]); w.w = cvt_pk_bf16(v1[2], v1[3]);
                        *(u32x4*)(Q + off + bj * HALF) = w; }
                    off += (size_t)16 * 2048; }
                off += (size_t)64 * 2048; }
        } else if (pn < 28) {
            const int dirb = (pn >= 20) ? 1 : 0, cb = (pn - (dirb ? 20 : 12)) * BM;
            const float* lb = lbt + dirb * 2048 + cb + cl;
            f32x4 l[2][2];
#pragma unroll
            for (int bj = 0; bj < 2; ++bj)
#pragma unroll
                for (int n = 0; n < 2; ++n) l[bj][n] = *(const f32x4*)(lb + bj * HALF + 4 * n);
            size_t off = (size_t)dirb * LFSTRIDE + (size_t)row0 * 2048 + cb + cl;
#pragma unroll
            for (int ai = 0; ai < 2; ++ai) {
#pragma unroll
                for (int m = 0; m < 4; ++m) { EPI_PIN(off);
#pragma unroll
                    for (int bj = 0; bj < 2; ++bj) { f32x4 o[2];
#pragma unroll
                        for (int n = 0; n < 2; ++n) { f32x4 a = acc[ai][bj][m][n]; asm volatile("" : "+v"(a));
#pragma unroll
                            for (int j = 0; j < 4; ++j) { const float lbv = l[bj][n][j]; o[n][j] = __logf(lbv + (1.0f - lbv) * sigmoid_f(a[j])); } }
                        u32x4 w; w.x = cvt_pk_f16(o[0][0], o[0][1]); w.y = cvt_pk_f16(o[0][2], o[0][3]); w.z = cvt_pk_f16(o[1][0], o[1][1]); w.w = cvt_pk_f16(o[1][2], o[1][3]);
                        *(u32x4*)(LFF + off + bj * HALF) = w; }
                    off += (size_t)16 * 2048; }
                off += (size_t)64 * 2048; }
        } else {
            size_t off = (size_t)row0 * DM + (pn - 44) * HALF + cl;
#pragma unroll
            for (int ai = 0; ai < 2; ++ai) {
#pragma unroll
                for (int m = 0; m < 4; ++m) { EPI_PIN(off);
                    const f32x4 a0 = acc[ai][0][m][0], a1 = acc[ai][0][m][1], b0 = acc[ai][1][m][0], b1 = acc[ai][1][m][1];
                    u32x4 wa; wa.x = cvt_pk_bf16(sigmoid_f(a0[0]), sigmoid_f(a0[1])); wa.y = cvt_pk_bf16(sigmoid_f(a0[2]), sigmoid_f(a0[3]));
                    wa.z = cvt_pk_bf16(sigmoid_f(a1[0]), sigmoid_f(a1[1])); wa.w = cvt_pk_bf16(sigmoid_f(a1[2]), sigmoid_f(a1[3]));
                    *(u32x4*)(SGA + off) = wa;
#define GRATIO(bv, gw_) (sigmoid_f(bv) * __builtin_amdgcn_rcpf(fmaxf(gw_, 1e-20f)))
                    u32x4 wb; wb.x = cvt_pk_bf16(GRATIO(b0[0], bf_lo(wa.x)), GRATIO(b0[1], bf_hi(wa.x))); wb.y = cvt_pk_bf16(GRATIO(b0[2], bf_lo(wa.y)), GRATIO(b0[3], bf_hi(wa.y)));
                    wb.z = cvt_pk_bf16(GRATIO(b1[0], bf_lo(wa.z)), GRATIO(b1[1], bf_hi(wa.z))); wb.w = cvt_pk_bf16(GRATIO(b1[2], bf_lo(wa.w)), GRATIO(b1[3], bf_hi(wa.w)));
#undef GRATIO
                    *(u32x4*)(SGA + SGSTRIDE + off) = wb;
                    off += (size_t)16 * DM; }
                off += (size_t)64 * DM; }
        }
    }
};

struct EpiGlu {
    static constexpr bool PERM = true, AFTER_DRAIN = false;
    const bf16_t* GA; bf16_t* YA;
    __device__ __forceinline__ void operator()(const f32x4 (&acc)[2][2][4][2], const Unit& u, int wr, int wc, int fr, int fq) const {
        size_t off = (size_t)(u.pm * BM + wr * 64 + fr) * 1024 + u.pn * BM + wc * 32 + 8 * fq, offy = (size_t)(u.pm * BM + wr * 64 + fr) * DY + u.pn * BM + wc * 32 + 8 * fq;
#pragma unroll
        for (int ai = 0; ai < 2; ++ai) {
#pragma unroll
            for (int m = 0; m < 4; ++m) { EPI_PIN(off); EPI_PIN(offy);
#pragma unroll
                for (int bj = 0; bj < 2; ++bj) { const size_t o = off + bj * HALF;
                    const u32x4 gq = *(const u32x4*)(GA + o); const f32x4 v0 = acc[ai][bj][m][0], v1 = acc[ai][bj][m][1];
                    u32x4 w; w.x = cvt_pk_bf16(bf_lo(gq.x) * sigmoid_f(v0[0]), bf_hi(gq.x) * sigmoid_f(v0[1])); w.y = cvt_pk_bf16(bf_lo(gq.y) * sigmoid_f(v0[2]), bf_hi(gq.y) * sigmoid_f(v0[3]));
                    w.z = cvt_pk_bf16(bf_lo(gq.z) * sigmoid_f(v1[0]), bf_hi(gq.z) * sigmoid_f(v1[1])); w.w = cvt_pk_bf16(bf_lo(gq.w) * sigmoid_f(v1[2]), bf_hi(gq.w) * sigmoid_f(v1[3]));
                    *(u32x4*)(YA + offy + bj * HALF) = w; }
                off += (size_t)16 * 1024; offy += (size_t)16 * DY; }
            off += (size_t)64 * 1024; offy += (size_t)64 * DY; }
    }
};

struct EpiMerge {
    static constexpr bool PERM = true, AFTER_DRAIN = false; static constexpr int MID_T = 32;
    const bf16_t* SGA; const bf16_t* SGB; bf16_t* MRG;
    __device__ __forceinline__ void mid(f32x4 (&acc)[2][2][4][2], const Unit& u, int wr, int wc, int fr, int fq) const {
        size_t off = (size_t)(u.pm * BM + wr * 64 + fr) * DM + u.pn * BM + wc * 32 + 8 * fq;
#pragma unroll
        for (int ai = 0; ai < 2; ++ai) {
#pragma unroll
            for (int m = 0; m < 4; ++m) { EPI_PIN(off);
#pragma unroll
                for (int bj = 0; bj < 2; ++bj) { const size_t o = off + bj * HALF;
                    const u32x4 rq = *(const u32x4*)(SGB + o);
                    f32x4 r0, r1; r0[0] = bf_lo(rq.x); r0[1] = bf_hi(rq.x); r0[2] = bf_lo(rq.y); r0[3] = bf_hi(rq.y); r1[0] = bf_lo(rq.z); r1[1] = bf_hi(rq.z); r1[2] = bf_lo(rq.w); r1[3] = bf_hi(rq.w);
                    acc[ai][bj][m][0] *= r0; acc[ai][bj][m][1] *= r1; }
                off += (size_t)16 * DM; }
            off += (size_t)64 * DM; }
    }
    __device__ __forceinline__ void operator()(const f32x4 (&acc)[2][2][4][2], const Unit& u, int wr, int wc, int fr, int fq) const {
        size_t off = (size_t)(u.pm * BM + wr * 64 + fr) * DM + u.pn * BM + wc * 32 + 8 * fq;
#pragma unroll
        for (int ai = 0; ai < 2; ++ai) {
#pragma unroll
            for (int m = 0; m < 4; ++m) { EPI_PIN(off);
#pragma unroll
                for (int bj = 0; bj < 2; ++bj) { const size_t o = off + bj * HALF;
                    const u32x4 ga = *(const u32x4*)(SGA + o);
                    const f32x4 v0 = acc[ai][bj][m][0], v1 = acc[ai][bj][m][1];
                    u32x4 w; w.x = cvt_pk_bf16(fmaxf(bf_lo(ga.x), 1e-20f) * v0[0], fmaxf(bf_hi(ga.x), 1e-20f) * v0[1]); w.y = cvt_pk_bf16(fmaxf(bf_lo(ga.y), 1e-20f) * v0[2], fmaxf(bf_hi(ga.y), 1e-20f) * v0[3]);
                    w.z = cvt_pk_bf16(fmaxf(bf_lo(ga.z), 1e-20f) * v1[0], fmaxf(bf_hi(ga.z), 1e-20f) * v1[1]); w.w = cvt_pk_bf16(fmaxf(bf_lo(ga.w), 1e-20f) * v1[2], fmaxf(bf_hi(ga.w), 1e-20f) * v1[3]);
                    *(u32x4*)(MRG + o) = w; }
                off += (size_t)16 * DM; }
            off += (size_t)64 * DM; }
    }
};
template <class E, class = void> struct HasMid { static constexpr bool value = false; };
template <class E> struct HasMid<E, decltype((void)E::MID_T)> { static constexpr bool value = true; };

template <class Epi, class Sched, bool ALIGN_EPI = false, bool SP2 = false>
__device__ __forceinline__ void gemm_phase(PG8_LAS unsigned char* lds, const Gemm g, const Sched& S, const Epi& E) {
    int tid_ = threadIdx.x; asm volatile("" : "+v"(tid_));
    const int tid = tid_, wid = __builtin_amdgcn_readfirstlane(tid >> 6), lane = tid & 63, wr = wid >> 2, wc = wid & 3, fr = lane & 15, fq = lane >> 4;
    const int K = g.K, nt = K / BK, LD = g.LD ? g.LD : g.K;
    unsigned voffA[2], voffB[2];
#pragma unroll
    for (int i = 0; i < 2; ++i) { int R, C; stage_rc(tid * 16 + i * 8192, R, C); const int Rb = Epi::PERM ? ((R & ~31) + perm32(R & 31)) : R;
        voffA[i] = (unsigned)(R * LD + C) * 2u; voffB[i] = (unsigned)(Rb * LD + C) * 2u; }
    const size_t kstep = (size_t)(BK * 2);
    const size_t hstep = (size_t)HALF * LD * 2;
    const size_t tstep = 2 * hstep;
    const unsigned ldsw = (unsigned)wid * 1024u;
    const int aoff = lds_byte(wr * 64 + fr, fq * 8), boff = lds_byte(wc * 32 + fr, fq * 8);
#define PG8_SA(b, h) (((b) * 2 + (h)) * HTB)
#define PG8_SB(b, h) ((4 + (b) * 2 + (h)) * HTB)
#define PG8_STAGE(bufoff, gbase, voff) do { _Pragma("unroll") for (int _i = 0; _i < 2; ++_i) \
        __builtin_amdgcn_global_load_lds((const unsigned*)((const char*)(gbase) + (voff)[_i]), (PG8_LAS unsigned*)(lds + (bufoff) + ldsw + _i * 8192), 16, 0, 0); } while (0)
#define PG8_LDA(dst, b, h) do { _Pragma("unroll") for (int m = 0; m < 4; ++m) _Pragma("unroll") for (int k = 0; k < 2; ++k) dst[m][k] = *(const PG8_LAS bf16x8*)(lds + PG8_SA(b, h) + aoff + m * 2048 + k * 1024); } while (0)
#define PG8_LDB(dst, b, h) do { _Pragma("unroll") for (int n = 0; n < 2; ++n) _Pragma("unroll") for (int k = 0; k < 2; ++k) dst[n][k] = *(const PG8_LAS bf16x8*)(lds + PG8_SB(b, h) + boff + n * 2048 + k * 1024); } while (0)
#define PG8_MMA(ai, bj, At, Bt) do { __builtin_amdgcn_s_setprio(1); _Pragma("unroll") for (int m = 0; m < 4; ++m) _Pragma("unroll") for (int n = 0; n < 2; ++n) _Pragma("unroll") for (int k = 0; k < 2; ++k) \
        acc[ai][bj][m][n] = __builtin_amdgcn_mfma_f32_16x16x32_bf16(Bt[n][k], At[m][k], acc[ai][bj][m][n], 0, 0, 0); __builtin_amdgcn_s_setprio(0); } while (0)
#define PG8_WAIT_V(n) asm volatile("s_waitcnt vmcnt(" #n ")" ::: "memory")
#define PG8_WAIT_L(n) asm volatile("s_waitcnt lgkmcnt(" #n ")" ::: "memory")
#define PG8_BAR __builtin_amdgcn_s_barrier()
#define PG8_SCHED __builtin_amdgcn_sched_barrier(0)
    Unit cur, nxt; int ui = 0;
    if (!S.next(0, cur)) return;
    f32x4 acc[2][2][4][2];
#pragma unroll
    for (int a = 0; a < 2; ++a)
#pragma unroll
        for (int b = 0; b < 2; ++b)
#pragma unroll
            for (int m = 0; m < 4; ++m)
#pragma unroll
                for (int n = 0; n < 2; ++n) acc[a][b][m][n] = (f32x4){0.f, 0.f, 0.f, 0.f};
    bf16x8 At[4][2], B0[2][2], B1[2][2];
    const char* cA = (const char*)g.A + (size_t)cur.pm * tstep; const char* cB;
    if constexpr (Sched::SPLITK) { cA += (size_t)Sched::kt0(cur) * kstep; cB = (const char*)g.Bt + (size_t)(cur.pn & 255) * tstep + (size_t)Sched::kt0(cur) * kstep; } else cB = (const char*)g.Bt + (size_t)cur.pn * tstep;
    S.a_ready(cur);
    if constexpr (SP2) {
        PG8_STAGE(PG8_SB(0, 0), cB, voffB); PG8_STAGE(PG8_SB(0, 1), cB + hstep, voffB); PG8_STAGE(PG8_SA(0, 0), cA, voffA); PG8_STAGE(PG8_SA(0, 1), cA + hstep, voffA);
        if (wr == 1) PG8_BAR;
        PG8_WAIT_V(2); PG8_BAR;
        PG8_STAGE(PG8_SB(1, 0), cB + kstep, voffB); PG8_STAGE(PG8_SA(1, 0), cA + kstep, voffA); PG8_STAGE(PG8_SB(1, 1), cB + hstep + kstep, voffB);
        PG8_WAIT_V(6); PG8_BAR;
    } else {
        PG8_STAGE(PG8_SB(0, 0), cB, voffB); PG8_STAGE(PG8_SA(0, 0), cA, voffA); PG8_STAGE(PG8_SB(0, 1), cB + hstep, voffB); PG8_STAGE(PG8_SA(0, 1), cA + hstep, voffA);
        if (wr == 1) PG8_BAR;
        PG8_WAIT_V(4); PG8_BAR;
        PG8_STAGE(PG8_SB(1, 0), cB + kstep, voffB); PG8_STAGE(PG8_SA(1, 0), cA + kstep, voffA); PG8_STAGE(PG8_SB(1, 1), cB + hstep + kstep, voffB);
        PG8_WAIT_V(6); PG8_BAR;
    }
    for (;;) {
        const bool has_next = S.next(ui + 1, nxt);
        const char* nA = cA; const char* nB = cB; int cnt = nt;
        if constexpr (Sched::SPLITK) { if (has_next) { nA = (const char*)g.A + (size_t)nxt.pm * tstep + (size_t)Sched::kt0(nxt) * kstep; nB = (const char*)g.Bt + (size_t)(nxt.pn & 255) * tstep + (size_t)Sched::kt0(nxt) * kstep; } cnt = Sched::cnt(cur, nt); }
        else { if (has_next) { nA = (const char*)g.A + (size_t)nxt.pm * tstep; nB = (const char*)g.Bt + (size_t)nxt.pn * tstep; } }
        for (int t = 0; t < cnt; t += 2) {
            if constexpr (HasMid<Epi>::value) { if (t == Epi::MID_T) E.mid(acc, cur, wr, wc, fr, fq); }
            const bool last = (t == cnt - 2);
            const char* a1 = cA + (size_t)(t + 1) * kstep;
            const char* a2 = last ? nA : cA + (size_t)(t + 2) * kstep; const char* b2 = last ? nB : cB + (size_t)(t + 2) * kstep;
            const char* a3 = a2 + kstep; const char* b3 = b2 + kstep;
            if (last && has_next) S.a_ready(nxt);
            if constexpr (SP2) {
            PG8_LDB(B0, 0, 0); PG8_LDB(B1, 0, 1); PG8_SCHED; PG8_LDA(At, 0, 0); PG8_STAGE(PG8_SA(1, 1), a1 + hstep, voffA);
            PG8_WAIT_V(8); PG8_WAIT_L(0); PG8_BAR; PG8_MMA(0, 0, At, B0); PG8_MMA(0, 1, At, B1); PG8_BAR; PG8_SCHED;
            PG8_LDA(At, 0, 1); PG8_STAGE(PG8_SB(0, 0), b2, voffB); PG8_STAGE(PG8_SB(0, 1), b2 + hstep, voffB); PG8_STAGE(PG8_SA(0, 0), a2, voffA);
            PG8_WAIT_V(8); PG8_WAIT_L(0); PG8_BAR; PG8_MMA(1, 0, At, B0); PG8_MMA(1, 1, At, B1); PG8_BAR; PG8_SCHED;
            PG8_LDB(B0, 1, 0); PG8_LDB(B1, 1, 1); PG8_SCHED; PG8_LDA(At, 1, 0); PG8_STAGE(PG8_SA(0, 1), a2 + hstep, voffA);
            PG8_WAIT_V(8); PG8_WAIT_L(0); PG8_BAR; PG8_MMA(0, 0, At, B0); PG8_MMA(0, 1, At, B1); PG8_BAR; PG8_SCHED;
            PG8_LDA(At, 1, 1); PG8_STAGE(PG8_SB(1, 0), b3, voffB); PG8_STAGE(PG8_SB(1, 1), b3 + hstep, voffB); PG8_STAGE(PG8_SA(1, 0), a3, voffA);
            PG8_WAIT_V(8); PG8_WAIT_L(0); PG8_BAR; PG8_MMA(1, 0, At, B0); PG8_MMA(1, 1, At, B1); PG8_BAR; PG8_SCHED;
            } else {
            PG8_LDB(B0, 0, 0); PG8_SCHED; PG8_LDA(At, 0, 0); PG8_STAGE(PG8_SA(1, 1), a1 + hstep, voffA);
            PG8_WAIT_L(8); PG8_BAR; PG8_WAIT_L(0); PG8_MMA(0, 0, At, B0); PG8_BAR; PG8_SCHED;
            PG8_LDB(B1, 0, 1); PG8_STAGE(PG8_SB(0, 0), b2, voffB);
            PG8_BAR; PG8_WAIT_L(0); PG8_MMA(0, 1, At, B1); PG8_BAR;
            PG8_LDA(At, 0, 1); PG8_STAGE(PG8_SA(0, 0), a2, voffA);
            PG8_BAR; PG8_WAIT_L(0); PG8_MMA(1, 0, At, B0); PG8_BAR; PG8_SCHED;
            PG8_STAGE(PG8_SB(0, 1), b2 + hstep, voffB);
            PG8_WAIT_V(6); PG8_BAR; PG8_MMA(1, 1, At, B1); PG8_BAR;
            PG8_LDB(B0, 1, 0); PG8_SCHED; PG8_LDA(At, 1, 0); PG8_STAGE(PG8_SA(0, 1), a2 + hstep, voffA);
            PG8_WAIT_L(8); PG8_BAR; PG8_WAIT_L(0); PG8_MMA(0, 0, At, B0); PG8_BAR; PG8_SCHED;
            PG8_LDB(B1, 1, 1); PG8_STAGE(PG8_SB(1, 0), b3, voffB);
            PG8_BAR; PG8_WAIT_L(0); PG8_MMA(0, 1, At, B1); PG8_BAR;
            PG8_LDA(At, 1, 1); PG8_STAGE(PG8_SA(1, 0), a3, voffA);
            PG8_BAR; PG8_WAIT_L(0); PG8_MMA(1, 0, At, B0); PG8_BAR; PG8_SCHED;
            PG8_STAGE(PG8_SB(1, 1), b3 + hstep, voffB);
            PG8_WAIT_V(6); PG8_BAR; PG8_MMA(1, 1, At, B1); PG8_BAR;
            }
        }
        if constexpr (ALIGN_EPI) { if (wr == 0) PG8_BAR; }
        if constexpr (!Epi::AFTER_DRAIN) { E(acc, cur, wr, wc, fr, fq); S.done(cur); }
        if (!has_next) break;
#pragma unroll
        for (int a = 0; a < 2; ++a)
#pragma unroll
            for (int b = 0; b < 2; ++b)
#pragma unroll
                for (int m = 0; m < 4; ++m)
#pragma unroll
                    for (int n = 0; n < 2; ++n) acc[a][b][m][n] = (f32x4){0.f, 0.f, 0.f, 0.f};
        cur = nxt; cA = nA; cB = nB; ++ui;
        if constexpr (ALIGN_EPI) { if (wr == 1) PG8_BAR; }
    }
    PG8_WAIT_V(0);
    if constexpr (!ALIGN_EPI) { if (wr == 0) PG8_BAR; }
    PG8_BAR;
    if constexpr (Epi::AFTER_DRAIN) { E.fused(acc, cur, wr, wc, fr, fq, lds, wid, lane); S.done(cur); }
#undef PG8_SA
#undef PG8_SB
#undef PG8_STAGE
#undef PG8_LDA
#undef PG8_LDB
#undef PG8_MMA
#undef PG8_WAIT_V
#undef PG8_WAIT_L
#undef PG8_BAR
#undef PG8_SCHED
}
}


constexpr int NWAVES = 8;
constexpr int D_MODEL = 4096, BATCH = 4, SEQ = 2048, CTX_LEN = 256, D_FF = 11008, D_A = 1024, D_B = 2048, N_IN = 19456, N_MOD = 9;
constexpr int D_FFP = D_FF + 64;
constexpr int RT = 9216;
constexpr int RPB = 2304;
constexpr int S5_G = 64, S5_P = 64, S5_H = 16, NCHUNK = 36;
constexpr float EPS = 1e-6f;
constexpr int ADA_KS = 8, NMODC_ = 36864;

constexpr size_t MiB = 1u << 20;
constexpr size_t WS_CTL = 0, CTL_ZERO_BYTES = 1 * MiB;
constexpr size_t WS_MODP = 2 * MiB;
constexpr size_t WS_MOD = 14 * MiB;
constexpr size_t WS_TAB = 15 * MiB;
constexpr size_t WS_Y = 188 * MiB  , WS_WP = 656 * MiB  ;
constexpr size_t WS_W13A = 16 * MiB, WS_W2A = 814 * MiB, WS_WIN = 274 * MiB, WS_WGLU = 426 * MiB, WS_WPA = 428 * MiB, WS_WPB = 436 * MiB, WS_WOUT = 452 * MiB, WS_W13B = 484 * MiB, WS_W2B = 901 * MiB;
constexpr size_t WS_ZN = 742 * MiB, WS_HID = 2026 * MiB, WS_H = 1008 * MiB, WS_UA = 1152 * MiB, WS_Q = 1188 * MiB, WS_V = 1224 * MiB, WS_OG = 1260 * MiB, WS_LFF = 1296 * MiB, WS_LFB = 1368 * MiB;
constexpr size_t WS_SGA = 1440 * MiB, WS_SGB = 1512 * MiB, WS_XEND = 1584 * MiB, WS_GA = 1594 * MiB, WS_YA = 1612 * MiB, WS_OHG = 1630 * MiB, WS_YB = 1774 * MiB, WS_PT = 1810 * MiB, WS_MRG = 1954 * MiB, WS_END = 2221 * MiB;
static_assert(WS_W13A + (size_t)2 * D_FF * D_MODEL * 2 <= WS_WIN && WS_W2A + (size_t)D_MODEL * D_FFP * 2 <= WS_W2B && WS_W2B + (size_t)D_MODEL * D_FFP * 2 <= WS_H && WS_WIN + (size_t)N_IN * D_MODEL * 2 <= WS_WGLU, "ws map 1");
static_assert(WS_W13B + (size_t)2 * D_FF * D_MODEL * 2 <= WS_ZN && WS_ZN + (size_t)RT * D_MODEL * 2 <= WS_W2A && WS_MRG + (size_t)RT * D_MODEL * 2 <= WS_HID && WS_HID + (size_t)RT * D_FFP * 2 <= WS_END, "ws map 2");
static_assert(WS_H + (size_t)RT * D_MODEL * 4 <= WS_UA && WS_UA + (size_t)RT * D_A * 4 <= WS_Q && WS_Q + (size_t)RT * D_B * 2 <= WS_V && WS_LFF + (size_t)RT * D_B * 4 <= WS_LFB && WS_SGA + (size_t)RT * D_MODEL * 2 <= WS_SGB, "ws map 3");
static_assert(WS_XEND + (size_t)BATCH * 2 * S5_G * NCHUNK * S5_P * 8 <= WS_GA && WS_OHG + (size_t)2 * RT * D_B * 4 <= WS_YB && WS_PT + (size_t)RT * D_MODEL * 4 <= WS_MRG && WS_MRG + (size_t)RT * D_MODEL * 2 <= WS_END, "ws map 4");
static_assert(WS_MODP + (size_t)ADA_KS * 5 * 36864 * 4 <= WS_MOD, "ws map 5");
constexpr int CW_BAR = 4096;
constexpr int CW_QUEUE = 8192, CW_DONE = 8192 + 64, CW_QUEUE2 = 8192 + 128, CW_QUEUE3 = 8192 + 192;

constexpr int RING_OFF = 0, RING_BYTES = 131072;
constexpr int LDSCTL_OFF = RING_BYTES, MISC_OFF = LDSCTL_OFF + 320;
constexpr int LDS_BYTES = 147456;
static_assert(MISC_OFF + 128 <= LDS_BYTES, "LDS map");

#define GAS __attribute__((address_space(1)))
#define LAS __attribute__((address_space(3)))
typedef unsigned short bf16;
typedef unsigned v4u __attribute__((ext_vector_type(4)));
typedef unsigned v2u __attribute__((ext_vector_type(2)));
typedef float f32x4 __attribute__((ext_vector_type(4)));
typedef float f32x2 __attribute__((ext_vector_type(2)));
typedef short bf16x8 __attribute__((ext_vector_type(8)));
typedef GAS unsigned gu32;
#define RLX_AGENT __ATOMIC_RELAXED, __HIP_MEMORY_SCOPE_AGENT
#define LDS_WAIT() asm volatile("s_waitcnt lgkmcnt(0)" ::: "memory")
#define VM_WAIT() asm volatile("s_waitcnt vmcnt(0)" ::: "memory")
using pg8::cvt_pk_bf16; using pg8::bf_lo; using pg8::bf_hi; using pg8::sigmoid_f; using pg8::silu_f;
__device__ __forceinline__ float wave_sum(float v) {
#pragma unroll
    for (int o = 1; o < 64; o <<= 1) v += __shfl_xor(v, o);
    return v;
}

#define XB_TMO      128
#define XB_XCNT(j)  (256  + 64 * (j))
#define XB_XSUB(j)  (1280 + 64 * (j))
#define XB_XGEN(j)  (2304 + 64 * (j))
#define XB_TOP      3328
#define XB_TOPGEN   3392
#define XCD_BAR_WORDS 3456
#define XB_SPIN_CAP (1u << 18)

__device__ __forceinline__ unsigned xb_ld(unsigned* p)              { return __hip_atomic_load(p, __ATOMIC_RELAXED, __HIP_MEMORY_SCOPE_AGENT); }
__device__ __forceinline__ unsigned xb_add(unsigned* p, unsigned v) { return __hip_atomic_fetch_add(p, v, __ATOMIC_RELAXED, __HIP_MEMORY_SCOPE_AGENT); }
__device__ __forceinline__ unsigned xb_xcc_id() { return (unsigned)__builtin_amdgcn_s_getreg((3 << 11) | 20) & 0xFu; }
#define XB_SPIN(cond, bar) do { unsigned _sp = 0; while (cond) { __builtin_amdgcn_s_sleep(1); \
    if ((++_sp & 255u) == 0u) { if (xb_ld(&(bar)[XB_TMO])) break; if (_sp > XB_SPIN_CAP) { atomicAdd(&(bar)[XB_TMO], 1u); break; } } } } while (0)

struct XcdBarrier {
    unsigned* bar; unsigned x;
    volatile LAS unsigned* st;
};

__device__ __forceinline__ XcdBarrier xcd_barrier_post(unsigned* bar, volatile LAS unsigned* st) {
    XcdBarrier b; b.bar = bar; b.x = xb_xcc_id(); b.st = st;
    if (threadIdx.x == 0) (void)xb_add(&bar[XB_XCNT(b.x)], 1u);
    return b;
}
__device__ __forceinline__ void xcd_barrier_complete(unsigned* bar, unsigned x, unsigned& nloc, unsigned& nx) {
    const unsigned G = gridDim.x * gridDim.y * gridDim.z;
    unsigned sum, cnt, mine, sp = 0u;
    for (;;) {
        sum = 0u; cnt = 0u; mine = 0u;
#pragma unroll
        for (unsigned j = 0; j < 16; ++j) { const unsigned c = xb_ld(&bar[XB_XCNT(j)]); sum += c; cnt += (c > 0u) ? 1u : 0u; mine = (j == x) ? c : mine; }
        if (sum == G) break;
        __builtin_amdgcn_s_sleep(1);
        if ((++sp & 255u) == 0u) { if (xb_ld(&bar[XB_TMO])) break; if (sp > XB_SPIN_CAP) { atomicAdd(&bar[XB_TMO], 1u); break; } }
    }
    nloc = mine > 0u ? mine : 1u; nx = cnt > 0u ? cnt : 1u;
}

__device__ __forceinline__ void xcd_barrier(const XcdBarrier& b) {
    asm volatile("s_waitcnt vmcnt(0)" ::: "memory");
    __syncthreads();
    if (threadIdx.x == 0) {
        unsigned* bar = b.bar;
        __builtin_amdgcn_s_waitcnt(0);
        unsigned nloc = b.st[0], nx = b.st[1];
        if (nloc == 0u) { xcd_barrier_complete(bar, b.x, nloc, nx); b.st[0] = nloc; b.st[1] = nx; }
        const unsigned old = xb_add(&bar[XB_XSUB(b.x)], 1u);
        const unsigned gen = old / nloc;
        if (old + 1u == (gen + 1u) * nloc) {
            __builtin_amdgcn_fence(__ATOMIC_RELEASE, "agent");
            asm volatile("s_waitcnt vmcnt(0)" ::: "memory");
            const unsigned og = xb_add(&bar[XB_TOP], 1u);
            const unsigned tg = og / nx;
            if (og + 1u == (tg + 1u) * nx) xb_add(&bar[XB_TOPGEN], 1u);
            else XB_SPIN(xb_ld(&bar[XB_TOPGEN]) == tg, bar);
            __builtin_amdgcn_fence(__ATOMIC_ACQUIRE, "agent");
            xb_add(&bar[XB_XGEN(b.x)], 1u);
            asm volatile("s_waitcnt vmcnt(0)" ::: "memory");
        } else {
            XB_SPIN(xb_ld(&bar[XB_XGEN(b.x)]) == gen, bar);
            __builtin_amdgcn_fence(__ATOMIC_ACQUIRE, "agent");
            asm volatile("s_waitcnt vmcnt(0)" ::: "memory");
        }
    }
    __syncthreads();
}


struct Args { const float* in[31]; float* out; unsigned char* ws; };
enum { I_X = 0, I_C, I_CTX, I_CCTX, I_WADA, I_BADA, I_NORM1, I_W1A, I_W3A, I_W2A, I_NORMMIX, I_WIN, I_LAMRE, I_LAMIM, I_LOGDT, I_BRE, I_BIM, I_CRE, I_CIM, I_S5D, I_WGLU,
       I_LBLOG, I_HGNORM, I_WPA, I_WPB, I_WOUT, I_NORM2, I_W1B, I_W3B, I_W2B, I_NORMF };

struct ItemDesc { const float* src; bf16* dst; int N, K; };
__device__ __forceinline__ ItemDesc make_item(const float* W, int K, int N, bf16* WT, int kind, int item, int ld = 0) {
    if (ld) K = ld;
    const int nblk = N / 32, kb = item / nblk, nb = item - kb * nblk, k0 = 64 * kb, n0 = 32 * nb;
    int drow = (kind == 0) ? n0 : ((n0 >> 7) * 256 + (n0 & 127) + (kind == 2 ? 128 : 0));
    if (kind == 3) { const int st = n0 >> 8; const int dt = (st < 4) ? st : (st < 12) ? st + 24 : (st < 36) ? st - 8 : st;
        drow = dt * 256 + (n0 & 255);
        if (st >= 44) { const int isb = (st >= 60) ? 1 : 0, c = (st - 44 - 16 * isb) * 256 + (n0 & 255); drow = (44 + (c >> 7)) * 256 + (c & 127) + 128 * isb; } }
    ItemDesc d; d.src = W + (size_t)k0 * N + n0; d.dst = WT + (size_t)drow * K + k0; d.N = N; d.K = K; return d;
}
__device__ __forceinline__ void item_load(const ItemDesc& d, f32x4 (&v)[8], int lane) {
    const float* p = d.src + (size_t)(lane >> 3) * d.N + 4 * (lane & 7);
#pragma unroll
    for (int i = 0; i < 8; ++i) v[i] = __builtin_nontemporal_load((const GAS f32x4*)(p + (size_t)(8 * i) * d.N));
}
__device__ __forceinline__ void item_store(const ItemDesc& d, const f32x4 (&v)[8], LAS float* scr, int lane) {
#pragma unroll
    for (int i = 0; i < 8; ++i) { LAS float* s = scr + (8 * i + (lane >> 3)) * 33 + 4 * (lane & 7); s[0] = v[i].x; s[1] = v[i].y; s[2] = v[i].z; s[3] = v[i].w; }
    LDS_WAIT(); asm volatile("" ::: "memory");
    const int c = lane & 7;
#pragma unroll
    for (int j = 0; j < 4; ++j) { const int n = (lane >> 3) + 8 * j; const LAS float* s = scr + (8 * c) * 33 + n;
        v4u o; o.x = cvt_pk_bf16(s[0 * 33], s[1 * 33]); o.y = cvt_pk_bf16(s[2 * 33], s[3 * 33]); o.z = cvt_pk_bf16(s[4 * 33], s[5 * 33]); o.w = cvt_pk_bf16(s[6 * 33], s[7 * 33]);
        __builtin_nontemporal_store(o, (GAS v4u*)(d.dst + (size_t)n * d.K + 8 * c)); }
    LDS_WAIT(); asm volatile("" ::: "memory");
}
constexpr int IT_FF = (D_MODEL / 64) * (D_FF / 32), IT_WIN = (D_MODEL / 64) * (N_IN / 32), IT_GLU = (D_A / 64) * (D_A / 32), IT_PA = (D_A / 64) * (D_MODEL / 32), IT_PB = (D_B / 64) * (D_MODEL / 32), IT_OUT = (D_MODEL / 64) * (D_MODEL / 32);
constexpr int T_ITEMS = 6 * IT_FF + IT_WIN + IT_GLU + IT_PA + IT_PB + IT_OUT;
constexpr int ADA_TASKS = 144 * ADA_KS, ADA_KLEN = D_MODEL / ADA_KS;

__device__ __forceinline__ void p0_ada_task(const float* cvec, const float* cctx, const float* wada, float* modp, int task, LAS float* scr, int lane) {
    const int cg = task % 144, ks = task / 144, k0 = ks * ADA_KLEN, n0 = cg * 256 + lane * 4;
#pragma unroll
    for (int i = 0; i < 5; ++i)
        for (int kk = lane; kk < ADA_KLEN; kk += 64) { const float v = (i < 4) ? cvec[i * D_MODEL + k0 + kk] : cctx[k0 + kk]; scr[kk * 8 + i] = silu_f(v); }
    LDS_WAIT(); asm volatile("" ::: "memory");
    f32x4 a0 = {0.f, 0.f, 0.f, 0.f}, a1 = a0, a2 = a0, a3 = a0, a4 = a0;
    const float* wp = wada + (size_t)k0 * NMODC_ + n0;
#pragma unroll 16
    for (int k = 0; k < ADA_KLEN; ++k) {
        const f32x4 w = __builtin_nontemporal_load((const GAS f32x4*)(wp + (size_t)k * NMODC_));
        const f32x4 s = *(const LAS f32x4*)(scr + k * 8); const float s4 = scr[k * 8 + 4];
        a0 += w * s[0]; a1 += w * s[1]; a2 += w * s[2]; a3 += w * s[3]; a4 += w * s4;
    }
    float* o = modp + (size_t)ks * 5 * NMODC_ + n0;
    *(f32x4*)(o) = a0; *(f32x4*)(o + NMODC_) = a1; *(f32x4*)(o + 2 * NMODC_) = a2; *(f32x4*)(o + 3 * NMODC_) = a3; *(f32x4*)(o + 4 * NMODC_) = a4;
    LDS_WAIT(); asm volatile("" ::: "memory");
}

__device__ __forceinline__ void norm_mod_row(const float* src, const float* gain, const float* shift, const float* scale, bf16* dst, int lane) {
    const GAS f32x4* xr = (const GAS f32x4*)src + lane;
    f32x4 v[16]; float s = 0.f;
#pragma unroll
    for (int j = 0; j < 16; ++j) { v[j] = xr[64 * j]; s += (v[j].x * v[j].x + v[j].y * v[j].y) + (v[j].z * v[j].z + v[j].w * v[j].w); }
    const float rstd = 1.0f / sqrtf(wave_sum(s) * (1.f / D_MODEL) + EPS);
    const GAS f32x4* gp = (const GAS f32x4*)gain + lane; const GAS f32x4* hp = (const GAS f32x4*)shift + lane; const GAS f32x4* cp = (const GAS f32x4*)scale + lane;
    GAS v2u* o8 = (GAS v2u*)dst + lane;
#pragma unroll
    for (int j = 0; j < 16; ++j) { const f32x4 g = gp[64 * j], sh = hp[64 * j], sc = cp[64 * j]; const f32x4 y = (v[j] * rstd * g) * (sc + 1.0f) + sh;
        v2u w; w.x = cvt_pk_bf16(y.x, y.y); w.y = cvt_pk_bf16(y.z, y.w); o8[64 * j] = w; }
}
__device__ __forceinline__ void norm_mod_row_h(const pg8::h16_t* src, const float* gain, const float* shift, const float* scale, bf16* dst, int lane) {
    const GAS v2u* xr = (const GAS v2u*)src + lane;
    f32x4 v[16]; float s = 0.f;
#pragma unroll
    for (int j = 0; j < 16; ++j) { const v2u w = xr[64 * j]; const f32x2 a = pg8::unpk_f16(w.x), c = pg8::unpk_f16(w.y); v[j] = (f32x4){a.x, a.y, c.x, c.y};
        s += (v[j].x * v[j].x + v[j].y * v[j].y) + (v[j].z * v[j].z + v[j].w * v[j].w); }
    const float rstd = 1.0f / sqrtf(wave_sum(s) * (1.f / D_MODEL) + EPS);
    const GAS f32x4* gp = (const GAS f32x4*)gain + lane; const GAS f32x4* hp = (const GAS f32x4*)shift + lane; const GAS f32x4* cp = (const GAS f32x4*)scale + lane;
    GAS v2u* o8 = (GAS v2u*)dst + lane;
#pragma unroll
    for (int j = 0; j < 16; ++j) { const f32x4 g = gp[64 * j], sh = hp[64 * j], sc = cp[64 * j]; const f32x4 y = (v[j] * rstd * g) * (sc + 1.0f) + sh;
        v2u w; w.x = cvt_pk_bf16(y.x, y.y); w.y = cvt_pk_bf16(y.z, y.w); o8[64 * j] = w; }
}
__device__ __forceinline__ void norm_mod_row_part(const float* base, const pg8::h16_t* part, const float* m2, const float* gain, const float* shift, const float* scale, bf16* dst, int lane) {
    const GAS f32x4* xr = (const GAS f32x4*)base + lane; const GAS v2u* pr = (const GAS v2u*)part + lane; const GAS f32x4* mr = (const GAS f32x4*)m2 + lane;
    constexpr size_t QS = (size_t)BATCH * CTX_LEN * D_MODEL / 4;
    f32x4 v[16]; float s = 0.f;
#pragma unroll
    for (int j = 0; j < 16; ++j) { f32x4 p = (f32x4){0.f, 0.f, 0.f, 0.f};
#pragma unroll
        for (int k = 0; k < 4; ++k) { const v2u w = pr[k * QS + 64 * j]; const f32x2 a = pg8::unpk_f16(w.x), c = pg8::unpk_f16(w.y); p += (f32x4){a.x, a.y, c.x, c.y}; }
        v[j] = xr[64 * j] + (mr[64 * j] * 0.5f) * p; s += (v[j].x * v[j].x + v[j].y * v[j].y) + (v[j].z * v[j].z + v[j].w * v[j].w);
        if ((j & 3) == 3) asm volatile("" ::: "memory"); }
    const float rstd = 1.0f / sqrtf(wave_sum(s) * (1.f / D_MODEL) + EPS);
    const GAS f32x4* gp = (const GAS f32x4*)gain + lane; const GAS f32x4* hp = (const GAS f32x4*)shift + lane; const GAS f32x4* cp = (const GAS f32x4*)scale + lane;
    GAS v2u* o8 = (GAS v2u*)dst + lane;
#pragma unroll
    for (int j = 0; j < 16; ++j) { const f32x4 g = gp[64 * j], sh = hp[64 * j], sc = cp[64 * j]; const f32x4 y = (v[j] * rstd * g) * (sc + 1.0f) + sh;
        v2u w; w.x = cvt_pk_bf16(y.x, y.y); w.y = cvt_pk_bf16(y.z, y.w); o8[64 * j] = w; }
}
__device__ __forceinline__ void norm_final_row_h(const pg8::h16_t* src, float* dst, const float* gain, int lane) {
    const GAS v2u* xr = (const GAS v2u*)src + lane; GAS f32x4* o = (GAS f32x4*)dst + lane;
    f32x4 v[16]; float s = 0.f;
#pragma unroll
    for (int j = 0; j < 16; ++j) { const v2u w = xr[64 * j]; const f32x2 a = pg8::unpk_f16(w.x), c = pg8::unpk_f16(w.y); v[j] = (f32x4){a.x, a.y, c.x, c.y};
        s += (v[j].x * v[j].x + v[j].y * v[j].y) + (v[j].z * v[j].z + v[j].w * v[j].w); }
    const float rstd = 1.0f / sqrtf(wave_sum(s) * (1.f / D_MODEL) + EPS);
    const GAS f32x4* gp = (const GAS f32x4*)gain + lane;
#pragma unroll
    for (int j = 0; j < 16; ++j) o[64 * j] = v[j] * rstd * gp[64 * j];
}
__device__ __forceinline__ void norm_final_row(float* io, const float* gain, int lane) {
    GAS f32x4* xr = (GAS f32x4*)io + lane;
    f32x4 v[16]; float s = 0.f;
#pragma unroll
    for (int j = 0; j < 16; ++j) { v[j] = xr[64 * j]; s += (v[j].x * v[j].x + v[j].y * v[j].y) + (v[j].z * v[j].z + v[j].w * v[j].w); }
    const float rstd = 1.0f / sqrtf(wave_sum(s) * (1.f / D_MODEL) + EPS);
    const GAS f32x4* gp = (const GAS f32x4*)gain + lane;
#pragma unroll
    for (int j = 0; j < 16; ++j) xr[64 * j] = v[j] * rstd * gp[64 * j];
}

__device__ __forceinline__ void s5_table_entry(const float* lam_re, const float* lam_im, const float* log_dt, float* TAB, int idx) {
    const int dg = idx >> 6;
    const double dt = exp((double)log_dt[dg]);
    const double lr = (double)lam_re[idx], li = (double)lam_im[idx];
    const double mag = exp(lr * dt), th = li * dt;
    const double TWO_PI = 6.283185307179586476925286766559;
    const double rr = th - TWO_PI * rint(th * (1.0 / TWO_PI));
    const double abr = mag * cos(rr), abi = mag * sin(rr);
    const double den = lr * lr + li * li, nr = abr - 1.0;
    const double kr = (nr * lr + abi * li) / den, ki = (abi * lr - nr * li) / den;
    double pr = abr, pi = abi;
#pragma unroll
    for (int i = 0; i < 6; ++i) { const double tr = pr * pr - pi * pi, ti = 2.0 * pr * pi; pr = tr; pi = ti; }
    float* o = TAB + (size_t)idx * 8;
    o[0] = (float)abr; o[1] = (float)abi; o[2] = (float)kr; o[3] = (float)ki; o[4] = (float)pr; o[5] = (float)pi; o[6] = 0.f; o[7] = 0.f;
}
#define S5_LOAD_BK(d_, g_, p_) \
    float ar, ai, a64r, a64i; f32x2 bk2[16]; \
    { const f32x4 t0 = *(const f32x4*)(TAB + ((size_t)(((d_) * 64 + (g_)) * 64 + (p_))) * 8), t1 = *(const f32x4*)(TAB + ((size_t)(((d_) * 64 + (g_)) * 64 + (p_))) * 8 + 4); \
      ar = t0[0]; ai = t0[1]; a64r = t1[0]; a64i = t1[1]; const float kr = t0[2], ki = t0[3]; \
      const f32x4* br = (const f32x4*)(b_re + ((size_t)((g_) * 64 + (p_))) * 16); const f32x4* bi = (const f32x4*)(b_im + ((size_t)((g_) * 64 + (p_))) * 16); \
      _Pragma("unroll") for (int q = 0; q < 4; ++q) { const f32x4 x = br[q], y = bi[q]; \
          _Pragma("unroll") for (int j = 0; j < 4; ++j) { bk2[4 * q + j] = (f32x2){kr * x[j] - ki * y[j], kr * y[j] + ki * x[j]}; } } }
#define S5_STEP(tl_) { const f32x4 u0 = UL[(tl_) * 4 + 0], u1 = UL[(tl_) * 4 + 1], u2 = UL[(tl_) * 4 + 2], u3 = UL[(tl_) * 4 + 3]; \
        f32x2 e0 = bk2[0] * u0[0], e1 = bk2[1] * u0[1]; \
        e0 += bk2[2] * u0[2]; e1 += bk2[3] * u0[3]; e0 += bk2[4] * u1[0]; e1 += bk2[5] * u1[1]; e0 += bk2[6] * u1[2]; e1 += bk2[7] * u1[3]; \
        e0 += bk2[8] * u2[0]; e1 += bk2[9] * u2[1]; e0 += bk2[10] * u2[2]; e1 += bk2[11] * u2[3]; e0 += bk2[12] * u3[0]; e1 += bk2[13] * u3[1]; e0 += bk2[14] * u3[2]; e1 += bk2[15] * u3[3]; \
        e0 += e1; \
        const float nr_ = ar * xr - ai * xi + e0.x, ni_ = ar * xi + ai * xr + e0.y; xr = nr_; xi = ni_; }

typedef float f32x16 __attribute__((ext_vector_type(16)));
__device__ __forceinline__ void s5_make_ef(bf16x8 (&Ef)[4], const float* TAB, const float* b_re, const float* b_im, int d, int g, int lane) {
    const int half = lane >> 5, l31 = lane & 31;
#pragma unroll
    for (int s2 = 0; s2 < 2; ++s2) { const int ps = 32 * s2 + l31;
        const f32x4 tt = *(const f32x4*)(TAB + ((size_t)((d * 64 + g) * 64 + ps)) * 8); const float kr = tt[2], ki = tt[3];
        const float* brp = b_re + ((size_t)(g * 64 + ps)) * 16 + 8 * half; const float* bip = b_im + ((size_t)(g * 64 + ps)) * 16 + 8 * half;
        const f32x4 r0 = *(const f32x4*)brp, r1 = *(const f32x4*)(brp + 4), i0 = *(const f32x4*)bip, i1 = *(const f32x4*)(bip + 4);
        v4u wr_, wi_;
        wr_.x = cvt_pk_bf16(kr * r0[0] - ki * i0[0], kr * r0[1] - ki * i0[1]); wr_.y = cvt_pk_bf16(kr * r0[2] - ki * i0[2], kr * r0[3] - ki * i0[3]);
        wr_.z = cvt_pk_bf16(kr * r1[0] - ki * i1[0], kr * r1[1] - ki * i1[1]); wr_.w = cvt_pk_bf16(kr * r1[2] - ki * i1[2], kr * r1[3] - ki * i1[3]);
        wi_.x = cvt_pk_bf16(kr * i0[0] + ki * r0[0], kr * i0[1] + ki * r0[1]); wi_.y = cvt_pk_bf16(kr * i0[2] + ki * r0[2], kr * i0[3] + ki * r0[3]);
        wi_.z = cvt_pk_bf16(kr * i1[0] + ki * r1[0], kr * i1[1] + ki * r1[1]); wi_.w = cvt_pk_bf16(kr * i1[2] + ki * r1[2], kr * i1[3] + ki * r1[3]);
        Ef[s2] = __builtin_bit_cast(bf16x8, wr_); Ef[2 + s2] = __builtin_bit_cast(bf16x8, wi_); }
}
#define S5_E_TILES(blk_) \
    const int tk_ = 16 * (blk_) + (l31 & 3) + 4 * (l31 >> 3); \
    const f32x4 ua_ = UL[tk_ * 4 + 2 * half], ub_ = UL[tk_ * 4 + 2 * half + 1]; \
    v4u aw_; aw_.x = cvt_pk_bf16(ua_[0], ua_[1]); aw_.y = cvt_pk_bf16(ua_[2], ua_[3]); aw_.z = cvt_pk_bf16(ub_[0], ub_[1]); aw_.w = cvt_pk_bf16(ub_[2], ub_[3]); \
    const bf16x8 Af_ = __builtin_bit_cast(bf16x8, aw_); \
    f32x16 zero16_; _Pragma("unroll") for (int q_ = 0; q_ < 16; ++q_) zero16_[q_] = 0.f; \
    const f32x16 D0 = __builtin_amdgcn_mfma_f32_32x32x16_bf16(Af_, Ef[0], zero16_, 0, 0, 0), D1 = __builtin_amdgcn_mfma_f32_32x32x16_bf16(Af_, Ef[1], zero16_, 0, 0, 0); \
    const f32x16 D2 = __builtin_amdgcn_mfma_f32_32x32x16_bf16(Af_, Ef[2], zero16_, 0, 0, 0), D3 = __builtin_amdgcn_mfma_f32_32x32x16_bf16(Af_, Ef[3], zero16_, 0, 0, 0);

__device__ __forceinline__ void s5_pass_a(LAS unsigned char* scr, int task, const float* TAB, const float* b_re, const float* b_im, const pg8::h16_t* UA, float* XEND, int lane) {
    const int c = task % NCHUNK; int r = task / NCHUNK; const int g = r & 63; r >>= 6; const int d = r & 1; const int b = r >> 1;
    const int half = lane >> 5, l31 = lane & 31;
    const f32x4 t0 = *(const f32x4*)(TAB + ((size_t)((d * 64 + g) * 64 + lane)) * 8); const float ar = t0[0], ai = t0[1];
    bf16x8 Ef[4]; s5_make_ef(Ef, TAB, b_re, b_im, d, g, lane);
    const int j0 = 64 * c;
    const int trow = (d == 0) ? (j0 + lane) : ((j0 < CTX_LEN ? 255 - j0 : 2559 - j0) - lane);
    const v4u* up = (const v4u*)(UA + ((size_t)(b * RPB + trow)) * D_A + g * 16);
    LAS f32x4* UL = (LAS f32x4*)scr;
#pragma unroll
    for (int q = 0; q < 2; ++q) { const v4u w = up[q]; const f32x2 p0 = pg8::unpk_f16(w.x), p1 = pg8::unpk_f16(w.y), p2 = pg8::unpk_f16(w.z), p3 = pg8::unpk_f16(w.w);
        UL[lane * 4 + 2 * q] = (f32x4){p0.x, p0.y, p1.x, p1.y}; UL[lane * 4 + 2 * q + 1] = (f32x4){p2.x, p2.y, p3.x, p3.y}; }
    LDS_WAIT(); asm volatile("" ::: "memory");
    float xr = 0.f, xi = 0.f;
#pragma unroll
    for (int i = 0; i < 4; ++i) {
        S5_E_TILES(i)
#pragma unroll
        for (int ss = 0; ss < 16; ++ss) { const float er = half ? D1[ss] : D0[ss], ei = half ? D3[ss] : D2[ss];
            const float nr_ = ar * xr - ai * xi + er, ni_ = ar * xi + ai * xr + ei; xr = nr_; xi = ni_; }
    }
    __hip_atomic_store((unsigned long long*)(XEND + ((size_t)task * 64 + lane) * 2), ((unsigned long long)__float_as_uint(xi) << 32) | (unsigned long long)__float_as_uint(xr), __ATOMIC_RELAXED, __HIP_MEMORY_SCOPE_AGENT);
    LDS_WAIT(); asm volatile("" ::: "memory");
}

__device__ __forceinline__ float gelu_tanh_f(float y) { const float z = 1.5957691216057308f * (y + 0.044715f * y * y * y); return y * sigmoid_f(z); }
__device__ __forceinline__ unsigned short f2bf_rne(float f) { unsigned u = __float_as_uint(f); return (unsigned short)((u + 0x7fffu + ((u >> 16) & 1u)) >> 16); }

__device__ __forceinline__ void s5_pass_c(LAS unsigned char* scr, int task, const float* TAB, const float* b_re, const float* b_im, const float* c_re, const float* c_im, const float* dskip,
                                          const pg8::h16_t* UA, const float* XEND, bf16* GA, int lane) {
    const int c = 4 + (task & 31), g = (task >> 5) & 63, b = task >> 11;
    const int r16 = lane & 15, q4 = lane >> 4;
    LAS f32x4* UL = (LAS f32x4*)scr;
    LAS unsigned char* XB = scr + 4096;
    const int row0 = b * RPB + 64 * c;
    { const v4u* up = (const v4u*)(UA + ((size_t)(row0 + lane)) * D_A + g * 16);
#pragma unroll
      for (int q = 0; q < 2; ++q) { const v4u w = up[q]; const f32x2 p0 = pg8::unpk_f16(w.x), p1 = pg8::unpk_f16(w.y), p2 = pg8::unpk_f16(w.z), p3 = pg8::unpk_f16(w.w);
          UL[lane * 4 + 2 * q] = (f32x4){p0.x, p0.y, p1.x, p1.y}; UL[lane * 4 + 2 * q + 1] = (f32x4){p2.x, p2.y, p3.x, p3.y}; } }
    bf16x8 Cf[4];
#pragma unroll
    for (int ks = 0; ks < 4; ++ks) { const int k0 = 32 * ks + 8 * q4; const bool im = (ks >= 2);
        const float* src = (im ? c_im : c_re) + ((size_t)(g * 16 + r16)) * 64 + (k0 & 63); const float sg = im ? -1.f : 1.f;
        const f32x4 a = *(const f32x4*)src, bb = *(const f32x4*)(src + 4);
        v4u w; w.x = cvt_pk_bf16(sg * a[0], sg * a[1]); w.y = cvt_pk_bf16(sg * a[2], sg * a[3]); w.z = cvt_pk_bf16(sg * bb[0], sg * bb[1]); w.w = cvt_pk_bf16(sg * bb[2], sg * bb[3]);
        Cf[ks] = __builtin_bit_cast(bf16x8, w); }
    f32x4 ya[4];
#pragma unroll
    for (int i = 0; i < 4; ++i) ya[i] = (f32x4){0.f, 0.f, 0.f, 0.f};
    LDS_WAIT(); asm volatile("" ::: "memory");
    const int half = lane >> 5, l31 = lane & 31;
#pragma unroll
    for (int d = 0; d < 2; ++d) {
        float ar, ai, a64r, a64i;
        { const f32x4 t0 = *(const f32x4*)(TAB + ((size_t)((d * 64 + g) * 64 + lane)) * 8), t1 = *(const f32x4*)(TAB + ((size_t)((d * 64 + g) * 64 + lane)) * 8 + 4);
          ar = t0[0]; ai = t0[1]; a64r = t1[0]; a64i = t1[1]; }
        bf16x8 Ef[4]; s5_make_ef(Ef, TAB, b_re, b_im, d, g, lane);
        const int nprev = (d == 0) ? c : (39 - c);
        const f32x2* xe = (const f32x2*)(XEND + ((size_t)(((b * 2 + d) * 64 + g) * NCHUNK)) * 128) + lane;
        float xr = 0.f, xi = 0.f;
#pragma unroll 8
        for (int cc = 0; cc < nprev; ++cc) { const f32x2 e = xe[cc * 64]; const float nr_ = a64r * xr - a64i * xi + e.x, ni_ = a64r * xi + a64i * xr + e.y; xr = nr_; xi = ni_; }
#pragma unroll
        for (int ii = 0; ii < 4; ++ii) {
            const int i = (d == 0) ? ii : (3 - ii);
            S5_E_TILES(i)
#pragma unroll
            for (int ss = 0; ss < 16; ++ss) {
                const int s16 = (d == 0) ? ss : (15 - ss);
                const float er = half ? D1[s16] : D0[s16], ei = half ? D3[s16] : D2[s16];
                const float nr_ = ar * xr - ai * xi + er, ni_ = ar * xi + ai * xr + ei; xr = nr_; xi = ni_;
                *(LAS unsigned short*)(XB + s16 * 272 + 2 * lane) = f2bf_rne(xr);
                *(LAS unsigned short*)(XB + s16 * 272 + 128 + 2 * lane) = f2bf_rne(xi);
            }
            LDS_WAIT(); asm volatile("" ::: "memory");
#pragma unroll
            for (int ks = 0; ks < 4; ++ks) { const bf16x8 Bf = *(const LAS bf16x8*)(XB + r16 * 272 + 64 * ks + 16 * q4);
                ya[i] = __builtin_amdgcn_mfma_f32_16x16x32_bf16(Cf[ks], Bf, ya[i], 0, 0, 0); }
            LDS_WAIT(); asm volatile("" ::: "memory");
        }
    }
    const f32x4 dk = *(const f32x4*)(dskip + g * 16 + 4 * q4);
#pragma unroll
    for (int i = 0; i < 4; ++i) { const int tl = 16 * i + r16; const f32x4 u4 = UL[tl * 4 + q4];
        const f32x4 y = ya[i] + dk * u4;
        v2u w; w.x = cvt_pk_bf16(gelu_tanh_f(y[0]), gelu_tanh_f(y[1])); w.y = cvt_pk_bf16(gelu_tanh_f(y[2]), gelu_tanh_f(y[3]));
        *(GAS v2u*)(GA + ((size_t)(row0 + tl)) * D_A + g * 16 + 4 * q4) = w; }
    LDS_WAIT(); asm volatile("" ::: "memory");
}

__device__ __forceinline__ int hg_row(int b, int dir, int j) {
    const int jf = dir ? (j < CTX_LEN ? (CTX_LEN - 1 - j) : (2559 - j)) : j;
    int t = jf; if (jf >= CTX_LEN) { const int jj = jf - CTX_LEN; t = CTX_LEN + (jj & 31) * 64 + (jj >> 5); }
    return b * RPB + t;
}
constexpr int HG_TOT = 0, HG_DEC = 8192, HG_ROWS = 8704, HG_QS = 9216, HG_KS = 26624, HG_QB = 44032, HG_K2T = 61440, HG_VT = 79872, HG_P = 98304;
__device__ __forceinline__ void hgrn2_unit(LAS unsigned char* lds, int unit, const bf16* Q, const bf16* V, const pg8::h16_t* LFF, const pg8::h16_t* LFB, bf16* OHG, int tid) {
    const int b = unit >> 5, head = (unit >> 1) & 15, dir = unit & 1;
    const pg8::h16_t* LF = dir ? LFB : LFF;
    bf16* O = OHG + (size_t)dir * RT * D_B;
    const int lane = tid & 63, w = __builtin_amdgcn_readfirstlane(tid >> 6), kp = lane, tq = w, r16 = lane & 15, q4 = lane >> 4;
    const int colb = head * 128;
    LAS float* TOT = (LAS float*)(lds + HG_TOT); LAS float* DEC = (LAS float*)(lds + HG_DEC); LAS int* ROWS = (LAS int*)(lds + HG_ROWS); LAS float* EREF = (LAS float*)(lds + HG_QB);
    f32x4 S[8];
#pragma unroll
    for (int i = 0; i < 8; ++i) S[i] = (f32x4){0.f, 0.f, 0.f, 0.f};
    f32x2 lf[8]; unsigned qv[8], vv[8]; int rows[8];
#pragma unroll
    for (int i = 0; i < 8; ++i) { rows[i] = hg_row(b, dir, 8 * tq + i); const size_t o = (size_t)rows[i] * D_B + colb + 2 * kp;
        lf[i] = pg8::unpk_f16(*(const GAS unsigned*)(LF + o)); qv[i] = *(const GAS unsigned*)(Q + o); vv[i] = *(const GAS unsigned*)(V + o); }
    { float s0 = 0.f, s1 = 0.f;
#pragma unroll
      for (int i = 0; i < 8; ++i) { s0 += lf[i].x; s1 += lf[i].y; }
      *(LAS f32x2*)(TOT + tq * 128 + 2 * kp) = (f32x2){s0, s1}; }
    LDS_WAIT(); __builtin_amdgcn_s_barrier(); asm volatile("" ::: "memory");
    for (int c = 0; c < NCHUNK; ++c) {
        const LAS float* TC = TOT + (c & 1) * 1024;
        float off0 = 0.f, off1 = 0.f, ref0 = 0.f, ref1 = 0.f, all0 = 0.f, all1 = 0.f;
#pragma unroll
        for (int t2 = 0; t2 < 8; ++t2) { const f32x2 tt = *(const LAS f32x2*)(TC + t2 * 128 + 2 * kp);
            if (t2 < tq) { off0 += tt.x; off1 += tt.y; } if (t2 < 4) { ref0 += tt.x; ref1 += tt.y; } all0 += tt.x; all1 += tt.y; }
        const bool outp = (c >= 4);
        float k20[8], k21[8];
        { float b0 = off0, b1 = off1; const float ca0 = __expf(all0 - ref0), ca1 = __expf(all1 - ref1);
#pragma unroll
          for (int i = 0; i < 8; ++i) {
            b0 += lf[i].x; b1 += lf[i].y;
            const float kk0 = 1.0f - __expf(lf[i].x), kk1 = 1.0f - __expf(lf[i].y);
            const float ks0 = kk0 * __expf(ref0 - b0), ks1 = kk1 * __expf(ref1 - b1);
            k20[i] = ks0 * ca0; k21[i] = ks1 * ca1;
            if (outp) { const float q0 = bf_lo(qv[i]), q1 = bf_hi(qv[i]); const int t = 8 * tq + i;
                *(LAS unsigned*)(lds + HG_QS + t * 272 + 4 * kp) = cvt_pk_bf16(q0 * __expf(b0 - ref0), q1 * __expf(b1 - ref1));
                *(LAS unsigned*)(lds + HG_KS + t * 272 + 4 * kp) = cvt_pk_bf16(ks0, ks1); }
          } }
        { v4u a, bq; a.x = cvt_pk_bf16(k20[0], k20[1]); a.y = cvt_pk_bf16(k20[2], k20[3]); a.z = cvt_pk_bf16(k20[4], k20[5]); a.w = cvt_pk_bf16(k20[6], k20[7]);
          bq.x = cvt_pk_bf16(k21[0], k21[1]); bq.y = cvt_pk_bf16(k21[2], k21[3]); bq.z = cvt_pk_bf16(k21[4], k21[5]); bq.w = cvt_pk_bf16(k21[6], k21[7]);
          *(LAS v4u*)(lds + HG_K2T + (2 * kp) * 144 + 16 * tq) = a; *(LAS v4u*)(lds + HG_K2T + (2 * kp + 1) * 144 + 16 * tq) = bq;
          v4u lo, hi;
          lo.x = __builtin_amdgcn_perm(vv[1], vv[0], 0x05040100u); lo.y = __builtin_amdgcn_perm(vv[3], vv[2], 0x05040100u); lo.z = __builtin_amdgcn_perm(vv[5], vv[4], 0x05040100u); lo.w = __builtin_amdgcn_perm(vv[7], vv[6], 0x05040100u);
          hi.x = __builtin_amdgcn_perm(vv[1], vv[0], 0x07060302u); hi.y = __builtin_amdgcn_perm(vv[3], vv[2], 0x07060302u); hi.z = __builtin_amdgcn_perm(vv[5], vv[4], 0x07060302u); hi.w = __builtin_amdgcn_perm(vv[7], vv[6], 0x07060302u);
          *(LAS v4u*)(lds + HG_VT + (2 * kp) * 144 + 16 * tq) = lo; *(LAS v4u*)(lds + HG_VT + (2 * kp + 1) * 144 + 16 * tq) = hi; }
        if (tq == 0) { *(LAS f32x2*)(DEC + 2 * kp) = (f32x2){__expf(all0), __expf(all1)}; *(LAS f32x2*)(EREF + 2 * kp) = (f32x2){__expf(ref0), __expf(ref1)}; }
        if (kp == 0) {
#pragma unroll
            for (int i = 0; i < 8; ++i) ROWS[8 * tq + i] = rows[i]; }
        if (c + 1 < NCHUNK) {
#pragma unroll
            for (int i = 0; i < 8; ++i) { rows[i] = hg_row(b, dir, 64 * (c + 1) + 8 * tq + i); const size_t o = (size_t)rows[i] * D_B + colb + 2 * kp;
                lf[i] = pg8::unpk_f16(*(const GAS unsigned*)(LF + o)); qv[i] = *(const GAS unsigned*)(Q + o); vv[i] = *(const GAS unsigned*)(V + o); } }
        LDS_WAIT(); __builtin_amdgcn_s_barrier(); asm volatile("" ::: "memory");
        bf16x8 Vf[2];
#pragma unroll
        for (int ks2 = 0; ks2 < 2; ++ks2) Vf[ks2] = *(const LAS bf16x8*)(lds + HG_VT + (16 * w + r16) * 144 + 64 * ks2 + 16 * q4);
        f32x4 oacc[4]; int orow[4][4];
#pragma unroll
        for (int ti = 0; ti < 4; ++ti) oacc[ti] = (f32x4){0.f, 0.f, 0.f, 0.f};
        if (outp) {
            bf16x8 Af[4], Bf[2][4];
#pragma unroll
            for (int ks = 0; ks < 4; ++ks) Af[ks] = *(const LAS bf16x8*)(lds + HG_KS + (16 * (w >> 1) + r16) * 272 + 64 * ks + 16 * q4);
#pragma unroll
            for (int tsel = 0; tsel < 2; ++tsel) { const int ti = 2 * (w & 1) + tsel;
#pragma unroll
                for (int ks = 0; ks < 4; ++ks) Bf[tsel][ks] = *(const LAS bf16x8*)(lds + HG_QS + (16 * ti + r16) * 272 + 64 * ks + 16 * q4); }
#pragma unroll
            for (int ti = 0; ti < 4; ++ti) { typedef int i32x4 __attribute__((ext_vector_type(4))); const i32x4 rr = *(const LAS i32x4*)(ROWS + 16 * ti + 4 * q4);
                orow[ti][0] = rr.x; orow[ti][1] = rr.y; orow[ti][2] = rr.z; orow[ti][3] = rr.w; }
#pragma unroll
            for (int tsel = 0; tsel < 2; ++tsel) { const int idx = 2 * w + tsel, si = idx >> 2, ti = idx & 3;
                f32x4 dacc = (f32x4){0.f, 0.f, 0.f, 0.f};
#pragma unroll
                for (int ks = 0; ks < 4; ++ks) dacc = __builtin_amdgcn_mfma_f32_16x16x32_bf16(Af[ks], Bf[tsel][ks], dacc, 0, 0, 0);
                const int t = 16 * ti + r16, s0 = 16 * si + 4 * q4;
#pragma unroll
                for (int j = 0; j < 4; ++j) if (s0 + j > t) dacc[j] = 0.f;
                v2u pw; pw.x = cvt_pk_bf16(dacc[0], dacc[1]); pw.y = cvt_pk_bf16(dacc[2], dacc[3]);
                *(LAS v2u*)(lds + HG_P + t * 144 + 2 * s0) = pw; }
            v2u alo[4][4], ahi[4][4]; f32x4 er[8];
#pragma unroll
            for (int kt = 0; kt < 8; ++kt) er[kt] = *(const LAS f32x4*)(EREF + 16 * kt + 4 * q4);
#pragma unroll
            for (int ks = 0; ks < 4; ++ks)
#pragma unroll
                for (int ti = 0; ti < 4; ++ti) { alo[ks][ti] = *(const LAS v2u*)(lds + HG_QS + (16 * ti + r16) * 272 + 64 * ks + 8 * q4);
                    ahi[ks][ti] = *(const LAS v2u*)(lds + HG_QS + (16 * ti + r16) * 272 + 64 * ks + 32 + 8 * q4); }
#pragma unroll
            for (int ks = 0; ks < 4; ++ks) { const f32x4 s0 = S[2 * ks] * er[2 * ks], s1 = S[2 * ks + 1] * er[2 * ks + 1];
                v4u sw; sw.x = cvt_pk_bf16(s0[0], s0[1]); sw.y = cvt_pk_bf16(s0[2], s0[3]); sw.z = cvt_pk_bf16(s1[0], s1[1]); sw.w = cvt_pk_bf16(s1[2], s1[3]);
                const bf16x8 Sf = __builtin_bit_cast(bf16x8, sw);
#pragma unroll
                for (int ti = 0; ti < 4; ++ti) { v4u aw; aw.x = alo[ks][ti].x; aw.y = alo[ks][ti].y; aw.z = ahi[ks][ti].x; aw.w = ahi[ks][ti].y;
                    oacc[ti] = __builtin_amdgcn_mfma_f32_16x16x32_bf16(__builtin_bit_cast(bf16x8, aw), Sf, oacc[ti], 0, 0, 0); } }
        }
        { bf16x8 Kf[8][2]; f32x4 dc[8];
#pragma unroll
          for (int kt = 0; kt < 8; ++kt) { dc[kt] = *(const LAS f32x4*)(DEC + 16 * kt + 4 * q4);
#pragma unroll
              for (int ks2 = 0; ks2 < 2; ++ks2) Kf[kt][ks2] = *(const LAS bf16x8*)(lds + HG_K2T + (16 * kt + r16) * 144 + 64 * ks2 + 16 * q4); }
#pragma unroll
          for (int kt = 0; kt < 8; ++kt) { S[kt] = S[kt] * dc[kt];
#pragma unroll
              for (int ks2 = 0; ks2 < 2; ++ks2) S[kt] = __builtin_amdgcn_mfma_f32_16x16x32_bf16(Kf[kt][ks2], Vf[ks2], S[kt], 0, 0, 0); } }
        if (c + 1 < NCHUNK) { float s0 = 0.f, s1 = 0.f;
#pragma unroll
            for (int i = 0; i < 8; ++i) { s0 += lf[i].x; s1 += lf[i].y; }
            *(LAS f32x2*)(TOT + ((c + 1) & 1) * 1024 + tq * 128 + 2 * kp) = (f32x2){s0, s1}; }
        LDS_WAIT(); __builtin_amdgcn_s_barrier(); asm volatile("" ::: "memory");
        if (outp) {
            bf16x8 Pf[4][2];
#pragma unroll
            for (int ti = 0; ti < 4; ++ti)
#pragma unroll
                for (int ks2 = 0; ks2 < 2; ++ks2) Pf[ti][ks2] = *(const LAS bf16x8*)(lds + HG_P + (16 * ti + r16) * 144 + 64 * ks2 + 16 * q4);
#pragma unroll
            for (int ti = 0; ti < 4; ++ti)
#pragma unroll
                for (int ks2 = 0; ks2 < 2; ++ks2) oacc[ti] = __builtin_amdgcn_mfma_f32_16x16x32_bf16(Pf[ti][ks2], Vf[ks2], oacc[ti], 0, 0, 0);
#pragma unroll
            for (int ti = 0; ti < 4; ++ti)
#pragma unroll
                for (int j = 0; j < 4; ++j) O[(size_t)orow[ti][j] * D_B + colb + 16 * w + r16] = (bf16)(cvt_pk_bf16(oacc[ti][j], 0.f) & 0xffffu);
        }
    }
    LDS_WAIT(); __builtin_amdgcn_s_barrier(); asm volatile("" ::: "memory");
}
__device__ __forceinline__ void hg_finalize_row(int lr, const bf16* OHG, const bf16* OG, const float* gn, bf16* YB, int lane) {
    const int row = (lr >> 11) * RPB + CTX_LEN + (lr & 2047);
    const size_t o = (size_t)row * D_B + 2 * lane;
    unsigned a[16], bq[16], og[16];
#pragma unroll
    for (int h = 0; h < 16; ++h) { a[h] = *(const GAS unsigned*)(OHG + o + h * 128); bq[h] = *(const GAS unsigned*)(OHG + (size_t)RT * D_B + o + h * 128); og[h] = *(const GAS unsigned*)(OG + o + h * 128); }
#pragma unroll
    for (int h = 0; h < 16; ++h) { const float o0 = bf_lo(a[h]) + bf_lo(bq[h]), o1 = bf_hi(a[h]) + bf_hi(bq[h]);
        const float r = 1.0f / sqrtf(wave_sum(o0 * o0 + o1 * o1) * (1.f / 128.f) + EPS);
        const f32x2 g = *(const GAS f32x2*)(gn + h * 128 + 2 * lane);
        *(GAS unsigned*)(YB + (size_t)row * pg8::DY + 2 * lane + h * 128) = cvt_pk_bf16(o0 * r * g.x * silu_f(bf_lo(og[h])), o1 * r * g.y * silu_f(bf_hi(og[h])));
    }
}

constexpr int ITB_WIN = 3 * IT_FF, ITB_GLU = ITB_WIN + IT_WIN, ITB_FF2 = ITB_GLU + IT_GLU + IT_PA + IT_PB + IT_OUT;
constexpr int TAIL2_ITEMS = 30912, TAIL5_ITEMS = 3000;
constexpr int CONV6_ITEMS = 24000;
constexpr int P0_HOLE = ITB_WIN, P0_ITEMS = T_ITEMS - IT_FF - TAIL2_ITEMS - CONV6_ITEMS;
static_assert(ITB_FF2 + 3 * IT_FF == T_ITEMS, "item list");
__device__ __forceinline__ ItemDesc item_desc(const Args& args, unsigned char* ws, int it) {
    int r = it;
    if (r < IT_FF) return make_item(args.in[I_W1A], D_MODEL, D_FF, (bf16*)(ws + WS_W13A), 1, r); r -= IT_FF;
    if (r < IT_FF) return make_item(args.in[I_W3A], D_MODEL, D_FF, (bf16*)(ws + WS_W13A), 2, r); r -= IT_FF;
    if (r < IT_FF) return make_item(args.in[I_W2A], D_FF, D_MODEL, (bf16*)(ws + WS_W2A), 0, r, D_FFP); r -= IT_FF;
    if (r < IT_WIN) return make_item(args.in[I_WIN], D_MODEL, N_IN, (bf16*)(ws + WS_WIN), 3, r); r -= IT_WIN;
    if (r < IT_GLU) return make_item(args.in[I_WGLU], D_A, D_A, (bf16*)(ws + WS_WGLU), 0, r); r -= IT_GLU;
    if (r < IT_PA) return make_item(args.in[I_WPA], D_A, D_MODEL, (bf16*)(ws + WS_WP) + D_B, 0, r, pg8::DY); r -= IT_PA;
    if (r < IT_PB) return make_item(args.in[I_WPB], D_B, D_MODEL, (bf16*)(ws + WS_WP), 0, r, pg8::DY); r -= IT_PB;
    if (r < IT_OUT) return make_item(args.in[I_WOUT], D_MODEL, D_MODEL, (bf16*)(ws + WS_WOUT), 0, r); r -= IT_OUT;
    if (r < IT_FF) return make_item(args.in[I_W1B], D_MODEL, D_FF, (bf16*)(ws + WS_W13B), 1, r); r -= IT_FF;
    if (r < IT_FF) return make_item(args.in[I_W3B], D_MODEL, D_FF, (bf16*)(ws + WS_W13B), 2, r); r -= IT_FF;
    return make_item(args.in[I_W2B], D_FF, D_MODEL, (bf16*)(ws + WS_W2B), 0, r, D_FFP);
}
__device__ __forceinline__ void convert_range(const Args& args, unsigned char* ws, int first, int end, int step, LAS float* s, int lane, int hole_at = 0x7fffffff, int hole_len = 0) {
    if (first >= end) return;
    ItemDesc d0 = item_desc(args, ws, first < hole_at ? first : first + hole_len); f32x4 va[8]; item_load(d0, va, lane);
    for (int it = first; it < end; it += step) {
        const int nx = it + step; ItemDesc d1 = d0; f32x4 vb[8];
        if (nx < end) { d1 = item_desc(args, ws, nx < hole_at ? nx : nx + hole_len); item_load(d1, vb, lane); }
        else {
#pragma unroll
            for (int i = 0; i < 8; ++i) vb[i] = va[i]; }
        item_store(d0, va, s, lane);
        d0 = d1;
#pragma unroll
        for (int i = 0; i < 8; ++i) va[i] = vb[i];
    }
}
__device__ __forceinline__ void tail_convert(const Args& args, unsigned char* ws, int begin, int end, int first_block, int G, int bx, int wave, LAS float* s) {
    int tl = threadIdx.x; asm volatile("" : "+v"(tl));
    if (first_block >= G) { convert_range(args, ws, begin + bx * NWAVES + wave, end, G * NWAVES, s, tl & 63); return; }
    if (bx < first_block) return;
    convert_range(args, ws, begin + (bx - first_block) * NWAVES + wave, end, (G - first_block) * NWAVES, s, tl & 63);
}

__global__ void __launch_bounds__(NWAVES * 64, 2) fwd_kernel(Args args) {
    extern __shared__ __attribute__((aligned(16))) unsigned char lds_raw[];
    LAS unsigned char* lds = (LAS unsigned char*)lds_raw;
    volatile LAS unsigned* MISC = (volatile LAS unsigned*)(lds + MISC_OFF);
    const int tid = threadIdx.x, wave = __builtin_amdgcn_readfirstlane(tid >> 6);
#define PHASE_LANE() int tidp = threadIdx.x; asm volatile("" : "+v"(tidp)); const int lane = tidp & 63; (void)lane
    const int G = gridDim.x, bx = blockIdx.x;
    const int vcu = (G % 8 == 0) ? (bx % 8) * (G / 8) + bx / 8 : bx;
    const int gw = vcu * NWAVES + wave, NGW = G * NWAVES;
    unsigned char* ws = args.ws;
    gu32* ctl = (gu32*)(ws + WS_CTL);
    for (int u = tid; u < (LDS_BYTES - LDSCTL_OFF) / 4; u += NWAVES * 64) ((LAS unsigned*)(lds + LDSCTL_OFF))[u] = 0u;
    __syncthreads();
    XcdBarrier bar = xcd_barrier_post((unsigned*)(ctl + CW_BAR), MISC + 8);
    LAS unsigned char* scr = lds + RING_OFF + wave * 16384;

    float* MODP = (float*)(ws + WS_MODP); float* MOD = (float*)(ws + WS_MOD); float* TAB = (float*)(ws + WS_TAB); float* LBT = (float*)(ws + WS_TAB + 512 * 1024);
    bf16* W13A = (bf16*)(ws + WS_W13A); bf16* W2A = (bf16*)(ws + WS_W2A); bf16* WIN = (bf16*)(ws + WS_WIN); bf16* WGLU = (bf16*)(ws + WS_WGLU); bf16* WPA = (bf16*)(ws + WS_WPA);
    bf16* WPB = (bf16*)(ws + WS_WPB); bf16* WOUT = (bf16*)(ws + WS_WOUT); bf16* W13B = (bf16*)(ws + WS_W13B); bf16* W2B = (bf16*)(ws + WS_W2B);
    bf16* ZN = (bf16*)(ws + WS_ZN); bf16* HID = (bf16*)(ws + WS_HID); pg8::h16_t* HB = (pg8::h16_t*)(ws + WS_H); pg8::h16_t* UA = (pg8::h16_t*)(ws + WS_UA);
    bf16* QB_ = (bf16*)(ws + WS_Q); bf16* VB_ = (bf16*)(ws + WS_V); bf16* OGB = (bf16*)(ws + WS_OG); pg8::h16_t* LFF = (pg8::h16_t*)(ws + WS_LFF); pg8::h16_t* LFB = (pg8::h16_t*)(ws + WS_LFB);
    bf16* SGA = (bf16*)(ws + WS_SGA); bf16* SGB = (bf16*)(ws + WS_SGB); float* XEND = (float*)(ws + WS_XEND); bf16* GA = (bf16*)(ws + WS_GA); bf16* YY = (bf16*)(ws + WS_Y); bf16* WP = (bf16*)(ws + WS_WP);
    bf16* OHG = (bf16*)(ws + WS_OHG); float* PT = (float*)(ws + WS_PT); bf16* MRG = (bf16*)(ws + WS_MRG);

    {
        PHASE_LANE();
        for (int idx = bx * (NWAVES * 64) + tidp; idx < 8192 + 4096; idx += G * NWAVES * 64) {
            if (idx < 8192) s5_table_entry(args.in[I_LAMRE], args.in[I_LAMIM], args.in[I_LOGDT], TAB, idx);
            else { const int j = idx - 8192, d = j >> 11, cc = j & 2047; const float l0 = args.in[I_LBLOG][(d * 2 + 0) * D_B + cc], l1 = args.in[I_LBLOG][(d * 2 + 1) * D_B + cc]; LBT[j] = 1.0f / (1.0f + expf(l1 - l0)); }
        }
        if (NGW > ADA_TASKS) {
            int per = (P0_ITEMS + ADA_TASKS * 64 + NGW - 1) / NGW; if (per < 64) per = 64;
            const int a = per - 64, s1 = (a * NGW < P0_ITEMS) ? a * NGW : P0_ITEMS;
            convert_range(args, ws, gw, s1, NGW, (LAS float*)scr, lane, P0_HOLE, TAIL2_ITEMS);
            if (gw < ADA_TASKS) p0_ada_task(args.in[I_C], args.in[I_CCTX], args.in[I_WADA], MODP, gw, (LAS float*)scr, lane);
            else convert_range(args, ws, s1 + (gw - ADA_TASKS), P0_ITEMS, NGW - ADA_TASKS, (LAS float*)scr, lane, P0_HOLE, TAIL2_ITEMS);
        } else {
            for (int t = gw; t < ADA_TASKS; t += NGW) p0_ada_task(args.in[I_C], args.in[I_CCTX], args.in[I_WADA], MODP, t, (LAS float*)scr, lane);
            convert_range(args, ws, gw, P0_ITEMS, NGW, (LAS float*)scr, lane, P0_HOLE, TAIL2_ITEMS);
        }
    }
    xcd_barrier(bar);
    { PHASE_LANE();
    for (int idx = bx * (NWAVES * 64) + tidp; idx < 5 * NMODC_; idx += G * NWAVES * 64) {
        float s = args.in[I_BADA][idx % NMODC_];
#pragma unroll
        for (int k = 0; k < ADA_KS; ++k) s += MODP[(size_t)k * 5 * NMODC_ + idx];
        MOD[idx] = s;
    } }
    xcd_barrier(bar);
    { PHASE_LANE();
    for (int m = gw; m < RT; m += NGW) { const int b = m / RPB, t = m - b * RPB; const bool isctx = t < CTX_LEN;
        const float* src = isctx ? args.in[I_CTX] + ((size_t)b * CTX_LEN + t) * D_MODEL : args.in[I_X] + ((size_t)b * SEQ + (t - CTX_LEN)) * D_MODEL;
        const float* mv = MOD + (size_t)(isctx ? 4 : b) * NMODC_;
        norm_mod_row(src, args.in[I_NORM1], mv + 0 * D_MODEL, mv + 1 * D_MODEL, ZN + (size_t)m * D_MODEL, lane); } }
    xcd_barrier(bar);
    { pg8::Gemm g{ZN, W13A, RT, 2 * D_FF, D_MODEL}; pg8::TileOrder S; S.init(36, 86, G, bx, 0); pg8::EpiSwiGLU E{HID, D_FFP};
      pg8::gemm_phase<pg8::EpiSwiGLU, pg8::TileOrder, true, true>(lds + RING_OFF, g, S, E); }
    tail_convert(args, ws, ITB_WIN, ITB_WIN + TAIL2_ITEMS, (36 * 86) % 256, G, bx, wave, (LAS float*)scr);
    xcd_barrier(bar);
    { pg8::Gemm g{HID, W2A, RT, D_MODEL, D_FF, D_FFP}; pg8::DownSplitOrder S; S.init(G, bx); pg8::EpiDown1 E{{args.in[I_X], args.in[I_CTX], HB, nullptr, MOD, 2, 0.5f}, (pg8::h16_t*)PT};
      pg8::gemm_phase<pg8::EpiDown1, pg8::DownSplitOrder, true, true>(lds + RING_OFF, g, S, E); }
    xcd_barrier(bar);
    { PHASE_LANE();
    for (int m = gw; m < RT; m += NGW) { const int b = m / RPB, t = m - b * RPB; const bool isctx = t < CTX_LEN;
        const float* mv = MOD + (size_t)(isctx ? 4 : b) * NMODC_;
        int ln = lane; asm volatile("" : "+v"(ln));
        if (isctx) norm_mod_row_part(args.in[I_CTX] + ((size_t)b * CTX_LEN + t) * D_MODEL, (const pg8::h16_t*)PT + ((size_t)b * CTX_LEN + t) * D_MODEL, mv + 2 * D_MODEL, args.in[I_NORMMIX], mv + 3 * D_MODEL, mv + 4 * D_MODEL, ZN + (size_t)m * D_MODEL, ln);
        else norm_mod_row_h(HB + (size_t)m * D_MODEL, args.in[I_NORMMIX], mv + 3 * D_MODEL, mv + 4 * D_MODEL, ZN + (size_t)m * D_MODEL, ln);
    } }
    xcd_barrier(bar);
    { pg8::Gemm g{ZN, WIN, RT, N_IN, D_MODEL}; pg8::TileOrder2 S; S.init(28, 48, G, bx); pg8::EpiWin E{UA, QB_, LFF, SGA, LBT};
      pg8::gemm_phase<pg8::EpiWin, pg8::TileOrder2, true, true>(lds + RING_OFF, g, S, E); }
    tail_convert(args, ws, T_ITEMS - IT_FF, T_ITEMS - IT_FF + TAIL5_ITEMS, (36 * 28 + 32 * 48) % 256, G, bx, wave, (LAS float*)scr);
    xcd_barrier(bar);
    { PHASE_LANE();
      constexpr int NTA = BATCH * 2 * S5_G * NCHUNK, NTC = BATCH * S5_G * 32;
      const bool hgblk = (G > 128) && (bx < 128);
      const unsigned nprod = (G > 128) ? (unsigned)(G - 128) : (unsigned)G;
      for (int u = bx; u < 128; u += G) hgrn2_unit(lds + RING_OFF, u, QB_, VB_, LFF, LFB, OHG, tidp);
      if (!hgblk) {
          for (;;) {
              int base = 0; if (lane == 0) base = (int)__hip_atomic_fetch_add((unsigned*)(ctl + CW_QUEUE), 4u, RLX_AGENT);
              base = __builtin_amdgcn_readfirstlane(base);
              if (base >= NTA) break;
#pragma unroll 1
              for (int t = base; t < base + 4; ++t) s5_pass_a(scr, t, TAB, args.in[I_BRE], args.in[I_BIM], UA, XEND, lane);
          }
          asm volatile("s_waitcnt vmcnt(0)" ::: "memory");
          __syncthreads();
          if (tidp == 0) (void)__hip_atomic_fetch_add((unsigned*)(ctl + CW_DONE), 1u, RLX_AGENT);
      }
      if (tidp == 0) { unsigned sp = 0;
          while (__hip_atomic_load((unsigned*)(ctl + CW_DONE), RLX_AGENT) < nprod) { __builtin_amdgcn_s_sleep(8);
              if ((++sp & 255u) == 0u) { if (xb_ld((unsigned*)(ctl + CW_BAR) + XB_TMO)) break; if (sp > (1u << 20)) { atomicAdd((unsigned*)(ctl + CW_BAR) + XB_TMO, 1u); break; } } }
          __builtin_amdgcn_fence(__ATOMIC_ACQUIRE, "agent");
          asm volatile("s_waitcnt vmcnt(0)" ::: "memory"); }
      __syncthreads();
      for (;;) {
          int base = 0; if (lane == 0) base = (int)__hip_atomic_fetch_add((unsigned*)(ctl + CW_QUEUE2), 2u, RLX_AGENT);
          base = __builtin_amdgcn_readfirstlane(base);
          if (base >= NTC) break;
#pragma unroll 1
          for (int t = base; t < base + 2; ++t) s5_pass_c(scr, t, TAB, args.in[I_BRE], args.in[I_BIM], args.in[I_CRE], args.in[I_CIM], args.in[I_S5D], UA, XEND, GA, lane);
      }
      for (;;) {
          int base = 0; if (lane == 0) base = (int)__hip_atomic_fetch_add((unsigned*)(ctl + CW_QUEUE3), 8u, RLX_AGENT);
          base = __builtin_amdgcn_readfirstlane(base);
          if (base >= CONV6_ITEMS) break;
          const int i0 = T_ITEMS - IT_FF - CONV6_ITEMS + base;
          convert_range(args, ws, i0, i0 + 8, 1, (LAS float*)scr, lane);
      }
    }
    xcd_barrier(bar);
    const bool glu_split = (G == 256);
    if (glu_split && bx < 128) {
      pg8::Gemm g{GA, WGLU, RT, D_A, D_A}; pg8::TileOrder S; S.init(32, 4, 128, bx, 1); pg8::EpiGlu E{GA, YY + D_B};
      pg8::gemm_phase<pg8::EpiGlu, pg8::TileOrder, true, true>(lds + RING_OFF, g, S, E);
    } else { PHASE_LANE();
    const int gw7 = glu_split ? (bx - 128) * NWAVES + wave : gw, ngw7 = glu_split ? NGW - 128 * NWAVES : NGW;
    for (int t = gw7; t < BATCH * SEQ; t += ngw7) hg_finalize_row(t, OHG, OGB, args.in[I_HGNORM], YY, lane);
    }
    xcd_barrier(bar);
    if (!glu_split) { pg8::Gemm g{GA, WGLU, RT, D_A, D_A}; pg8::TileOrder S; S.init(32, 4, G, bx, 1); pg8::EpiGlu E{GA, YY + D_B};
      pg8::gemm_phase<pg8::EpiGlu, pg8::TileOrder, true, true>(lds + RING_OFF, g, S, E); xcd_barrier(bar); }
    { pg8::Gemm g{YY, WP, RT, D_MODEL, D_B + D_A}; pg8::TileOrder S; S.init(32, 16, G, bx, 1); pg8::EpiMerge E{SGA, SGB, MRG};
      pg8::gemm_phase<pg8::EpiMerge, pg8::TileOrder, true, true>(lds + RING_OFF, g, S, E); }
    xcd_barrier(bar);
    { pg8::Gemm g{MRG, WOUT, RT, D_MODEL, D_MODEL}; pg8::TileOrder S; S.init(32, 16, G, bx, 1); pg8::EpiResid<1, 0> E{nullptr, nullptr, HB, nullptr, MOD, 5, 1.0f};
      pg8::gemm_phase<pg8::EpiResid<1, 0>, pg8::TileOrder, true, true>(lds + RING_OFF, g, S, E); }
    xcd_barrier(bar);
    { PHASE_LANE();
    for (int lr = gw; lr < BATCH * SEQ; lr += NGW) { const int b = lr >> 11, m = b * RPB + CTX_LEN + (lr & 2047);
        const float* mv = MOD + (size_t)b * NMODC_;
        norm_mod_row_h(HB + (size_t)m * D_MODEL, args.in[I_NORM2], mv + 6 * D_MODEL, mv + 7 * D_MODEL, ZN + (size_t)m * D_MODEL, lane); } }
    xcd_barrier(bar);
    { pg8::Gemm g{ZN, W13B, RT, 2 * D_FF, D_MODEL}; pg8::TileOrder S; S.init(32, 86, G, bx, 1); pg8::EpiSwiGLU E{HID, D_FFP};
      pg8::gemm_phase<pg8::EpiSwiGLU, pg8::TileOrder, true, true>(lds + RING_OFF, g, S, E); }
    tail_convert(args, ws, T_ITEMS - IT_FF + TAIL5_ITEMS, T_ITEMS, (32 * 86) % 256, G, bx, wave, (LAS float*)scr);
    xcd_barrier(bar);
    { pg8::Gemm g{HID, W2B, RT, D_MODEL, D_FF, D_FFP}; pg8::HalfRowsOrder S; S.init(G, bx); pg8::EpiResid<1, 0> E{nullptr, nullptr, HB, nullptr, MOD, 8, 0.5f};
      pg8::gemm_phase<pg8::EpiResid<1, 0>, pg8::HalfRowsOrder, true, true>(lds + RING_OFF, g, S, E); }
    xcd_barrier(bar);
    { PHASE_LANE();
    const bool tmo_set = __hip_atomic_load((unsigned*)(ctl + CW_BAR) + XB_TMO, RLX_AGENT) != 0u;
    for (int lr = gw; lr < BATCH * SEQ; lr += NGW) { norm_final_row_h(HB + ((size_t)(lr >> 11) * RPB + CTX_LEN + (lr & 2047)) * D_MODEL, args.out + (size_t)lr * D_MODEL, args.in[I_NORMF], lane);
        if (tmo_set) { GAS f32x4* xr = (GAS f32x4*)(args.out + (size_t)lr * D_MODEL) + lane;
#pragma unroll
            for (int j = 0; j < 16; ++j) xr[64 * j] = (f32x4){1e30f, 1e30f, 1e30f, 1e30f}; } } }
}

extern "C" void kernel_launch(void* const* d_in, const int* in_sizes, int n_in, void* d_out, int out_size, void* d_ws, size_t ws_size, hipStream_t stream) {
    static int grid = 0;
    if (grid == 0) {
        if (n_in != 31 || out_size != BATCH * SEQ * D_MODEL || ws_size < WS_END) { fprintf(stderr, "kernel_launch: unexpected shapes (n_in %d, out %d, ws %zu)\n", n_in, out_size, ws_size); grid = -1; return; }
        int dev = 0, cus = 0, per_cu = 0;
        if (hipGetDevice(&dev) != hipSuccess || hipDeviceGetAttribute(&cus, hipDeviceAttributeMultiprocessorCount, dev) != hipSuccess) { grid = -1; return; }
        if (hipFuncSetAttribute((const void*)fwd_kernel, hipFuncAttributeMaxDynamicSharedMemorySize, LDS_BYTES) != hipSuccess) { fprintf(stderr, "kernel_launch: hipFuncSetAttribute failed\n"); grid = -1; return; }
        if (hipOccupancyMaxActiveBlocksPerMultiprocessor(&per_cu, (const void*)fwd_kernel, NWAVES * 64, LDS_BYTES) != hipSuccess || per_cu < 1)
            fprintf(stderr, "kernel_launch: note: occupancy query reports %d workgroups per CU\n", per_cu);
        (void)hipGetLastError();
        grid = cus;
    }
    if (grid < 0) return;
    if (hipMemsetAsync((char*)d_ws + WS_CTL, 0, CTL_ZERO_BYTES, stream) != hipSuccess) { fprintf(stderr, "kernel_launch: memset failed\n"); return; }
    Args a{};
    for (int i = 0; i < 31; ++i) a.in[i] = (const float*)d_in[i];
    a.out = (float*)d_out; a.ws = (unsigned char*)d_ws;
    hipLaunchKernelGGL(fwd_kernel, dim3(grid), dim3(NWAVES * 64), LDS_BYTES, stream, a);
    const hipError_t le = hipPeekAtLastError();
    if (le != hipSuccess) fprintf(stderr, "kernel_launch: launch failed: %s\n", hipGetErrorName(le));
}
```

```cpp
#include <hip/hip_runtime.h>
#include <cstdio>
#include <cstdint>

namespace pg8 {
#define PG8_LAS __attribute__((address_space(3)))
typedef unsigned short bf16_t;
typedef short bf16x8 __attribute__((ext_vector_type(8)));
typedef float f32x4 __attribute__((ext_vector_type(4)));
typedef unsigned u32x4 __attribute__((ext_vector_type(4)));
constexpr int BM = 256, BK = 64, HALF = 128, HTB = HALF * BK * 2  , STAGE_BYTES = 8 * HTB, NXCD = 8, WGM = 8;

__host__ __device__ __forceinline__ int lds_byte(int r, int c) { const int st = (r >> 4) * 2 + (c >> 5), rr = r & 15, cc = c & 31, ob = rr * 64 + cc * 2; return st * 1024 + (ob ^ (((ob >> 9) & 1) << 5)); }
__host__ __device__ __forceinline__ void stage_rc(int b, int& R, int& C) { const int st = b / 1024, sb = b % 1024, swz = sb ^ (((sb >> 9) & 1) << 5); R = (st >> 1) * 16 + swz / 64; C = (st & 1) * 32 + (swz % 64) / 2; }
__host__ __device__ __forceinline__ int perm32(int rho) { const int n = rho >> 4, i = rho & 15; return 8 * (i >> 2) + 4 * n + (i & 3); }

struct Unit { int pm, pn; };
struct Gemm { const bf16_t* A; const bf16_t* Bt; int M, N, K, LD = 0; };

struct StaticOrder {
    static constexpr bool SPLITK = false;
    int nM, nN, nwg, G, c;
    __host__ __device__ void init(int M, int N, int G_, int c_) { nM = M / BM; nN = N / BM; nwg = nM * nN; G = G_; c = c_; }
    __host__ __device__ bool next(int i, Unit& u) const {
        const long L = (long)i * G + c; if (L >= nwg) return false;
        int wgid = (int)L; { const int q = nwg / NXCD, r = nwg % NXCD, xcd = wgid % NXCD, off = wgid / NXCD; wgid = (xcd < r ? xcd * (q + 1) : r * (q + 1) + (xcd - r) * q) + off; }
        const int nig = WGM * nN, gid = wgid / nig, fm = gid * WGM, gsz = (nM - fm) < WGM ? (nM - fm) : WGM;
        u.pm = fm + ((wgid % nig) % gsz); u.pn = (wgid % nig) / gsz; return true;
    }
    __device__ __forceinline__ void a_ready(const Unit&) const {}
    __device__ __forceinline__ void done(const Unit&) const {}
};


struct TileOrder2 {
    static constexpr bool SPLITK = false;
    int n1c, n2c, nwg1, nwg, G, c;
    __host__ __device__ void init(int n1c_, int n2c_, int G_, int c_) { n1c = n1c_; n2c = n2c_; nwg1 = 36 * n1c; nwg = nwg1 + 32 * n2c; G = G_; c = c_; }
    __host__ __device__ static void map(int L, int nM, int nN, int& pm, int& pn) {
        const int nwg = nM * nN; int wgid = L; { const int q = nwg / NXCD, r = nwg % NXCD, xcd = wgid % NXCD, off = wgid / NXCD; wgid = (xcd < r ? xcd * (q + 1) : r * (q + 1) + (xcd - r) * q) + off; }
        const int nig = WGM * nN, gid = wgid / nig, fm = gid * WGM, gsz = (nM - fm) < WGM ? (nM - fm) : WGM;
        pm = fm + ((wgid % nig) % gsz); pn = (wgid % nig) / gsz; }
    __host__ __device__ bool next(int i, Unit& u) const {
        const long L = (long)i * G + c; if (L >= nwg) return false;
        int pm, pn;
        if (L < nwg1) map((int)L, 36, n1c, pm, pn);
        else { map((int)L - nwg1, 32, n2c, pm, pn); pm = (pm >> 3) * 9 + 1 + (pm & 7); pn += n1c; }
        u.pm = pm; u.pn = pn; return true;
    }
    __device__ __forceinline__ void a_ready(const Unit&) const {}
    __device__ __forceinline__ void done(const Unit&) const {}
};
struct TileOrder {
    static constexpr bool SPLITK = false;
    int nM, nN, nwg, G, c, lat_only;
    __host__ __device__ void init(int nM_, int nN_, int G_, int c_, int lat_only_) { nM = nM_; nN = nN_; nwg = nM * nN; G = G_; c = c_; lat_only = lat_only_; }
    __host__ __device__ bool next(int i, Unit& u) const {
        const long L = (long)i * G + c; if (L >= nwg) return false;
        int wgid = (int)L; { const int q = nwg / NXCD, r = nwg % NXCD, xcd = wgid % NXCD, off = wgid / NXCD; wgid = (xcd < r ? xcd * (q + 1) : r * (q + 1) + (xcd - r) * q) + off; }
        const int nig = WGM * nN, gid = wgid / nig, fm = gid * WGM, gsz = (nM - fm) < WGM ? (nM - fm) : WGM;
        int pm = fm + ((wgid % nig) % gsz); u.pn = (wgid % nig) / gsz;
        if (lat_only) pm = (pm >> 3) * 9 + 1 + (pm & 7);
        u.pm = pm; return true;
    }
    __device__ __forceinline__ void a_ready(const Unit&) const {}
    __device__ __forceinline__ void done(const Unit&) const {}
};

struct HalfRowsOrder {
    static constexpr bool SPLITK = false, STAGGER = false;
    TileOrder fb; int G, c;
    __host__ __device__ void init(int G_, int c_) { fb.init(32, 16, G_, c_, 1); G = G_; c = c_; }
    __host__ __device__ bool next(int i, Unit& u) const {
        if (G != 256) return fb.next(i, u);
        if (i >= 2) return false;
        const int x = c & 7, j = c >> 3, pl = 16 * i + 4 * (x >> 1) + (j & 3);
        u.pm = (pl >> 3) * 9 + 1 + (pl & 7); u.pn = 8 * (x & 1) + (j >> 2); return true;
    }
    __device__ __forceinline__ void a_ready(const Unit&) const {}
    __device__ __forceinline__ void done(const Unit&) const {}
};
struct DownSplitOrder {
    static constexpr bool SPLITK = true;
    HalfRowsOrder lat; int G, c;
    __host__ __device__ void init(int G_, int c_) { lat.init(G_, c_); G = G_; c = c_; }
    __host__ __device__ bool next(int i, Unit& u) const {
        const long L = (long)i * G + c; if (L >= 512 + 256) return false;
        if (L < 512) return lat.next(i, u);
        const int idx = (int)L - 512;
        u.pm = 9 * (idx >> 6); u.pn = ((idx >> 2) & 15) | (((idx & 3) + 1) << 8); return true;
    }
    __host__ __device__ static int kt0(const Unit& u) { const int q = u.pn >> 8; return q == 0 ? 0 : (q - 1) * 44 - (q == 4 ? 2 : 0); }
    __host__ __device__ static int cnt(const Unit& u, int full) { const int q = u.pn >> 8; return q == 0 ? full : (q <= 2 ? 44 : 42); }
    __device__ __forceinline__ void a_ready(const Unit&) const {}
    __device__ __forceinline__ void done(const Unit&) const {}
};

typedef float f32x2_cv __attribute__((ext_vector_type(2)));
typedef __bf16 bf16x2_cv __attribute__((ext_vector_type(2)));
__device__ __forceinline__ unsigned cvt_pk_bf16(float lo, float hi) { const f32x2_cv v = {lo, hi}; const bf16x2_cv b = __builtin_convertvector(v, bf16x2_cv); return __builtin_bit_cast(unsigned, b); }
typedef _Float16 h16x2_cv __attribute__((ext_vector_type(2)));
typedef unsigned short h16_t;
__device__ __forceinline__ unsigned cvt_pk_f16(float lo, float hi) { const f32x2_cv v = {lo, hi}; const h16x2_cv h = __builtin_convertvector(v, h16x2_cv); return __builtin_bit_cast(unsigned, h); }
__device__ __forceinline__ f32x2_cv unpk_f16(unsigned w) { const h16x2_cv h = __builtin_bit_cast(h16x2_cv, w); return __builtin_convertvector(h, f32x2_cv); }
__device__ __forceinline__ float bf_lo(unsigned w) { return __uint_as_float(w << 16); }
__device__ __forceinline__ float bf_hi(unsigned w) { return __uint_as_float(w & 0xffff0000u); }
__device__ __forceinline__ float sigmoid_f(float x) { return __builtin_amdgcn_rcpf(1.0f + __builtin_amdgcn_exp2f(-1.4426950408889634f * x)); }
__device__ __forceinline__ float silu_f(float x) { return x * sigmoid_f(x); }

constexpr int TOK_ROWS = 9216, ROWS_PER_B = 2304, CTXR = 256, LATR = 2048, DM = 4096, NMODC = 36864, DY = 3072;


#define EPI_PIN(x) do { asm volatile("" : "+v"(x)); __builtin_amdgcn_sched_barrier(0); } while (0)
struct EpiSwiGLU {
    static constexpr bool PERM = true, AFTER_DRAIN = false;
    bf16_t* H; int ldh;
    __device__ __forceinline__ void operator()(const f32x4 (&acc)[2][2][4][2], const Unit& u, int wr, int wc, int fr, int fq) const {
        size_t off = (size_t)(u.pm * BM + wr * 64 + fr) * ldh + u.pn * HALF + wc * 32 + 8 * fq;
#pragma unroll
        for (int ai = 0; ai < 2; ++ai) {
#pragma unroll
            for (int m = 0; m < 4; ++m) { EPI_PIN(off);
                const f32x4 a0 = acc[ai][0][m][0], a1 = acc[ai][0][m][1], b0 = acc[ai][1][m][0], b1 = acc[ai][1][m][1];
                u32x4 w; w.x = cvt_pk_bf16(silu_f(a0[0]) * b0[0], silu_f(a0[1]) * b0[1]); w.y = cvt_pk_bf16(silu_f(a0[2]) * b0[2], silu_f(a0[3]) * b0[3]);
                w.z = cvt_pk_bf16(silu_f(a1[0]) * b1[0], silu_f(a1[1]) * b1[1]); w.w = cvt_pk_bf16(silu_f(a1[2]) * b1[2], silu_f(a1[3]) * b1[3]);
                *(u32x4*)(H + off) = w; off += (size_t)16 * ldh; }
            off += (size_t)64 * ldh; }
    }
};

template <int BASE_MODE, int OUT_MODE> struct EpiResid {
    static constexpr bool PERM = true, AFTER_DRAIN = false;
    const float* x; const float* ctx; h16_t* hbuf; float* dout; const float* mod; int mchunk; float coef;
    __device__ __forceinline__ void operator()(const f32x4 (&acc)[2][2][4][2], const Unit& u, int wr, int wc, int fr, int fq) const {
        const int b = u.pm / 9, tt = u.pm - 9 * b; const bool isctx = (tt == 0);
        const float* basep = nullptr; const h16_t* baseh = nullptr; float* outp = nullptr; h16_t* outh = nullptr;
        if (BASE_MODE == 0) basep = isctx ? ctx + (size_t)b * CTXR * DM : x + ((size_t)b * LATR + (size_t)(tt - 1) * BM) * DM; else baseh = hbuf + (size_t)u.pm * BM * DM;
        if (OUT_MODE == 0) outh = hbuf + (size_t)u.pm * BM * DM; else outp = dout + ((size_t)b * LATR + (size_t)(tt - 1) * BM) * DM;
        const float* mv = mod + (size_t)(isctx ? 4 : b) * NMODC + (size_t)mchunk * DM;
        const int col0 = u.pn * BM + wc * 32 + 8 * fq;
        f32x4 g[2][2];
#pragma unroll
        for (int bj = 0; bj < 2; ++bj)
#pragma unroll
            for (int n = 0; n < 2; ++n) g[bj][n] = *(const f32x4*)(mv + col0 + bj * HALF + 4 * n) * coef;
        const size_t off0 = (size_t)(wr * 64 + fr) * DM + col0;
        f32x4 bs[4][2][2][2]; u32x4 bh[4][2][2];
#define ERES_LOAD(bt) _Pragma("unroll") for (int mm = 0; mm < 2; ++mm) { const size_t o = off0 + (size_t)(((bt) >> 1) * HALF + (((bt) & 1) * 2 + mm) * 16) * DM; \
            _Pragma("unroll") for (int bj = 0; bj < 2; ++bj) { if constexpr (BASE_MODE == 0) { _Pragma("unroll") for (int n = 0; n < 2; ++n) bs[bt][mm][bj][n] = *(const f32x4*)(basep + o + bj * HALF + 4 * n); } \
                else bh[bt][mm][bj] = *(const u32x4*)(baseh + o + bj * HALF); } }
#define ERES_DONE(bt) _Pragma("unroll") for (int mm = 0; mm < 2; ++mm) { const size_t o = off0 + (size_t)(((bt) >> 1) * HALF + (((bt) & 1) * 2 + mm) * 16) * DM; \
            _Pragma("unroll") for (int bj = 0; bj < 2; ++bj) { f32x4 b0, b1; \
                if constexpr (BASE_MODE == 0) { b0 = bs[bt][mm][bj][0]; b1 = bs[bt][mm][bj][1]; } \
                else { const u32x4 w = bh[bt][mm][bj]; const f32x2_cv p0 = unpk_f16(w.x), p1 = unpk_f16(w.y), p2 = unpk_f16(w.z), p3 = unpk_f16(w.w); b0 = (f32x4){p0.x, p0.y, p1.x, p1.y}; b1 = (f32x4){p2.x, p2.y, p3.x, p3.y}; } \
                const f32x4 r0 = b0 + g[bj][0] * acc[(bt) >> 1][bj][((bt) & 1) * 2 + mm][0], r1 = b1 + g[bj][1] * acc[(bt) >> 1][bj][((bt) & 1) * 2 + mm][1]; \
                if constexpr (OUT_MODE == 0) { u32x4 w; w.x = cvt_pk_f16(r0[0], r0[1]); w.y = cvt_pk_f16(r0[2], r0[3]); w.z = cvt_pk_f16(r1[0], r1[1]); w.w = cvt_pk_f16(r1[2], r1[3]); *(u32x4*)(outh + o + bj * HALF) = w; } \
                else { *(f32x4*)(outp + o + bj * HALF) = r0; *(f32x4*)(outp + o + bj * HALF + 4) = r1; } } }
        ERES_LOAD(0) __builtin_amdgcn_sched_barrier(0);
        ERES_LOAD(1) __builtin_amdgcn_sched_barrier(0);
        ERES_DONE(0) __builtin_amdgcn_sched_barrier(0);
        ERES_LOAD(2) __builtin_amdgcn_sched_barrier(0);
        ERES_DONE(1) __builtin_amdgcn_sched_barrier(0);
        ERES_LOAD(3) __builtin_amdgcn_sched_barrier(0);
        ERES_DONE(2) __builtin_amdgcn_sched_barrier(0);
        ERES_DONE(3)
#undef ERES_LOAD
#undef ERES_DONE
    }
};

struct EpiDown1 {
    static constexpr bool PERM = true, AFTER_DRAIN = false;
    EpiResid<0, 0> R; h16_t* part;
    __device__ __forceinline__ void operator()(const f32x4 (&acc)[2][2][4][2], const Unit& u, int wr, int wc, int fr, int fq) const {
        const int q = u.pn >> 8;
        if (q == 0) { R(acc, u, wr, wc, fr, fq); return; }
        size_t off = ((size_t)(q - 1) * 1024 + (size_t)(u.pm / 9) * CTXR + wr * 64 + fr) * DM + (u.pn & 255) * BM + wc * 32 + 8 * fq;
#pragma unroll
        for (int ai = 0; ai < 2; ++ai) {
#pragma unroll
            for (int m = 0; m < 4; ++m) { EPI_PIN(off);
#pragma unroll
                for (int bj = 0; bj < 2; ++bj) { const f32x4 v0 = acc[ai][bj][m][0], v1 = acc[ai][bj][m][1];
                    u32x4 w; w.x = cvt_pk_f16(v0[0], v0[1]); w.y = cvt_pk_f16(v0[2], v0[3]); w.z = cvt_pk_f16(v1[0], v1[1]); w.w = cvt_pk_f16(v1[2], v1[3]);
                    *(u32x4*)(part + off + bj * HALF) = w; }
                off += (size_t)16 * DM; }
            off += (size_t)64 * DM; }
    }
};

struct EpiWin {
    static constexpr bool PERM = true, AFTER_DRAIN = false;
    h16_t* UA; bf16_t* Q; h16_t* LFF; bf16_t* SGA; const float* lbt;
    static constexpr size_t QSTRIDE = (size_t)36 * 1048576 / 2, LFSTRIDE = (size_t)72 * 1048576 / 2, SGSTRIDE = (size_t)72 * 1048576 / 2;
    __device__ __forceinline__ void operator()(const f32x4 (&acc)[2][2][4][2], const Unit& u, int wr, int wc, int fr, int fq) const {
        const int pn = u.pn, row0 = u.pm * BM + wr * 64 + fr, cl = wc * 32 + 8 * fq;
        if (pn < 4) {
            size_t off = (size_t)row0 * 1024 + pn * BM + cl;
#pragma unroll
            for (int ai = 0; ai < 2; ++ai) {
#pragma unroll
                for (int m = 0; m < 4; ++m) { EPI_PIN(off);
#pragma unroll
                    for (int bj = 0; bj < 2; ++bj) { const f32x4 v0 = acc[ai][bj][m][0], v1 = acc[ai][bj][m][1];
                        u32x4 w; w.x = cvt_pk_f16(v0[0], v0[1]); w.y = cvt_pk_f16(v0[2], v0[3]); w.z = cvt_pk_f16(v1[0], v1[1]); w.w = cvt_pk_f16(v1[2], v1[3]);
                        *(u32x4*)(UA + off + bj * HALF) = w; }
                    off += (size_t)16 * 1024; }
                off += (size_t)64 * 1024; }
        } else if (pn < 12 || (pn >= 28 && pn < 44)) {
            const int sel = (pn < 12) ? 1 : ((pn >= 36) ? 2 : 0), cb = (pn - (sel == 1 ? 4 : (sel == 2 ? 36 : 28))) * BM;
            size_t off = (size_t)sel * QSTRIDE + (size_t)row0 * 2048 + cb + cl;
#pragma unroll
            for (int ai = 0; ai < 2; ++ai) {
#pragma unroll
                for (int m = 0; m < 4; ++m) { EPI_PIN(off);
#pragma unroll
                    for (int bj = 0; bj < 2; ++bj) { const f32x4 v0 = acc[ai][bj][m][0], v1 = acc[ai][bj][m][1];
                        u32x4 w; w.x = cvt_pk_bf16(v0[0], v0[1]); w.y = cvt_pk_bf16(v0[2], v0[3]); w.z = cvt_pk_bf16(v1[0], v1[1]); w.w = cvt_pk_bf16(v1[2], v1[3]);
                        *(u32x4*)(Q + off + bj * HALF) = w; }
                    off += (size_t)16 * 2048; }
                off += (size_t)64 * 2048; }
        } else if (pn < 28) {
            const int dirb = (pn >= 20) ? 1 : 0, cb = (pn - (dirb ? 20 : 12)) * BM;
            const float* lb = lbt + dirb * 2048 + cb + cl;
            f32x4 l[2][2];
#pragma unroll
            for (int bj = 0; bj < 2; ++bj)
#pragma unroll
                for (int n = 0; n < 2; ++n) l[bj][n] = *(const f32x4*)(lb + bj * HALF + 4 * n);
            size_t off = (size_t)dirb * LFSTRIDE + (size_t)row0 * 2048 + cb + cl;
#pragma unroll
            for (int ai = 0; ai < 2; ++ai) {
#pragma unroll
                for (int m = 0; m < 4; ++m) { EPI_PIN(off);
#pragma unroll
                    for (int bj = 0; bj < 2; ++bj) { f32x4 o[2];
#pragma unroll
                        for (int n = 0; n < 2; ++n) { f32x4 a = acc[ai][bj][m][n]; asm volatile("" : "+v"(a));
#pragma unroll
                            for (int j = 0; j < 4; ++j) { const float lbv = l[bj][n][j]; o[n][j] = __logf(lbv + (1.0f - lbv) * sigmoid_f(a[j])); } }
                        u32x4 w; w.x = cvt_pk_f16(o[0][0], o[0][1]); w.y = cvt_pk_f16(o[0][2], o[0][3]); w.z = cvt_pk_f16(o[1][0], o[1][1]); w.w = cvt_pk_f16(o[1][2], o[1][3]);
                        *(u32x4*)(LFF + off + bj * HALF) = w; }
                    off += (size_t)16 * 2048; }
                off += (size_t)64 * 2048; }
        } else {
            size_t off = (size_t)row0 * DM + (pn - 44) * HALF + cl;
#pragma unroll
            for (int ai = 0; ai < 2; ++ai) {
#pragma unroll
                for (int m = 0; m < 4; ++m) { EPI_PIN(off);
                    const f32x4 a0 = acc[ai][0][m][0], a1 = acc[ai][0][m][1], b0 = acc[ai][1][m][0], b1 = acc[ai][1][m][1];
                    u32x4 wa; wa.x = cvt_pk_bf16(sigmoid_f(a0[0]), sigmoid_f(a0[1])); wa.y = cvt_pk_bf16(sigmoid_f(a0[2]), sigmoid_f(a0[3]));
                    wa.z = cvt_pk_bf16(sigmoid_f(a1[0]), sigmoid_f(a1[1])); wa.w = cvt_pk_bf16(sigmoid_f(a1[2]), sigmoid_f(a1[3]));
                    *(u32x4*)(SGA + off) = wa;
#define GRATIO(bv, gw_) (sigmoid_f(bv) * __builtin_amdgcn_rcpf(fmaxf(gw_, 1e-20f)))
                    u32x4 wb; wb.x = cvt_pk_bf16(GRATIO(b0[0], bf_lo(wa.x)), GRATIO(b0[1], bf_hi(wa.x))); wb.y = cvt_pk_bf16(GRATIO(b0[2], bf_lo(wa.y)), GRATIO(b0[3], bf_hi(wa.y)));
                    wb.z = cvt_pk_bf16(GRATIO(b1[0], bf_lo(wa.z)), GRATIO(b1[1], bf_hi(wa.z))); wb.w = cvt_pk_bf16(GRATIO(b1[2], bf_lo(wa.w)), GRATIO(b1[3], bf_hi(wa.w)));
#undef GRATIO
                    *(u32x4*)(SGA + SGSTRIDE + off) = wb;
                    off += (size_t)16 * DM; }
                off += (size_t)64 * DM; }
        }
    }
};

struct EpiGlu {
    static constexpr bool PERM = true, AFTER_DRAIN = false;
    const bf16_t* GA; bf16_t* YA;
    __device__ __forceinline__ void operator()(const f32x4 (&acc)[2][2][4][2], const Unit& u, int wr, int wc, int fr, int fq) const {
        size_t off = (size_t)(u.pm * BM + wr * 64 + fr) * 1024 + u.pn * BM + wc * 32 + 8 * fq, offy = (size_t)(u.pm * BM + wr * 64 + fr) * DY + u.pn * BM + wc * 32 + 8 * fq;
#pragma unroll
        for (int ai = 0; ai < 2; ++ai) {
#pragma unroll
            for (int m = 0; m < 4; ++m) { EPI_PIN(off); EPI_PIN(offy);
#pragma unroll
                for (int bj = 0; bj < 2; ++bj) { const size_t o = off + bj * HALF;
                    const u32x4 gq = *(const u32x4*)(GA + o); const f32x4 v0 = acc[ai][bj][m][0], v1 = acc[ai][bj][m][1];
                    u32x4 w; w.x = cvt_pk_bf16(bf_lo(gq.x) * sigmoid_f(v0[0]), bf_hi(gq.x) * sigmoid_f(v0[1])); w.y = cvt_pk_bf16(bf_lo(gq.y) * sigmoid_f(v0[2]), bf_hi(gq.y) * sigmoid_f(v0[3]));
                    w.z = cvt_pk_bf16(bf_lo(gq.z) * sigmoid_f(v1[0]), bf_hi(gq.z) * sigmoid_f(v1[1])); w.w = cvt_pk_bf16(bf_lo(gq.w) * sigmoid_f(v1[2]), bf_hi(gq.w) * sigmoid_f(v1[3]));
                    *(u32x4*)(YA + offy + bj * HALF) = w; }
                off += (size_t)16 * 1024; offy += (size_t)16 * DY; }
            off += (size_t)64 * 1024; offy += (size_t)64 * DY; }
    }
};

struct EpiMerge {
    static constexpr bool PERM = true, AFTER_DRAIN = false; static constexpr int MID_T = 32;
    const bf16_t* SGA; const bf16_t* SGB; bf16_t* MRG;
    __device__ __forceinline__ void mid(f32x4 (&acc)[2][2][4][2], const Unit& u, int wr, int wc, int fr, int fq) const {
        size_t off = (size_t)(u.pm * BM + wr * 64 + fr) * DM + u.pn * BM + wc * 32 + 8 * fq;
#pragma unroll
        for (int ai = 0; ai < 2; ++ai) {
#pragma unroll
            for (int m = 0; m < 4; ++m) { EPI_PIN(off);
#pragma unroll
                for (int bj = 0; bj < 2; ++bj) { const size_t o = off + bj * HALF;
                    const u32x4 rq = *(const u32x4*)(SGB + o);
                    f32x4 r0, r1; r0[0] = bf_lo(rq.x); r0[1] = bf_hi(rq.x); r0[2] = bf_lo(rq.y); r0[3] = bf_hi(rq.y); r1[0] = bf_lo(rq.z); r1[1] = bf_hi(rq.z); r1[2] = bf_lo(rq.w); r1[3] = bf_hi(rq.w);
                    acc[ai][bj][m][0] *= r0; acc[ai][bj][m][1] *= r1; }
                off += (size_t)16 * DM; }
            off += (size_t)64 * DM; }
    }
    __device__ __forceinline__ void operator()(const f32x4 (&acc)[2][2][4][2], const Unit& u, int wr, int wc, int fr, int fq) const {
        size_t off = (size_t)(u.pm * BM + wr * 64 + fr) * DM + u.pn * BM + wc * 32 + 8 * fq;
#pragma unroll
        for (int ai = 0; ai < 2; ++ai) {
#pragma unroll
            for (int m = 0; m < 4; ++m) { EPI_PIN(off);
#pragma unroll
                for (int bj = 0; bj < 2; ++bj) { const size_t o = off + bj * HALF;
                    const u32x4 ga = *(const u32x4*)(SGA + o);
                    const f32x4 v0 = acc[ai][bj][m][0], v1 = acc[ai][bj][m][1];
                    u32x4 w; w.x = cvt_pk_bf16(fmaxf(bf_lo(ga.x), 1e-20f) * v0[0], fmaxf(bf_hi(ga.x), 1e-20f) * v0[1]); w.y = cvt_pk_bf16(fmaxf(bf_lo(ga.y), 1e-20f) * v0[2], fmaxf(bf_hi(ga.y), 1e-20f) * v0[3]);
                    w.z = cvt_pk_bf16(fmaxf(bf_lo(ga.z), 1e-20f) * v1[0], fmaxf(bf_hi(ga.z), 1e-20f) * v1[1]); w.w = cvt_pk_bf16(fmaxf(bf_lo(ga.w), 1e-20f) * v1[2], fmaxf(bf_hi(ga.w), 1e-20f) * v1[3]);
                    *(u32x4*)(MRG + o) = w; }
                off += (size_t)16 * DM; }
            off += (size_t)64 * DM; }
    }
};
template <class E, class = void> struct HasMid { static constexpr bool value = false; };
template <class E> struct HasMid<E, decltype((void)E::MID_T)> { static constexpr bool value = true; };

template <class Epi, class Sched, bool ALIGN_EPI = false, bool SP2 = false>
__device__ __forceinline__ void gemm_phase(PG8_LAS unsigned char* lds, const Gemm g, const Sched& S, const Epi& E) {
    int tid_ = threadIdx.x; asm volatile("" : "+v"(tid_));
    const int tid = tid_, wid = __builtin_amdgcn_readfirstlane(tid >> 6), lane = tid & 63, wr = wid >> 2, wc = wid & 3, fr = lane & 15, fq = lane >> 4;
    const int K = g.K, nt = K / BK, LD = g.LD ? g.LD : g.K;
    unsigned voffA[2], voffB[2];
#pragma unroll
    for (int i = 0; i < 2; ++i) { int R, C; stage_rc(tid * 16 + i * 8192, R, C); const int Rb = Epi::PERM ? ((R & ~31) + perm32(R & 31)) : R;
        voffA[i] = (unsigned)(R * LD + C) * 2u; voffB[i] = (unsigned)(Rb * LD + C) * 2u; }
    const size_t kstep = (size_t)(BK * 2);
    const size_t hstep = (size_t)HALF * LD * 2;
    const size_t tstep = 2 * hstep;
    const unsigned ldsw = (unsigned)wid * 1024u;
    const int aoff = lds_byte(wr * 64 + fr, fq * 8), boff = lds_byte(wc * 32 + fr, fq * 8);
#define PG8_SA(b, h) (((b) * 2 + (h)) * HTB)
#define PG8_SB(b, h) ((4 + (b) * 2 + (h)) * HTB)
#define PG8_STAGE(bufoff, gbase, voff) do { _Pragma("unroll") for (int _i = 0; _i < 2; ++_i) \
        __builtin_amdgcn_global_load_lds((const unsigned*)((const char*)(gbase) + (voff)[_i]), (PG8_LAS unsigned*)(lds + (bufoff) + ldsw + _i * 8192), 16, 0, 0); } while (0)
#define PG8_LDA(dst, b, h) do { _Pragma("unroll") for (int m = 0; m < 4; ++m) _Pragma("unroll") for (int k = 0; k < 2; ++k) dst[m][k] = *(const PG8_LAS bf16x8*)(lds + PG8_SA(b, h) + aoff + m * 2048 + k * 1024); } while (0)
#define PG8_LDB(dst, b, h) do { _Pragma("unroll") for (int n = 0; n < 2; ++n) _Pragma("unroll") for (int k = 0; k < 2; ++k) dst[n][k] = *(const PG8_LAS bf16x8*)(lds + PG8_SB(b, h) + boff + n * 2048 + k * 1024); } while (0)
#define PG8_MMA(ai, bj, At, Bt) do { __builtin_amdgcn_s_setprio(1); _Pragma("unroll") for (int m = 0; m < 4; ++m) _Pragma("unroll") for (int n = 0; n < 2; ++n) _Pragma("unroll") for (int k = 0; k < 2; ++k) \
        acc[ai][bj][m][n] = __builtin_amdgcn_mfma_f32_16x16x32_bf16(Bt[n][k], At[m][k], acc[ai][bj][m][n], 0, 0, 0); __builtin_amdgcn_s_setprio(0); } while (0)
#define PG8_WAIT_V(n) asm volatile("s_waitcnt vmcnt(" #n ")" ::: "memory")
#define PG8_WAIT_L(n) asm volatile("s_waitcnt lgkmcnt(" #n ")" ::: "memory")
#define PG8_BAR __builtin_amdgcn_s_barrier()
#define PG8_SCHED __builtin_amdgcn_sched_barrier(0)
    Unit cur, nxt; int ui = 0;
    if (!S.next(0, cur)) return;
    f32x4 acc[2][2][4][2];
#pragma unroll
    for (int a = 0; a < 2; ++a)
#pragma unroll
        for (int b = 0; b < 2; ++b)
#pragma unroll
            for (int m = 0; m < 4; ++m)
#pragma unroll
                for (int n = 0; n < 2; ++n) acc[a][b][m][n] = (f32x4){0.f, 0.f, 0.f, 0.f};
    bf16x8 At[4][2], B0[2][2], B1[2][2];
    const char* cA = (const char*)g.A + (size_t)cur.pm * tstep; const char* cB;
    if constexpr (Sched::SPLITK) { cA += (size_t)Sched::kt0(cur) * kstep; cB = (const char*)g.Bt + (size_t)(cur.pn & 255) * tstep + (size_t)Sched::kt0(cur) * kstep; } else cB = (const char*)g.Bt + (size_t)cur.pn * tstep;
    S.a_ready(cur);
    if constexpr (SP2) {
        PG8_STAGE(PG8_SB(0, 0), cB, voffB); PG8_STAGE(PG8_SB(0, 1), cB + hstep, voffB); PG8_STAGE(PG8_SA(0, 0), cA, voffA); PG8_STAGE(PG8_SA(0, 1), cA + hstep, voffA);
        if (wr == 1) PG8_BAR;
        PG8_WAIT_V(2); PG8_BAR;
        PG8_STAGE(PG8_SB(1, 0), cB + kstep, voffB); PG8_STAGE(PG8_SA(1, 0), cA + kstep, voffA); PG8_STAGE(PG8_SB(1, 1), cB + hstep + kstep, voffB);
        PG8_WAIT_V(6); PG8_BAR;
    } else {
        PG8_STAGE(PG8_SB(0, 0), cB, voffB); PG8_STAGE(PG8_SA(0, 0), cA, voffA); PG8_STAGE(PG8_SB(0, 1), cB + hstep, voffB); PG8_STAGE(PG8_SA(0, 1), cA + hstep, voffA);
        if (wr == 1) PG8_BAR;
        PG8_WAIT_V(4); PG8_BAR;
        PG8_STAGE(PG8_SB(1, 0), cB + kstep, voffB); PG8_STAGE(PG8_SA(1, 0), cA + kstep, voffA); PG8_STAGE(PG8_SB(1, 1), cB + hstep + kstep, voffB);
        PG8_WAIT_V(6); PG8_BAR;
    }
    for (;;) {
        const bool has_next = S.next(ui + 1, nxt);
        const char* nA = cA; const char* nB = cB; int cnt = nt;
        if constexpr (Sched::SPLITK) { if (has_next) { nA = (const char*)g.A + (size_t)nxt.pm * tstep + (size_t)Sched::kt0(nxt) * kstep; nB = (const char*)g.Bt + (size_t)(nxt.pn & 255) * tstep + (size_t)Sched::kt0(nxt) * kstep; } cnt = Sched::cnt(cur, nt); }
        else { if (has_next) { nA = (const char*)g.A + (size_t)nxt.pm * tstep; nB = (const char*)g.Bt + (size_t)nxt.pn * tstep; } }
        for (int t = 0; t < cnt; t += 2) {
            if constexpr (HasMid<Epi>::value) { if (t == Epi::MID_T) E.mid(acc, cur, wr, wc, fr, fq); }
            const bool last = (t == cnt - 2);
            const char* a1 = cA + (size_t)(t + 1) * kstep;
            const char* a2 = last ? nA : cA + (size_t)(t + 2) * kstep; const char* b2 = last ? nB : cB + (size_t)(t + 2) * kstep;
            const char* a3 = a2 + kstep; const char* b3 = b2 + kstep;
            if (last && has_next) S.a_ready(nxt);
            if constexpr (SP2) {
            PG8_LDB(B0, 0, 0); PG8_LDB(B1, 0, 1); PG8_SCHED; PG8_LDA(At, 0, 0); PG8_STAGE(PG8_SA(1, 1), a1 + hstep, voffA);
            PG8_WAIT_V(8); PG8_WAIT_L(0); PG8_BAR; PG8_MMA(0, 0, At, B0); PG8_MMA(0, 1, At, B1); PG8_BAR; PG8_SCHED;
            PG8_LDA(At, 0, 1); PG8_STAGE(PG8_SB(0, 0), b2, voffB); PG8_STAGE(PG8_SB(0, 1), b2 + hstep, voffB); PG8_STAGE(PG8_SA(0, 0), a2, voffA);
            PG8_WAIT_V(8); PG8_WAIT_L(0); PG8_BAR; PG8_MMA(1, 0, At, B0); PG8_MMA(1, 1, At, B1); PG8_BAR; PG8_SCHED;
            PG8_LDB(B0, 1, 0); PG8_LDB(B1, 1, 1); PG8_SCHED; PG8_LDA(At, 1, 0); PG8_STAGE(PG8_SA(0, 1), a2 + hstep, voffA);
            PG8_WAIT_V(8); PG8_WAIT_L(0); PG8_BAR; PG8_MMA(0, 0, At, B0); PG8_MMA(0, 1, At, B1); PG8_BAR; PG8_SCHED;
            PG8_LDA(At, 1, 1); PG8_STAGE(PG8_SB(1, 0), b3, voffB); PG8_STAGE(PG8_SB(1, 1), b3 + hstep, voffB); PG8_STAGE(PG8_SA(1, 0), a3, voffA);
            PG8_WAIT_V(8); PG8_WAIT_L(0); PG8_BAR; PG8_MMA(1, 0, At, B0); PG8_MMA(1, 1, At, B1); PG8_BAR; PG8_SCHED;
            } else {
            PG8_LDB(B0, 0, 0); PG8_SCHED; PG8_LDA(At, 0, 0); PG8_STAGE(PG8_SA(1, 1), a1 + hstep, voffA);
            PG8_WAIT_L(8); PG8_BAR; PG8_WAIT_L(0); PG8_MMA(0, 0, At, B0); PG8_BAR; PG8_SCHED;
            PG8_LDB(B1, 0, 1); PG8_STAGE(PG8_SB(0, 0), b2, voffB);
            PG8_BAR; PG8_WAIT_L(0); PG8_MMA(0, 1, At, B1); PG8_BAR;
            PG8_LDA(At, 0, 1); PG8_STAGE(PG8_SA(0, 0), a2, voffA);
            PG8_BAR; PG8_WAIT_L(0); PG8_MMA(1, 0, At, B0); PG8_BAR; PG8_SCHED;
            PG8_STAGE(PG8_SB(0, 1), b2 + hstep, voffB);
            PG8_WAIT_V(6); PG8_BAR; PG8_MMA(1, 1, At, B1); PG8_BAR;
            PG8_LDB(B0, 1, 0); PG8_SCHED; PG8_LDA(At, 1, 0); PG8_STAGE(PG8_SA(0, 1), a2 + hstep, voffA);
            PG8_WAIT_L(8); PG8_BAR; PG8_WAIT_L(0); PG8_MMA(0, 0, At, B0); PG8_BAR; PG8_SCHED;
            PG8_LDB(B1, 1, 1); PG8_STAGE(PG8_SB(1, 0), b3, voffB);
            PG8_BAR; PG8_WAIT_L(0); PG8_MMA(0, 1, At, B1); PG8_BAR;
            PG8_LDA(At, 1, 1); PG8_STAGE(PG8_SA(1, 0), a3, voffA);
            PG8_BAR; PG8_WAIT_L(0); PG8_MMA(1, 0, At, B0); PG8_BAR; PG8_SCHED;
            PG8_STAGE(PG8_SB(1, 1), b3 + hstep, voffB);
            PG8_WAIT_V(6); PG8_BAR; PG8_MMA(1, 1, At, B1); PG8_BAR;
            }
        }
        if constexpr (ALIGN_EPI) { if (wr == 0) PG8_BAR; }
        if constexpr (!Epi::AFTER_DRAIN) { E(acc, cur, wr, wc, fr, fq); S.done(cur); }
        if (!has_next) break;
#pragma unroll
        for (int a = 0; a < 2; ++a)
#pragma unroll
            for (int b = 0; b < 2; ++b)
#pragma unroll
                for (int m = 0; m < 4; ++m)
#pragma unroll
                    for (int n = 0; n < 2; ++n) acc[a][b][m][n] = (f32x4){0.f, 0.f, 0.f, 0.f};
        cur = nxt; cA = nA; cB = nB; ++ui;
        if constexpr (ALIGN_EPI) { if (wr == 1) PG8_BAR; }
    }
    PG8_WAIT_V(0);
    if constexpr (!ALIGN_EPI) { if (wr == 0) PG8_BAR; }
    PG8_BAR;
    if constexpr (Epi::AFTER_DRAIN) { E.fused(acc, cur, wr, wc, fr, fq, lds, wid, lane); S.done(cur); }
#undef PG8_SA
#undef PG8_SB
#undef PG8_STAGE
#undef PG8_LDA
#undef PG8_LDB
#undef PG8_MMA
#undef PG8_WAIT_V
#undef PG8_WAIT_L
#undef PG8_BAR
#undef PG8_SCHED
}
}


constexpr int NWAVES = 8;
constexpr int D_MODEL = 4096, BATCH = 4, SEQ = 2048, CTX_LEN = 256, D_FF = 11008, D_A = 1024, D_B = 2048, N_IN = 19456, N_MOD = 9;
constexpr int D_FFP = D_FF + 64;
constexpr int RT = 9216;
constexpr int RPB = 2304;
constexpr int S5_G = 64, S5_P = 64, S5_H = 16, NCHUNK = 36;
constexpr float EPS = 1e-6f;
constexpr int ADA_KS = 8, NMODC_ = 36864;

constexpr size_t MiB = 1u << 20;
constexpr size_t WS_CTL = 0, CTL_ZERO_BYTES = 1 * MiB;
constexpr size_t WS_MODP = 2 * MiB;
constexpr size_t WS_MOD = 14 * MiB;
constexpr size_t WS_TAB = 15 * MiB;
constexpr size_t WS_Y = 188 * MiB  , WS_WP = 656 * MiB  ;
constexpr size_t WS_W13A = 16 * MiB, WS_W2A = 814 * MiB, WS_WIN = 274 * MiB, WS_WGLU = 426 * MiB, WS_WPA = 428 * MiB, WS_WPB = 436 * MiB, WS_WOUT = 452 * MiB, WS_W13B = 484 * MiB, WS_W2B = 901 * MiB;
constexpr size_t WS_ZN = 742 * MiB, WS_HID = 2026 * MiB, WS_H = 1008 * MiB, WS_UA = 1152 * MiB, WS_Q = 1188 * MiB, WS_V = 1224 * MiB, WS_OG = 1260 * MiB, WS_LFF = 1296 * MiB, WS_LFB = 1368 * MiB;
constexpr size_t WS_SGA = 1440 * MiB, WS_SGB = 1512 * MiB, WS_XEND = 1584 * MiB, WS_GA = 1594 * MiB, WS_YA = 1612 * MiB, WS_OHG = 1630 * MiB, WS_YB = 1774 * MiB, WS_PT = 1810 * MiB, WS_MRG = 1954 * MiB, WS_END = 2221 * MiB;
static_assert(WS_W13A + (size_t)2 * D_FF * D_MODEL * 2 <= WS_WIN && WS_W2A + (size_t)D_MODEL * D_FFP * 2 <= WS_W2B && WS_W2B + (size_t)D_MODEL * D_FFP * 2 <= WS_H && WS_WIN + (size_t)N_IN * D_MODEL * 2 <= WS_WGLU, "ws map 1");
static_assert(WS_W13B + (size_t)2 * D_FF * D_MODEL * 2 <= WS_ZN && WS_ZN + (size_t)RT * D_MODEL * 2 <= WS_W2A && WS_MRG + (size_t)RT * D_MODEL * 2 <= WS_HID && WS_HID + (size_t)RT * D_FFP * 2 <= WS_END, "ws map 2");
static_assert(WS_H + (size_t)RT * D_MODEL * 4 <= WS_UA && WS_UA + (size_t)RT * D_A * 4 <= WS_Q && WS_Q + (size_t)RT * D_B * 2 <= WS_V && WS_LFF + (size_t)RT * D_B * 4 <= WS_LFB && WS_SGA + (size_t)RT * D_MODEL * 2 <= WS_SGB, "ws map 3");
static_assert(WS_XEND + (size_t)BATCH * 2 * S5_G * NCHUNK * S5_P * 8 <= WS_GA && WS_OHG + (size_t)2 * RT * D_B * 4 <= WS_YB && WS_PT + (size_t)RT * D_MODEL * 4 <= WS_MRG && WS_MRG + (size_t)RT * D_MODEL * 2 <= WS_END, "ws map 4");
static_assert(WS_MODP + (size_t)ADA_KS * 5 * 36864 * 4 <= WS_MOD, "ws map 5");
constexpr int CW_BAR = 4096;
constexpr int CW_QUEUE = 8192, CW_DONE = 8192 + 64, CW_QUEUE2 = 8192 + 128, CW_QUEUE3 = 8192 + 192;

constexpr int RING_OFF = 0, RING_BYTES = 131072;
constexpr int LDSCTL_OFF = RING_BYTES, MISC_OFF = LDSCTL_OFF + 320;
constexpr int LDS_BYTES = 147456;
static_assert(MISC_OFF + 128 <= LDS_BYTES, "LDS map");

#define GAS __attribute__((address_space(1)))
#define LAS __attribute__((address_space(3)))
typedef unsigned short bf16;
typedef unsigned v4u __attribute__((ext_vector_type(4)));
typedef unsigned v2u __attribute__((ext_vector_type(2)));
typedef float f32x4 __attribute__((ext_vector_type(4)));
typedef float f32x2 __attribute__((ext_vector_type(2)));
typedef short bf16x8 __attribute__((ext_vector_type(8)));
typedef GAS unsigned gu32;
#define RLX_AGENT __ATOMIC_RELAXED, __HIP_MEMORY_SCOPE_AGENT
#define LDS_WAIT() asm volatile("s_waitcnt lgkmcnt(0)" ::: "memory")
#define VM_WAIT() asm volatile("s_waitcnt vmcnt(0)" ::: "memory")
using pg8::cvt_pk_bf16; using pg8::bf_lo; using pg8::bf_hi; using pg8::sigmoid_f; using pg8::silu_f;
__device__ __forceinline__ float wave_sum(float v) {
#pragma unroll
    for (int o = 1; o < 64; o <<= 1) v += __shfl_xor(v, o);
    return v;
}

#define XB_TMO      128
#define XB_XCNT(j)  (256  + 64 * (j))
#define XB_XSUB(j)  (1280 + 64 * (j))
#define XB_XGEN(j)  (2304 + 64 * (j))
#define XB_TOP      3328
#define XB_TOPGEN   3392
#define XCD_BAR_WORDS 3456
#define XB_SPIN_CAP (1u << 18)

__device__ __forceinline__ unsigned xb_ld(unsigned* p)              { return __hip_atomic_load(p, __ATOMIC_RELAXED, __HIP_MEMORY_SCOPE_AGENT); }
__device__ __forceinline__ unsigned xb_add(unsigned* p, unsigned v) { return __hip_atomic_fetch_add(p, v, __ATOMIC_RELAXED, __HIP_MEMORY_SCOPE_AGENT); }
__device__ __forceinline__ unsigned xb_xcc_id() { return (unsigned)__builtin_amdgcn_s_getreg((3 << 11) | 20) & 0xFu; }
#define XB_SPIN(cond, bar) do { unsigned _sp = 0; while (cond) { __builtin_amdgcn_s_sleep(1); \
    if ((++_sp & 255u) == 0u) { if (xb_ld(&(bar)[XB_TMO])) break; if (_sp > XB_SPIN_CAP) { atomicAdd(&(bar)[XB_TMO], 1u); break; } } } } while (0)

struct XcdBarrier {
    unsigned* bar; unsigned x;
    volatile LAS unsigned* st;
};

__device__ __forceinline__ XcdBarrier xcd_barrier_post(unsigned* bar, volatile LAS unsigned* st) {
    XcdBarrier b; b.bar = bar; b.x = xb_xcc_id(); b.st = st;
    if (threadIdx.x == 0) (void)xb_add(&bar[XB_XCNT(b.x)], 1u);
    return b;
}
__device__ __forceinline__ void xcd_barrier_complete(unsigned* bar, unsigned x, unsigned& nloc, unsigned& nx) {
    const unsigned G = gridDim.x * gridDim.y * gridDim.z;
    unsigned sum, cnt, mine, sp = 0u;
    for (;;) {
        sum = 0u; cnt = 0u; mine = 0u;
#pragma unroll
        for (unsigned j = 0; j < 16; ++j) { const unsigned c = xb_ld(&bar[XB_XCNT(j)]); sum += c; cnt += (c > 0u) ? 1u : 0u; mine = (j == x) ? c : mine; }
        if (sum == G) break;
        __builtin_amdgcn_s_sleep(1);
        if ((++sp & 255u) == 0u) { if (xb_ld(&bar[XB_TMO])) break; if (sp > XB_SPIN_CAP) { atomicAdd(&bar[XB_TMO], 1u); break; } }
    }
    nloc = mine > 0u ? mine : 1u; nx = cnt > 0u ? cnt : 1u;
}

__device__ __forceinline__ void xcd_barrier(const XcdBarrier& b) {
    asm volatile("s_waitcnt vmcnt(0)" ::: "memory");
    __syncthreads();
    if (threadIdx.x == 0) {
        unsigned* bar = b.bar;
        __builtin_amdgcn_s_waitcnt(0);
        unsigned nloc = b.st[0], nx = b.st[1];
        if (nloc == 0u) { xcd_barrier_complete(bar, b.x, nloc, nx); b.st[0] = nloc; b.st[1] = nx; }
        const unsigned old = xb_add(&bar[XB_XSUB(b.x)], 1u);
        const unsigned gen = old / nloc;
        if (old + 1u == (gen + 1u) * nloc) {
            __builtin_amdgcn_fence(__ATOMIC_RELEASE, "agent");
            asm volatile("s_waitcnt vmcnt(0)" ::: "memory");
            const unsigned og = xb_add(&bar[XB_TOP], 1u);
            const unsigned tg = og / nx;
            if (og + 1u == (tg + 1u) * nx) xb_add(&bar[XB_TOPGEN], 1u);
            else XB_SPIN(xb_ld(&bar[XB_TOPGEN]) == tg, bar);
            __builtin_amdgcn_fence(__ATOMIC_ACQUIRE, "agent");
            xb_add(&bar[XB_XGEN(b.x)], 1u);
            asm volatile("s_waitcnt vmcnt(0)" ::: "memory");
        } else {
            XB_SPIN(xb_ld(&bar[XB_XGEN(b.x)]) == gen, bar);
            __builtin_amdgcn_fence(__ATOMIC_ACQUIRE, "agent");
            asm volatile("s_waitcnt vmcnt(0)" ::: "memory");
        }
    }
    __syncthreads();
}


struct Args { const float* in[31]; float* out; unsigned char* ws; };
enum { I_X = 0, I_C, I_CTX, I_CCTX, I_WADA, I_BADA, I_NORM1, I_W1A, I_W3A, I_W2A, I_NORMMIX, I_WIN, I_LAMRE, I_LAMIM, I_LOGDT, I_BRE, I_BIM, I_CRE, I_CIM, I_S5D, I_WGLU,
       I_LBLOG, I_HGNORM, I_WPA, I_WPB, I_WOUT, I_NORM2, I_W1B, I_W3B, I_W2B, I_NORMF };

struct ItemDesc { const float* src; bf16* dst; int N, K; };
__device__ __forceinline__ ItemDesc make_item(const float* W, int K, int N, bf16* WT, int kind, int item, int ld = 0) {
    if (ld) K = ld;
    const int nblk = N / 32, kb = item / nblk, nb = item - kb * nblk, k0 = 64 * kb, n0 = 32 * nb;
    int drow = (kind == 0) ? n0 : ((n0 >> 7) * 256 + (n0 & 127) + (kind == 2 ? 128 : 0));
    if (kind == 3) { const int st = n0 >> 8; const int dt = (st < 4) ? st : (st < 12) ? st + 24 : (st < 36) ? st - 8 : st;
        drow = dt * 256 + (n0 & 255);
        if (st >= 44) { const int isb = (st >= 60) ? 1 : 0, c = (st - 44 - 16 * isb) * 256 + (n0 & 255); drow = (44 + (c >> 7)) * 256 + (c & 127) + 128 * isb; } }
    ItemDesc d; d.src = W + (size_t)k0 * N + n0; d.dst = WT + (size_t)drow * K + k0; d.N = N; d.K = K; return d;
}
__device__ __forceinline__ void item_load(const ItemDesc& d, f32x4 (&v)[8], int lane) {
    const float* p = d.src + (size_t)(lane >> 3) * d.N + 4 * (lane & 7);
#pragma unroll
    for (int i = 0; i < 8; ++i) v[i] = __builtin_nontemporal_load((const GAS f32x4*)(p + (size_t)(8 * i) * d.N));
}
__device__ __forceinline__ void item_store(const ItemDesc& d, const f32x4 (&v)[8], LAS float* scr, int lane) {
#pragma unroll
    for (int i = 0; i < 8; ++i) { LAS float* s = scr + (8 * i + (lane >> 3)) * 33 + 4 * (lane & 7); s[0] = v[i].x; s[1] = v[i].y; s[2] = v[i].z; s[3] = v[i].w; }
    LDS_WAIT(); asm volatile("" ::: "memory");
    const int c = lane & 7;
#pragma unroll
    for (int j = 0; j < 4; ++j) { const int n = (lane >> 3) + 8 * j; const LAS float* s = scr + (8 * c) * 33 + n;
        v4u o; o.x = cvt_pk_bf16(s[0 * 33], s[1 * 33]); o.y = cvt_pk_bf16(s[2 * 33], s[3 * 33]); o.z = cvt_pk_bf16(s[4 * 33], s[5 * 33]); o.w = cvt_pk_bf16(s[6 * 33], s[7 * 33]);
        *(GAS v4u*)(d.dst + (size_t)n * d.K + 8 * c) = o; }
    LDS_WAIT(); asm volatile("" ::: "memory");
}
constexpr int IT_FF = (D_MODEL / 64) * (D_FF / 32), IT_WIN = (D_MODEL / 64) * (N_IN / 32), IT_GLU = (D_A / 64) * (D_A / 32), IT_PA = (D_A / 64) * (D_MODEL / 32), IT_PB = (D_B / 64) * (D_MODEL / 32), IT_OUT = (D_MODEL / 64) * (D_MODEL / 32);
constexpr int T_ITEMS = 6 * IT_FF + IT_WIN + IT_GLU + IT_PA + IT_PB + IT_OUT;
constexpr int ADA_TASKS = 144 * ADA_KS, ADA_KLEN = D_MODEL / ADA_KS;

__device__ __forceinline__ void p0_ada_task(const float* cvec, const float* cctx, const float* wada, float* modp, int task, LAS float* scr, int lane) {
    const int cg = task % 144, ks = task / 144, k0 = ks * ADA_KLEN, n0 = cg * 256 + lane * 4;
#pragma unroll
    for (int i = 0; i < 5; ++i)
        for (int kk = lane; kk < ADA_KLEN; kk += 64) { const float v = (i < 4) ? cvec[i * D_MODEL + k0 + kk] : cctx[k0 + kk]; scr[kk * 8 + i] = silu_f(v); }
    LDS_WAIT(); asm volatile("" ::: "memory");
    f32x4 a0 = {0.f, 0.f, 0.f, 0.f}, a1 = a0, a2 = a0, a3 = a0, a4 = a0;
    const float* wp = wada + (size_t)k0 * NMODC_ + n0;
#pragma unroll 32
    for (int k = 0; k < ADA_KLEN; ++k) {
        const f32x4 w = __builtin_nontemporal_load((const GAS f32x4*)(wp + (size_t)k * NMODC_));
        const f32x4 s = *(const LAS f32x4*)(scr + k * 8); const float s4 = scr[k * 8 + 4];
        a0 += w * s[0]; a1 += w * s[1]; a2 += w * s[2]; a3 += w * s[3]; a4 += w * s4;
    }
    float* o = modp + (size_t)ks * 5 * NMODC_ + n0;
    *(f32x4*)(o) = a0; *(f32x4*)(o + NMODC_) = a1; *(f32x4*)(o + 2 * NMODC_) = a2; *(f32x4*)(o + 3 * NMODC_) = a3; *(f32x4*)(o + 4 * NMODC_) = a4;
    LDS_WAIT(); asm volatile("" ::: "memory");
}

__device__ __forceinline__ void norm_mod_row(const float* src, const float* gain, const float* shift, const float* scale, bf16* dst, int lane) {
    const GAS f32x4* xr = (const GAS f32x4*)src + lane;
    f32x4 v[16]; float s = 0.f;
#pragma unroll
    for (int j = 0; j < 16; ++j) { v[j] = xr[64 * j]; s += (v[j].x * v[j].x + v[j].y * v[j].y) + (v[j].z * v[j].z + v[j].w * v[j].w); }
    const float rstd = 1.0f / sqrtf(wave_sum(s) * (1.f / D_MODEL) + EPS);
    const GAS f32x4* gp = (const GAS f32x4*)gain + lane; const GAS f32x4* hp = (const GAS f32x4*)shift + lane; const GAS f32x4* cp = (const GAS f32x4*)scale + lane;
    GAS v2u* o8 = (GAS v2u*)dst + lane;
#pragma unroll
    for (int j = 0; j < 16; ++j) { const f32x4 g = gp[64 * j], sh = hp[64 * j], sc = cp[64 * j]; const f32x4 y = (v[j] * rstd * g) * (sc + 1.0f) + sh;
        v2u w; w.x = cvt_pk_bf16(y.x, y.y); w.y = cvt_pk_bf16(y.z, y.w); o8[64 * j] = w; }
}
__device__ __forceinline__ void norm_mod_row_h(const pg8::h16_t* src, const float* gain, const float* shift, const float* scale, bf16* dst, int lane) {
    const GAS v2u* xr = (const GAS v2u*)src + lane;
    f32x4 v[16]; float s = 0.f;
#pragma unroll
    for (int j = 0; j < 16; ++j) { const v2u w = xr[64 * j]; const f32x2 a = pg8::unpk_f16(w.x), c = pg8::unpk_f16(w.y); v[j] = (f32x4){a.x, a.y, c.x, c.y};
        s += (v[j].x * v[j].x + v[j].y * v[j].y) + (v[j].z * v[j].z + v[j].w * v[j].w); }
    const float rstd = 1.0f / sqrtf(wave_sum(s) * (1.f / D_MODEL) + EPS);
    const GAS f32x4* gp = (const GAS f32x4*)gain + lane; const GAS f32x4* hp = (const GAS f32x4*)shift + lane; const GAS f32x4* cp = (const GAS f32x4*)scale + lane;
    GAS v2u* o8 = (GAS v2u*)dst + lane;
#pragma unroll
    for (int j = 0; j < 16; ++j) { const f32x4 g = gp[64 * j], sh = hp[64 * j], sc = cp[64 * j]; const f32x4 y = (v[j] * rstd * g) * (sc + 1.0f) + sh;
        v2u w; w.x = cvt_pk_bf16(y.x, y.y); w.y = cvt_pk_bf16(y.z, y.w); o8[64 * j] = w; }
}
__device__ __forceinline__ void norm_mod_row_part(const float* base, const pg8::h16_t* part, const float* m2, const float* gain, const float* shift, const float* scale, bf16* dst, int lane) {
    const GAS f32x4* xr = (const GAS f32x4*)base + lane; const GAS v2u* pr = (const GAS v2u*)part + lane; const GAS f32x4* mr = (const GAS f32x4*)m2 + lane;
    constexpr size_t QS = (size_t)BATCH * CTX_LEN * D_MODEL / 4;
    f32x4 v[16]; float s = 0.f;
#pragma unroll
    for (int j = 0; j < 16; ++j) { f32x4 p = (f32x4){0.f, 0.f, 0.f, 0.f};
#pragma unroll
        for (int k = 0; k < 4; ++k) { const v2u w = pr[k * QS + 64 * j]; const f32x2 a = pg8::unpk_f16(w.x), c = pg8::unpk_f16(w.y); p += (f32x4){a.x, a.y, c.x, c.y}; }
        v[j] = xr[64 * j] + (mr[64 * j] * 0.5f) * p; s += (v[j].x * v[j].x + v[j].y * v[j].y) + (v[j].z * v[j].z + v[j].w * v[j].w);
        if ((j & 3) == 3) asm volatile("" ::: "memory"); }
    const float rstd = 1.0f / sqrtf(wave_sum(s) * (1.f / D_MODEL) + EPS);
    const GAS f32x4* gp = (const GAS f32x4*)gain + lane; const GAS f32x4* hp = (const GAS f32x4*)shift + lane; const GAS f32x4* cp = (const GAS f32x4*)scale + lane;
    GAS v2u* o8 = (GAS v2u*)dst + lane;
#pragma unroll
    for (int j = 0; j < 16; ++j) { const f32x4 g = gp[64 * j], sh = hp[64 * j], sc = cp[64 * j]; const f32x4 y = (v[j] * rstd * g) * (sc + 1.0f) + sh;
        v2u w; w.x = cvt_pk_bf16(y.x, y.y); w.y = cvt_pk_bf16(y.z, y.w); o8[64 * j] = w; }
}
__device__ __forceinline__ void norm_final_row_h(const pg8::h16_t* src, float* dst, const float* gain, int lane) {
    const GAS v2u* xr = (const GAS v2u*)src + lane; GAS f32x4* o = (GAS f32x4*)dst + lane;
    f32x4 v[16]; float s = 0.f;
#pragma unroll
    for (int j = 0; j < 16; ++j) { const v2u w = xr[64 * j]; const f32x2 a = pg8::unpk_f16(w.x), c = pg8::unpk_f16(w.y); v[j] = (f32x4){a.x, a.y, c.x, c.y};
        s += (v[j].x * v[j].x + v[j].y * v[j].y) + (v[j].z * v[j].z + v[j].w * v[j].w); }
    const float rstd = 1.0f / sqrtf(wave_sum(s) * (1.f / D_MODEL) + EPS);
    const GAS f32x4* gp = (const GAS f32x4*)gain + lane;
#pragma unroll
    for (int j = 0; j < 16; ++j) o[64 * j] = v[j] * rstd * gp[64 * j];
}
__device__ __forceinline__ void norm_final_row(float* io, const float* gain, int lane) {
    GAS f32x4* xr = (GAS f32x4*)io + lane;
    f32x4 v[16]; float s = 0.f;
#pragma unroll
    for (int j = 0; j < 16; ++j) { v[j] = xr[64 * j]; s += (v[j].x * v[j].x + v[j].y * v[j].y) + (v[j].z * v[j].z + v[j].w * v[j].w); }
    const float rstd = 1.0f / sqrtf(wave_sum(s) * (1.f / D_MODEL) + EPS);
    const GAS f32x4* gp = (const GAS f32x4*)gain + lane;
#pragma unroll
    for (int j = 0; j < 16; ++j) xr[64 * j] = v[j] * rstd * gp[64 * j];
}

__device__ __forceinline__ void s5_table_entry(const float* lam_re, const float* lam_im, const float* log_dt, float* TAB, int idx) {
    const int dg = idx >> 6;
    const double dt = exp((double)log_dt[dg]);
    const double lr = (double)lam_re[idx], li = (double)lam_im[idx];
    const double mag = exp(lr * dt), th = li * dt;
    const double TWO_PI = 6.283185307179586476925286766559;
    const double rr = th - TWO_PI * rint(th * (1.0 / TWO_PI));
    const double abr = mag * cos(rr), abi = mag * sin(rr);
    const double den = lr * lr + li * li, nr = abr - 1.0;
    const double kr = (nr * lr + abi * li) / den, ki = (abi * lr - nr * li) / den;
    double pr = abr, pi = abi;
#pragma unroll
    for (int i = 0; i < 6; ++i) { const double tr = pr * pr - pi * pi, ti = 2.0 * pr * pi; pr = tr; pi = ti; }
    float* o = TAB + (size_t)idx * 8;
    o[0] = (float)abr; o[1] = (float)abi; o[2] = (float)kr; o[3] = (float)ki; o[4] = (float)pr; o[5] = (float)pi; o[6] = 0.f; o[7] = 0.f;
}
#define S5_LOAD_BK(d_, g_, p_) \
    float ar, ai, a64r, a64i; f32x2 bk2[16]; \
    { const f32x4 t0 = *(const f32x4*)(TAB + ((size_t)(((d_) * 64 + (g_)) * 64 + (p_))) * 8), t1 = *(const f32x4*)(TAB + ((size_t)(((d_) * 64 + (g_)) * 64 + (p_))) * 8 + 4); \
      ar = t0[0]; ai = t0[1]; a64r = t1[0]; a64i = t1[1]; const float kr = t0[2], ki = t0[3]; \
      const f32x4* br = (const f32x4*)(b_re + ((size_t)((g_) * 64 + (p_))) * 16); const f32x4* bi = (const f32x4*)(b_im + ((size_t)((g_) * 64 + (p_))) * 16); \
      _Pragma("unroll") for (int q = 0; q < 4; ++q) { const f32x4 x = br[q], y = bi[q]; \
          _Pragma("unroll") for (int j = 0; j < 4; ++j) { bk2[4 * q + j] = (f32x2){kr * x[j] - ki * y[j], kr * y[j] + ki * x[j]}; } } }
#define S5_STEP(tl_) { const f32x4 u0 = UL[(tl_) * 4 + 0], u1 = UL[(tl_) * 4 + 1], u2 = UL[(tl_) * 4 + 2], u3 = UL[(tl_) * 4 + 3]; \
        f32x2 e0 = bk2[0] * u0[0], e1 = bk2[1] * u0[1]; \
        e0 += bk2[2] * u0[2]; e1 += bk2[3] * u0[3]; e0 += bk2[4] * u1[0]; e1 += bk2[5] * u1[1]; e0 += bk2[6] * u1[2]; e1 += bk2[7] * u1[3]; \
        e0 += bk2[8] * u2[0]; e1 += bk2[9] * u2[1]; e0 += bk2[10] * u2[2]; e1 += bk2[11] * u2[3]; e0 += bk2[12] * u3[0]; e1 += bk2[13] * u3[1]; e0 += bk2[14] * u3[2]; e1 += bk2[15] * u3[3]; \
        e0 += e1; \
        const float nr_ = ar * xr - ai * xi + e0.x, ni_ = ar * xi + ai * xr + e0.y; xr = nr_; xi = ni_; }

typedef float f32x16 __attribute__((ext_vector_type(16)));
__device__ __forceinline__ void s5_make_ef(bf16x8 (&Ef)[4], const float* TAB, const float* b_re, const float* b_im, int d, int g, int lane) {
    const int half = lane >> 5, l31 = lane & 31;
#pragma unroll
    for (int s2 = 0; s2 < 2; ++s2) { const int ps = 32 * s2 + l31;
        const f32x4 tt = *(const f32x4*)(TAB + ((size_t)((d * 64 + g) * 64 + ps)) * 8); const float kr = tt[2], ki = tt[3];
        const float* brp = b_re + ((size_t)(g * 64 + ps)) * 16 + 8 * half; const float* bip = b_im + ((size_t)(g * 64 + ps)) * 16 + 8 * half;
        const f32x4 r0 = *(const f32x4*)brp, r1 = *(const f32x4*)(brp + 4), i0 = *(const f32x4*)bip, i1 = *(const f32x4*)(bip + 4);
        v4u wr_, wi_;
        wr_.x = cvt_pk_bf16(kr * r0[0] - ki * i0[0], kr * r0[1] - ki * i0[1]); wr_.y = cvt_pk_bf16(kr * r0[2] - ki * i0[2], kr * r0[3] - ki * i0[3]);
        wr_.z = cvt_pk_bf16(kr * r1[0] - ki * i1[0], kr * r1[1] - ki * i1[1]); wr_.w = cvt_pk_bf16(kr * r1[2] - ki * i1[2], kr * r1[3] - ki * i1[3]);
        wi_.x = cvt_pk_bf16(kr * i0[0] + ki * r0[0], kr * i0[1] + ki * r0[1]); wi_.y = cvt_pk_bf16(kr * i0[2] + ki * r0[2], kr * i0[3] + ki * r0[3]);
        wi_.z = cvt_pk_bf16(kr * i1[0] + ki * r1[0], kr * i1[1] + ki * r1[1]); wi_.w = cvt_pk_bf16(kr * i1[2] + ki * r1[2], kr * i1[3] + ki * r1[3]);
        Ef[s2] = __builtin_bit_cast(bf16x8, wr_); Ef[2 + s2] = __builtin_bit_cast(bf16x8, wi_); }
}
#define S5_E_TILES(blk_) \
    const int tk_ = 16 * (blk_) + (l31 & 3) + 4 * (l31 >> 3); \
    const f32x4 ua_ = UL[tk_ * 4 + 2 * half], ub_ = UL[tk_ * 4 + 2 * half + 1]; \
    v4u aw_; aw_.x = cvt_pk_bf16(ua_[0], ua_[1]); aw_.y = cvt_pk_bf16(ua_[2], ua_[3]); aw_.z = cvt_pk_bf16(ub_[0], ub_[1]); aw_.w = cvt_pk_bf16(ub_[2], ub_[3]); \
    const bf16x8 Af_ = __builtin_bit_cast(bf16x8, aw_); \
    f32x16 zero16_; _Pragma("unroll") for (int q_ = 0; q_ < 16; ++q_) zero16_[q_] = 0.f; \
    const f32x16 D0 = __builtin_amdgcn_mfma_f32_32x32x16_bf16(Af_, Ef[0], zero16_, 0, 0, 0), D1 = __builtin_amdgcn_mfma_f32_32x32x16_bf16(Af_, Ef[1], zero16_, 0, 0, 0); \
    const f32x16 D2 = __builtin_amdgcn_mfma_f32_32x32x16_bf16(Af_, Ef[2], zero16_, 0, 0, 0), D3 = __builtin_amdgcn_mfma_f32_32x32x16_bf16(Af_, Ef[3], zero16_, 0, 0, 0);

__device__ __forceinline__ void s5_pass_a(LAS unsigned char* scr, int task, const float* TAB, const float* b_re, const float* b_im, const pg8::h16_t* UA, float* XEND, int lane) {
    const int c = task % NCHUNK; int r = task / NCHUNK; const int g = r & 63; r >>= 6; const int d = r & 1; const int b = r >> 1;
    const int half = lane >> 5, l31 = lane & 31;
    const f32x4 t0 = *(const f32x4*)(TAB + ((size_t)((d * 64 + g) * 64 + lane)) * 8); const float ar = t0[0], ai = t0[1];
    bf16x8 Ef[4]; s5_make_ef(Ef, TAB, b_re, b_im, d, g, lane);
    const int j0 = 64 * c;
    const int trow = (d == 0) ? (j0 + lane) : ((j0 < CTX_LEN ? 255 - j0 : 2559 - j0) - lane);
    const v4u* up = (const v4u*)(UA + ((size_t)(b * RPB + trow)) * D_A + g * 16);
    LAS f32x4* UL = (LAS f32x4*)scr;
#pragma unroll
    for (int q = 0; q < 2; ++q) { const v4u w = up[q]; const f32x2 p0 = pg8::unpk_f16(w.x), p1 = pg8::unpk_f16(w.y), p2 = pg8::unpk_f16(w.z), p3 = pg8::unpk_f16(w.w);
        UL[lane * 4 + 2 * q] = (f32x4){p0.x, p0.y, p1.x, p1.y}; UL[lane * 4 + 2 * q + 1] = (f32x4){p2.x, p2.y, p3.x, p3.y}; }
    LDS_WAIT(); asm volatile("" ::: "memory");
    float xr = 0.f, xi = 0.f;
#pragma unroll
    for (int i = 0; i < 4; ++i) {
        S5_E_TILES(i)
#pragma unroll
        for (int ss = 0; ss < 16; ++ss) { const float er = half ? D1[ss] : D0[ss], ei = half ? D3[ss] : D2[ss];
            const float nr_ = ar * xr - ai * xi + er, ni_ = ar * xi + ai * xr + ei; xr = nr_; xi = ni_; }
    }
    __hip_atomic_store((unsigned long long*)(XEND + ((size_t)task * 64 + lane) * 2), ((unsigned long long)__float_as_uint(xi) << 32) | (unsigned long long)__float_as_uint(xr), __ATOMIC_RELAXED, __HIP_MEMORY_SCOPE_AGENT);
    LDS_WAIT(); asm volatile("" ::: "memory");
}

__device__ __forceinline__ float gelu_tanh_f(float y) { const float z = 1.5957691216057308f * (y + 0.044715f * y * y * y); return y * sigmoid_f(z); }
__device__ __forceinline__ unsigned short f2bf_rne(float f) { unsigned u = __float_as_uint(f); return (unsigned short)((u + 0x7fffu + ((u >> 16) & 1u)) >> 16); }

__device__ __forceinline__ void s5_pass_c(LAS unsigned char* scr, int task, const float* TAB, const float* b_re, const float* b_im, const float* c_re, const float* c_im, const float* dskip,
                                          const pg8::h16_t* UA, const float* XEND, bf16* GA, int lane) {
    const int c = 4 + (task & 31), g = (task >> 5) & 63, b = task >> 11;
    const int r16 = lane & 15, q4 = lane >> 4;
    LAS f32x4* UL = (LAS f32x4*)scr;
    LAS unsigned char* XB = scr + 4096;
    const int row0 = b * RPB + 64 * c;
    { const v4u* up = (const v4u*)(UA + ((size_t)(row0 + lane)) * D_A + g * 16);
#pragma unroll
      for (int q = 0; q < 2; ++q) { const v4u w = up[q]; const f32x2 p0 = pg8::unpk_f16(w.x), p1 = pg8::unpk_f16(w.y), p2 = pg8::unpk_f16(w.z), p3 = pg8::unpk_f16(w.w);
          UL[lane * 4 + 2 * q] = (f32x4){p0.x, p0.y, p1.x, p1.y}; UL[lane * 4 + 2 * q + 1] = (f32x4){p2.x, p2.y, p3.x, p3.y}; } }
    bf16x8 Cf[4];
#pragma unroll
    for (int ks = 0; ks < 4; ++ks) { const int k0 = 32 * ks + 8 * q4; const bool im = (ks >= 2);
        const float* src = (im ? c_im : c_re) + ((size_t)(g * 16 + r16)) * 64 + (k0 & 63); const float sg = im ? -1.f : 1.f;
        const f32x4 a = *(const f32x4*)src, bb = *(const f32x4*)(src + 4);
        v4u w; w.x = cvt_pk_bf16(sg * a[0], sg * a[1]); w.y = cvt_pk_bf16(sg * a[2], sg * a[3]); w.z = cvt_pk_bf16(sg * bb[0], sg * bb[1]); w.w = cvt_pk_bf16(sg * bb[2], sg * bb[3]);
        Cf[ks] = __builtin_bit_cast(bf16x8, w); }
    f32x4 ya[4];
#pragma unroll
    for (int i = 0; i < 4; ++i) ya[i] = (f32x4){0.f, 0.f, 0.f, 0.f};
    LDS_WAIT(); asm volatile("" ::: "memory");
    const int half = lane >> 5, l31 = lane & 31;
#pragma unroll
    for (int d = 0; d < 2; ++d) {
        float ar, ai, a64r, a64i;
        { const f32x4 t0 = *(const f32x4*)(TAB + ((size_t)((d * 64 + g) * 64 + lane)) * 8), t1 = *(const f32x4*)(TAB + ((size_t)((d * 64 + g) * 64 + lane)) * 8 + 4);
          ar = t0[0]; ai = t0[1]; a64r = t1[0]; a64i = t1[1]; }
        bf16x8 Ef[4]; s5_make_ef(Ef, TAB, b_re, b_im, d, g, lane);
        const int nprev = (d == 0) ? c : (39 - c);
        const f32x2* xe = (const f32x2*)(XEND + ((size_t)(((b * 2 + d) * 64 + g) * NCHUNK)) * 128) + lane;
        float xr = 0.f, xi = 0.f;
#pragma unroll 8
        for (int cc = 0; cc < nprev; ++cc) { const f32x2 e = xe[cc * 64]; const float nr_ = a64r * xr - a64i * xi + e.x, ni_ = a64r * xi + a64i * xr + e.y; xr = nr_; xi = ni_; }
#pragma unroll
        for (int ii = 0; ii < 4; ++ii) {
            const int i = (d == 0) ? ii : (3 - ii);
            S5_E_TILES(i)
#pragma unroll
            for (int ss = 0; ss < 16; ++ss) {
                const int s16 = (d == 0) ? ss : (15 - ss);
                const float er = half ? D1[s16] : D0[s16], ei = half ? D3[s16] : D2[s16];
                const float nr_ = ar * xr - ai * xi + er, ni_ = ar * xi + ai * xr + ei; xr = nr_; xi = ni_;
                *(LAS unsigned short*)(XB + s16 * 272 + 2 * lane) = f2bf_rne(xr);
                *(LAS unsigned short*)(XB + s16 * 272 + 128 + 2 * lane) = f2bf_rne(xi);
            }
            LDS_WAIT(); asm volatile("" ::: "memory");
#pragma unroll
            for (int ks = 0; ks < 4; ++ks) { const bf16x8 Bf = *(const LAS bf16x8*)(XB + r16 * 272 + 64 * ks + 16 * q4);
                ya[i] = __builtin_amdgcn_mfma_f32_16x16x32_bf16(Cf[ks], Bf, ya[i], 0, 0, 0); }
            LDS_WAIT(); asm volatile("" ::: "memory");
        }
    }
    const f32x4 dk = *(const f32x4*)(dskip + g * 16 + 4 * q4);
#pragma unroll
    for (int i = 0; i < 4; ++i) { const int tl = 16 * i + r16; const f32x4 u4 = UL[tl * 4 + q4];
        const f32x4 y = ya[i] + dk * u4;
        v2u w; w.x = cvt_pk_bf16(gelu_tanh_f(y[0]), gelu_tanh_f(y[1])); w.y = cvt_pk_bf16(gelu_tanh_f(y[2]), gelu_tanh_f(y[3]));
        *(GAS v2u*)(GA + ((size_t)(row0 + tl)) * D_A + g * 16 + 4 * q4) = w; }
    LDS_WAIT(); asm volatile("" ::: "memory");
}

__device__ __forceinline__ int hg_row(int b, int dir, int j) {
    const int jf = dir ? (j < CTX_LEN ? (CTX_LEN - 1 - j) : (2559 - j)) : j;
    int t = jf; if (jf >= CTX_LEN) { const int jj = jf - CTX_LEN; t = CTX_LEN + (jj & 31) * 64 + (jj >> 5); }
    return b * RPB + t;
}
constexpr int HG_TOT = 0, HG_DEC = 8192, HG_ROWS = 8704, HG_QS = 9216, HG_KS = 26624, HG_QB = 44032, HG_K2T = 61440, HG_VT = 79872, HG_P = 98304;
__device__ __forceinline__ void hgrn2_unit(LAS unsigned char* lds, int unit, const bf16* Q, const bf16* V, const pg8::h16_t* LFF, const pg8::h16_t* LFB, bf16* OHG, int tid) {
    const int b = unit >> 5, head = (unit >> 1) & 15, dir = unit & 1;
    const pg8::h16_t* LF = dir ? LFB : LFF;
    bf16* O = OHG + (size_t)dir * RT * D_B;
    const int lane = tid & 63, w = __builtin_amdgcn_readfirstlane(tid >> 6), kp = lane, tq = w, r16 = lane & 15, q4 = lane >> 4;
    const int colb = head * 128;
    LAS float* TOT = (LAS float*)(lds + HG_TOT); LAS float* DEC = (LAS float*)(lds + HG_DEC); LAS int* ROWS = (LAS int*)(lds + HG_ROWS); LAS float* EREF = (LAS float*)(lds + HG_QB);
    f32x4 S[8];
#pragma unroll
    for (int i = 0; i < 8; ++i) S[i] = (f32x4){0.f, 0.f, 0.f, 0.f};
    f32x2 lf[8]; unsigned qv[8], vv[8]; int rows[8];
#pragma unroll
    for (int i = 0; i < 8; ++i) { rows[i] = hg_row(b, dir, 8 * tq + i); const size_t o = (size_t)rows[i] * D_B + colb + 2 * kp;
        lf[i] = pg8::unpk_f16(*(const GAS unsigned*)(LF + o)); qv[i] = *(const GAS unsigned*)(Q + o); vv[i] = *(const GAS unsigned*)(V + o); }
    { float s0 = 0.f, s1 = 0.f;
#pragma unroll
      for (int i = 0; i < 8; ++i) { s0 += lf[i].x; s1 += lf[i].y; }
      *(LAS f32x2*)(TOT + tq * 128 + 2 * kp) = (f32x2){s0, s1}; }
    LDS_WAIT(); __builtin_amdgcn_s_barrier(); asm volatile("" ::: "memory");
    for (int c = 0; c < NCHUNK; ++c) {
        const LAS float* TC = TOT + (c & 1) * 1024;
        float off0 = 0.f, off1 = 0.f, ref0 = 0.f, ref1 = 0.f, all0 = 0.f, all1 = 0.f;
#pragma unroll
        for (int t2 = 0; t2 < 8; ++t2) { const f32x2 tt = *(const LAS f32x2*)(TC + t2 * 128 + 2 * kp);
            if (t2 < tq) { off0 += tt.x; off1 += tt.y; } if (t2 < 4) { ref0 += tt.x; ref1 += tt.y; } all0 += tt.x; all1 += tt.y; }
        const bool outp = (c >= 4);
        float k20[8], k21[8];
        { float b0 = off0, b1 = off1; const float ca0 = __expf(all0 - ref0), ca1 = __expf(all1 - ref1);
#pragma unroll
          for (int i = 0; i < 8; ++i) {
            b0 += lf[i].x; b1 += lf[i].y;
            const float kk0 = 1.0f - __expf(lf[i].x), kk1 = 1.0f - __expf(lf[i].y);
            const float ks0 = kk0 * __expf(ref0 - b0), ks1 = kk1 * __expf(ref1 - b1);
            k20[i] = ks0 * ca0; k21[i] = ks1 * ca1;
            if (outp) { const float q0 = bf_lo(qv[i]), q1 = bf_hi(qv[i]); const int t = 8 * tq + i;
                *(LAS unsigned*)(lds + HG_QS + t * 272 + 4 * kp) = cvt_pk_bf16(q0 * __expf(b0 - ref0), q1 * __expf(b1 - ref1));
                *(LAS unsigned*)(lds + HG_KS + t * 272 + 4 * kp) = cvt_pk_bf16(ks0, ks1); }
          } }
        { v4u a, bq; a.x = cvt_pk_bf16(k20[0], k20[1]); a.y = cvt_pk_bf16(k20[2], k20[3]); a.z = cvt_pk_bf16(k20[4], k20[5]); a.w = cvt_pk_bf16(k20[6], k20[7]);
          bq.x = cvt_pk_bf16(k21[0], k21[1]); bq.y = cvt_pk_bf16(k21[2], k21[3]); bq.z = cvt_pk_bf16(k21[4], k21[5]); bq.w = cvt_pk_bf16(k21[6], k21[7]);
          *(LAS v4u*)(lds + HG_K2T + (2 * kp) * 144 + 16 * tq) = a; *(LAS v4u*)(lds + HG_K2T + (2 * kp + 1) * 144 + 16 * tq) = bq;
          v4u lo, hi;
          lo.x = __builtin_amdgcn_perm(vv[1], vv[0], 0x05040100u); lo.y = __builtin_amdgcn_perm(vv[3], vv[2], 0x05040100u); lo.z = __builtin_amdgcn_perm(vv[5], vv[4], 0x05040100u); lo.w = __builtin_amdgcn_perm(vv[7], vv[6], 0x05040100u);
          hi.x = __builtin_amdgcn_perm(vv[1], vv[0], 0x07060302u); hi.y = __builtin_amdgcn_perm(vv[3], vv[2], 0x07060302u); hi.z = __builtin_amdgcn_perm(vv[5], vv[4], 0x07060302u); hi.w = __builtin_amdgcn_perm(vv[7], vv[6], 0x07060302u);
          *(LAS v4u*)(lds + HG_VT + (2 * kp) * 144 + 16 * tq) = lo; *(LAS v4u*)(lds + HG_VT + (2 * kp + 1) * 144 + 16 * tq) = hi; }
        if (tq == 0) { *(LAS f32x2*)(DEC + 2 * kp) = (f32x2){__expf(all0), __expf(all1)}; *(LAS f32x2*)(EREF + 2 * kp) = (f32x2){__expf(ref0), __expf(ref1)}; }
        if (kp == 0) {
#pragma unroll
            for (int i = 0; i < 8; ++i) ROWS[8 * tq + i] = rows[i]; }
        if (c + 1 < NCHUNK) {
#pragma unroll
            for (int i = 0; i < 8; ++i) { rows[i] = hg_row(b, dir, 64 * (c + 1) + 8 * tq + i); const size_t o = (size_t)rows[i] * D_B + colb + 2 * kp;
                lf[i] = pg8::unpk_f16(*(const GAS unsigned*)(LF + o)); qv[i] = *(const GAS unsigned*)(Q + o); vv[i] = *(const GAS unsigned*)(V + o); } }
        LDS_WAIT(); __builtin_amdgcn_s_barrier(); asm volatile("" ::: "memory");
        bf16x8 Vf[2];
#pragma unroll
        for (int ks2 = 0; ks2 < 2; ++ks2) Vf[ks2] = *(const LAS bf16x8*)(lds + HG_VT + (16 * w + r16) * 144 + 64 * ks2 + 16 * q4);
        f32x4 oacc[4]; int orow[4][4];
#pragma unroll
        for (int ti = 0; ti < 4; ++ti) oacc[ti] = (f32x4){0.f, 0.f, 0.f, 0.f};
        if (outp) {
            bf16x8 Af[4], Bf[2][4];
#pragma unroll
            for (int ks = 0; ks < 4; ++ks) Af[ks] = *(const LAS bf16x8*)(lds + HG_KS + (16 * (w >> 1) + r16) * 272 + 64 * ks + 16 * q4);
#pragma unroll
            for (int tsel = 0; tsel < 2; ++tsel) { const int ti = 2 * (w & 1) + tsel;
#pragma unroll
                for (int ks = 0; ks < 4; ++ks) Bf[tsel][ks] = *(const LAS bf16x8*)(lds + HG_QS + (16 * ti + r16) * 272 + 64 * ks + 16 * q4); }
#pragma unroll
            for (int ti = 0; ti < 4; ++ti) { typedef int i32x4 __attribute__((ext_vector_type(4))); const i32x4 rr = *(const LAS i32x4*)(ROWS + 16 * ti + 4 * q4);
                orow[ti][0] = rr.x; orow[ti][1] = rr.y; orow[ti][2] = rr.z; orow[ti][3] = rr.w; }
#pragma unroll
            for (int tsel = 0; tsel < 2; ++tsel) { const int idx = 2 * w + tsel, si = idx >> 2, ti = idx & 3;
                f32x4 dacc = (f32x4){0.f, 0.f, 0.f, 0.f};
#pragma unroll
                for (int ks = 0; ks < 4; ++ks) dacc = __builtin_amdgcn_mfma_f32_16x16x32_bf16(Af[ks], Bf[tsel][ks], dacc, 0, 0, 0);
                const int t = 16 * ti + r16, s0 = 16 * si + 4 * q4;
#pragma unroll
                for (int j = 0; j < 4; ++j) if (s0 + j > t) dacc[j] = 0.f;
                v2u pw; pw.x = cvt_pk_bf16(dacc[0], dacc[1]); pw.y = cvt_pk_bf16(dacc[2], dacc[3]);
                *(LAS v2u*)(lds + HG_P + t * 144 + 2 * s0) = pw; }
            v2u alo[4][4], ahi[4][4]; f32x4 er[8];
#pragma unroll
            for (int kt = 0; kt < 8; ++kt) er[kt] = *(const LAS f32x4*)(EREF + 16 * kt + 4 * q4);
#pragma unroll
            for (int ks = 0; ks < 4; ++ks)
#pragma unroll
                for (int ti = 0; ti < 4; ++ti) { alo[ks][ti] = *(const LAS v2u*)(lds + HG_QS + (16 * ti + r16) * 272 + 64 * ks + 8 * q4);
                    ahi[ks][ti] = *(const LAS v2u*)(lds + HG_QS + (16 * ti + r16) * 272 + 64 * ks + 32 + 8 * q4); }
#pragma unroll
            for (int ks = 0; ks < 4; ++ks) { const f32x4 s0 = S[2 * ks] * er[2 * ks], s1 = S[2 * ks + 1] * er[2 * ks + 1];
                v4u sw; sw.x = cvt_pk_bf16(s0[0], s0[1]); sw.y = cvt_pk_bf16(s0[2], s0[3]); sw.z = cvt_pk_bf16(s1[0], s1[1]); sw.w = cvt_pk_bf16(s1[2], s1[3]);
                const bf16x8 Sf = __builtin_bit_cast(bf16x8, sw);
#pragma unroll
                for (int ti = 0; ti < 4; ++ti) { v4u aw; aw.x = alo[ks][ti].x; aw.y = alo[ks][ti].y; aw.z = ahi[ks][ti].x; aw.w = ahi[ks][ti].y;
                    oacc[ti] = __builtin_amdgcn_mfma_f32_16x16x32_bf16(__builtin_bit_cast(bf16x8, aw), Sf, oacc[ti], 0, 0, 0); } }
        }
        { bf16x8 Kf[8][2]; f32x4 dc[8];
#pragma unroll
          for (int kt = 0; kt < 8; ++kt) { dc[kt] = *(const LAS f32x4*)(DEC + 16 * kt + 4 * q4);
#pragma unroll
              for (int ks2 = 0; ks2 < 2; ++ks2) Kf[kt][ks2] = *(const LAS bf16x8*)(lds + HG_K2T + (16 * kt + r16) * 144 + 64 * ks2 + 16 * q4); }
#pragma unroll
          for (int kt = 0; kt < 8; ++kt) { S[kt] = S[kt] * dc[kt];
#pragma unroll
              for (int ks2 = 0; ks2 < 2; ++ks2) S[kt] = __builtin_amdgcn_mfma_f32_16x16x32_bf16(Kf[kt][ks2], Vf[ks2], S[kt], 0, 0, 0); } }
        if (c + 1 < NCHUNK) { float s0 = 0.f, s1 = 0.f;
#pragma unroll
            for (int i = 0; i < 8; ++i) { s0 += lf[i].x; s1 += lf[i].y; }
            *(LAS f32x2*)(TOT + ((c + 1) & 1) * 1024 + tq * 128 + 2 * kp) = (f32x2){s0, s1}; }
        LDS_WAIT(); __builtin_amdgcn_s_barrier(); asm volatile("" ::: "memory");
        if (outp) {
            bf16x8 Pf[4][2];
#pragma unroll
            for (int ti = 0; ti < 4; ++ti)
#pragma unroll
                for (int ks2 = 0; ks2 < 2; ++ks2) Pf[ti][ks2] = *(const LAS bf16x8*)(lds + HG_P + (16 * ti + r16) * 144 + 64 * ks2 + 16 * q4);
#pragma unroll
            for (int ti = 0; ti < 4; ++ti)
#pragma unroll
                for (int ks2 = 0; ks2 < 2; ++ks2) oacc[ti] = __builtin_amdgcn_mfma_f32_16x16x32_bf16(Pf[ti][ks2], Vf[ks2], oacc[ti], 0, 0, 0);
#pragma unroll
            for (int ti = 0; ti < 4; ++ti)
#pragma unroll
                for (int j = 0; j < 4; ++j) O[(size_t)orow[ti][j] * D_B + colb + 16 * w + r16] = (bf16)(cvt_pk_bf16(oacc[ti][j], 0.f) & 0xffffu);
        }
    }
    LDS_WAIT(); __builtin_amdgcn_s_barrier(); asm volatile("" ::: "memory");
}
__device__ __forceinline__ void hg_finalize_row(int lr, const bf16* OHG, const bf16* OG, const float* gn, bf16* YB, int lane) {
    const int row = (lr >> 11) * RPB + CTX_LEN + (lr & 2047);
    const size_t o = (size_t)row * D_B + 2 * lane;
    unsigned a[16], bq[16], og[16];
#pragma unroll
    for (int h = 0; h < 16; ++h) { a[h] = *(const GAS unsigned*)(OHG + o + h * 128); bq[h] = *(const GAS unsigned*)(OHG + (size_t)RT * D_B + o + h * 128); og[h] = *(const GAS unsigned*)(OG + o + h * 128); }
#pragma unroll
    for (int h = 0; h < 16; ++h) { const float o0 = bf_lo(a[h]) + bf_lo(bq[h]), o1 = bf_hi(a[h]) + bf_hi(bq[h]);
        const float r = 1.0f / sqrtf(wave_sum(o0 * o0 + o1 * o1) * (1.f / 128.f) + EPS);
        const f32x2 g = *(const GAS f32x2*)(gn + h * 128 + 2 * lane);
        *(GAS unsigned*)(YB + (size_t)row * pg8::DY + 2 * lane + h * 128) = cvt_pk_bf16(o0 * r * g.x * silu_f(bf_lo(og[h])), o1 * r * g.y * silu_f(bf_hi(og[h])));
    }
}

constexpr int ITB_WIN = 3 * IT_FF, ITB_GLU = ITB_WIN + IT_WIN, ITB_FF2 = ITB_GLU + IT_GLU + IT_PA + IT_PB + IT_OUT;
constexpr int TAIL2_ITEMS = 30912, TAIL5_ITEMS = 3000;
constexpr int CONV6_ITEMS = 24000;
constexpr int P0_HOLE = ITB_WIN, P0_ITEMS = T_ITEMS - IT_FF - TAIL2_ITEMS - CONV6_ITEMS;
static_assert(ITB_FF2 + 3 * IT_FF == T_ITEMS, "item list");
__device__ __forceinline__ ItemDesc item_desc(const Args& args, unsigned char* ws, int it) {
    int r = it;
    if (r < IT_FF) return make_item(args.in[I_W1A], D_MODEL, D_FF, (bf16*)(ws + WS_W13A), 1, r); r -= IT_FF;
    if (r < IT_FF) return make_item(args.in[I_W3A], D_MODEL, D_FF, (bf16*)(ws + WS_W13A), 2, r); r -= IT_FF;
    if (r < IT_FF) return make_item(args.in[I_W2A], D_FF, D_MODEL, (bf16*)(ws + WS_W2A), 0, r, D_FFP); r -= IT_FF;
    if (r < IT_WIN) return make_item(args.in[I_WIN], D_MODEL, N_IN, (bf16*)(ws + WS_WIN), 3, r); r -= IT_WIN;
    if (r < IT_GLU) return make_item(args.in[I_WGLU], D_A, D_A, (bf16*)(ws + WS_WGLU), 0, r); r -= IT_GLU;
    if (r < IT_PA) return make_item(args.in[I_WPA], D_A, D_MODEL, (bf16*)(ws + WS_WP) + D_B, 0, r, pg8::DY); r -= IT_PA;
    if (r < IT_PB) return make_item(args.in[I_WPB], D_B, D_MODEL, (bf16*)(ws + WS_WP), 0, r, pg8::DY); r -= IT_PB;
    if (r < IT_OUT) return make_item(args.in[I_WOUT], D_MODEL, D_MODEL, (bf16*)(ws + WS_WOUT), 0, r); r -= IT_OUT;
    if (r < IT_FF) return make_item(args.in[I_W1B], D_MODEL, D_FF, (bf16*)(ws + WS_W13B), 1, r); r -= IT_FF;
    if (r < IT_FF) return make_item(args.in[I_W3B], D_MODEL, D_FF, (bf16*)(ws + WS_W13B), 2, r); r -= IT_FF;
    return make_item(args.in[I_W2B], D_FF, D_MODEL, (bf16*)(ws + WS_W2B), 0, r, D_FFP);
}
__device__ __forceinline__ void convert_range(const Args& args, unsigned char* ws, int first, int end, int step, LAS float* s, int lane, int hole_at = 0x7fffffff, int hole_len = 0) {
    if (first >= end) return;
    ItemDesc d0 = item_desc(args, ws, first < hole_at ? first : first + hole_len), d1 = d0; f32x4 va[8], vb[8]; item_load(d0, va, lane);
    if (first + step < end) { const int n1 = first + step; d1 = item_desc(args, ws, n1 < hole_at ? n1 : n1 + hole_len); item_load(d1, vb, lane); }
    else {
#pragma unroll
        for (int i = 0; i < 8; ++i) vb[i] = va[i]; }
    for (int it = first; it < end; it += step) {
        const int n2 = it + 2 * step; ItemDesc d2 = d1; f32x4 vc[8];
        if (n2 < end) { d2 = item_desc(args, ws, n2 < hole_at ? n2 : n2 + hole_len); item_load(d2, vc, lane); }
        else {
#pragma unroll
            for (int i = 0; i < 8; ++i) vc[i] = vb[i]; }
        item_store(d0, va, s, lane);
        d0 = d1; d1 = d2;
#pragma unroll
        for (int i = 0; i < 8; ++i) { va[i] = vb[i]; vb[i] = vc[i]; }
    }
}
__device__ __forceinline__ void tail_convert(const Args& args, unsigned char* ws, int begin, int end, int first_block, int G, int bx, int wave, LAS float* s) {
    int tl = threadIdx.x; asm volatile("" : "+v"(tl));
    if (first_block >= G) { convert_range(args, ws, begin + bx * NWAVES + wave, end, G * NWAVES, s, tl & 63); return; }
    if (bx < first_block) return;
    convert_range(args, ws, begin + (bx - first_block) * NWAVES + wave, end, (G - first_block) * NWAVES, s, tl & 63);
}

__global__ void __launch_bounds__(NWAVES * 64, 2) fwd_kernel(Args args) {
    extern __shared__ __attribute__((aligned(16))) unsigned char lds_raw[];
    LAS unsigned char* lds = (LAS unsigned char*)lds_raw;
    volatile LAS unsigned* MISC = (volatile LAS unsigned*)(lds + MISC_OFF);
    const int tid = threadIdx.x, wave = __builtin_amdgcn_readfirstlane(tid >> 6);
#define PHASE_LANE() int tidp = threadIdx.x; asm volatile("" : "+v"(tidp)); const int lane = tidp & 63; (void)lane
    const int G = gridDim.x, bx = blockIdx.x;
    const int vcu = (G % 8 == 0) ? (bx % 8) * (G / 8) + bx / 8 : bx;
    const int gw = vcu * NWAVES + wave, NGW = G * NWAVES;
    unsigned char* ws = args.ws;
    gu32* ctl = (gu32*)(ws + WS_CTL);
    for (int u = tid; u < (LDS_BYTES - LDSCTL_OFF) / 4; u += NWAVES * 64) ((LAS unsigned*)(lds + LDSCTL_OFF))[u] = 0u;
    __syncthreads();
    XcdBarrier bar = xcd_barrier_post((unsigned*)(ctl + CW_BAR), MISC + 8);
    LAS unsigned char* scr = lds + RING_OFF + wave * 16384;

    float* MODP = (float*)(ws + WS_MODP); float* MOD = (float*)(ws + WS_MOD); float* TAB = (float*)(ws + WS_TAB); float* LBT = (float*)(ws + WS_TAB + 512 * 1024);
    bf16* W13A = (bf16*)(ws + WS_W13A); bf16* W2A = (bf16*)(ws + WS_W2A); bf16* WIN = (bf16*)(ws + WS_WIN); bf16* WGLU = (bf16*)(ws + WS_WGLU); bf16* WPA = (bf16*)(ws + WS_WPA);
    bf16* WPB = (bf16*)(ws + WS_WPB); bf16* WOUT = (bf16*)(ws + WS_WOUT); bf16* W13B = (bf16*)(ws + WS_W13B); bf16* W2B = (bf16*)(ws + WS_W2B);
    bf16* ZN = (bf16*)(ws + WS_ZN); bf16* HID = (bf16*)(ws + WS_HID); pg8::h16_t* HB = (pg8::h16_t*)(ws + WS_H); pg8::h16_t* UA = (pg8::h16_t*)(ws + WS_UA);
    bf16* QB_ = (bf16*)(ws + WS_Q); bf16* VB_ = (bf16*)(ws + WS_V); bf16* OGB = (bf16*)(ws + WS_OG); pg8::h16_t* LFF = (pg8::h16_t*)(ws + WS_LFF); pg8::h16_t* LFB = (pg8::h16_t*)(ws + WS_LFB);
    bf16* SGA = (bf16*)(ws + WS_SGA); bf16* SGB = (bf16*)(ws + WS_SGB); float* XEND = (float*)(ws + WS_XEND); bf16* GA = (bf16*)(ws + WS_GA); bf16* YY = (bf16*)(ws + WS_Y); bf16* WP = (bf16*)(ws + WS_WP);
    bf16* OHG = (bf16*)(ws + WS_OHG); float* PT = (float*)(ws + WS_PT); bf16* MRG = (bf16*)(ws + WS_MRG);

    {
        PHASE_LANE();
        for (int idx = bx * (NWAVES * 64) + tidp; idx < 8192 + 4096; idx += G * NWAVES * 64) {
            if (idx < 8192) s5_table_entry(args.in[I_LAMRE], args.in[I_LAMIM], args.in[I_LOGDT], TAB, idx);
            else { const int j = idx - 8192, d = j >> 11, cc = j & 2047; const float l0 = args.in[I_LBLOG][(d * 2 + 0) * D_B + cc], l1 = args.in[I_LBLOG][(d * 2 + 1) * D_B + cc]; LBT[j] = 1.0f / (1.0f + expf(l1 - l0)); }
        }
        if (NGW > ADA_TASKS) {
            int per = (P0_ITEMS + ADA_TASKS * 64 + NGW - 1) / NGW; if (per < 64) per = 64;
            const int a = per - 64, s1 = (a * NGW < P0_ITEMS) ? a * NGW : P0_ITEMS;
            convert_range(args, ws, gw, s1, NGW, (LAS float*)scr, lane, P0_HOLE, TAIL2_ITEMS);
            if (gw < ADA_TASKS) p0_ada_task(args.in[I_C], args.in[I_CCTX], args.in[I_WADA], MODP, gw, (LAS float*)scr, lane);
            else convert_range(args, ws, s1 + (gw - ADA_TASKS), P0_ITEMS, NGW - ADA_TASKS, (LAS float*)scr, lane, P0_HOLE, TAIL2_ITEMS);
        } else {
            for (int t = gw; t < ADA_TASKS; t += NGW) p0_ada_task(args.in[I_C], args.in[I_CCTX], args.in[I_WADA], MODP, t, (LAS float*)scr, lane);
            convert_range(args, ws, gw, P0_ITEMS, NGW, (LAS float*)scr, lane, P0_HOLE, TAIL2_ITEMS);
        }
    }
    xcd_barrier(bar);
    { PHASE_LANE();
    for (int idx = bx * (NWAVES * 64) + tidp; idx < 5 * NMODC_; idx += G * NWAVES * 64) {
        float s = args.in[I_BADA][idx % NMODC_];
#pragma unroll
        for (int k = 0; k < ADA_KS; ++k) s += MODP[(size_t)k * 5 * NMODC_ + idx];
        MOD[idx] = s;
    } }
    xcd_barrier(bar);
    { PHASE_LANE();
    for (int m = gw; m < RT; m += NGW) { const int b = m / RPB, t = m - b * RPB; const bool isctx = t < CTX_LEN;
        const float* src = isctx ? args.in[I_CTX] + ((size_t)b * CTX_LEN + t) * D_MODEL : args.in[I_X] + ((size_t)b * SEQ + (t - CTX_LEN)) * D_MODEL;
        const float* mv = MOD + (size_t)(isctx ? 4 : b) * NMODC_;
        norm_mod_row(src, args.in[I_NORM1], mv + 0 * D_MODEL, mv + 1 * D_MODEL, ZN + (size_t)m * D_MODEL, lane); } }
    xcd_barrier(bar);
    { pg8::Gemm g{ZN, W13A, RT, 2 * D_FF, D_MODEL}; pg8::TileOrder S; S.init(36, 86, G, bx, 0); pg8::EpiSwiGLU E{HID, D_FFP};
      pg8::gemm_phase<pg8::EpiSwiGLU, pg8::TileOrder, true, true>(lds + RING_OFF, g, S, E); }
    tail_convert(args, ws, ITB_WIN, ITB_WIN + TAIL2_ITEMS, (36 * 86) % 256, G, bx, wave, (LAS float*)scr);
    xcd_barrier(bar);
    { pg8::Gemm g{HID, W2A, RT, D_MODEL, D_FF, D_FFP}; pg8::DownSplitOrder S; S.init(G, bx); pg8::EpiDown1 E{{args.in[I_X], args.in[I_CTX], HB, nullptr, MOD, 2, 0.5f}, (pg8::h16_t*)PT};
      pg8::gemm_phase<pg8::EpiDown1, pg8::DownSplitOrder, true, true>(lds + RING_OFF, g, S, E); }
    xcd_barrier(bar);
    { PHASE_LANE();
    for (int m = gw; m < RT; m += NGW) { const int b = m / RPB, t = m - b * RPB; const bool isctx = t < CTX_LEN;
        const float* mv = MOD + (size_t)(isctx ? 4 : b) * NMODC_;
        int ln = lane; asm volatile("" : "+v"(ln));
        if (isctx) norm_mod_row_part(args.in[I_CTX] + ((size_t)b * CTX_LEN + t) * D_MODEL, (const pg8::h16_t*)PT + ((size_t)b * CTX_LEN + t) * D_MODEL, mv + 2 * D_MODEL, args.in[I_NORMMIX], mv + 3 * D_MODEL, mv + 4 * D_MODEL, ZN + (size_t)m * D_MODEL, ln);
        else norm_mod_row_h(HB + (size_t)m * D_MODEL, args.in[I_NORMMIX], mv + 3 * D_MODEL, mv + 4 * D_MODEL, ZN + (size_t)m * D_MODEL, ln);
    } }
    xcd_barrier(bar);
    { pg8::Gemm g{ZN, WIN, RT, N_IN, D_MODEL}; pg8::TileOrder2 S; S.init(28, 48, G, bx); pg8::EpiWin E{UA, QB_, LFF, SGA, LBT};
      pg8::gemm_phase<pg8::EpiWin, pg8::TileOrder2, true, true>(lds + RING_OFF, g, S, E); }
    tail_convert(args, ws, T_ITEMS - IT_FF, T_ITEMS - IT_FF + TAIL5_ITEMS, (36 * 28 + 32 * 48) % 256, G, bx, wave, (LAS float*)scr);
    xcd_barrier(bar);
    { PHASE_LANE();
      constexpr int NTA = BATCH * 2 * S5_G * NCHUNK, NTC = BATCH * S5_G * 32;
      const bool hgblk = (G > 128) && (bx < 128);
      const unsigned nprod = (G > 128) ? (unsigned)(G - 128) : (unsigned)G;
      for (int u = bx; u < 128; u += G) hgrn2_unit(lds + RING_OFF, u, QB_, VB_, LFF, LFB, OHG, tidp);
      if (!hgblk) {
          for (;;) {
              int base = 0; if (lane == 0) base = (int)__hip_atomic_fetch_add((unsigned*)(ctl + CW_QUEUE), 4u, RLX_AGENT);
              base = __builtin_amdgcn_readfirstlane(base);
              if (base >= NTA) break;
#pragma unroll 1
              for (int t = base; t < base + 4; ++t) s5_pass_a(scr, t, TAB, args.in[I_BRE], args.in[I_BIM], UA, XEND, lane);
          }
          asm volatile("s_waitcnt vmcnt(0)" ::: "memory");
          __syncthreads();
          if (tidp == 0) (void)__hip_atomic_fetch_add((unsigned*)(ctl + CW_DONE), 1u, RLX_AGENT);
      }
      if (tidp == 0) { unsigned sp = 0;
          while (__hip_atomic_load((unsigned*)(ctl + CW_DONE), RLX_AGENT) < nprod) { __builtin_amdgcn_s_sleep(8);
              if ((++sp & 255u) == 0u) { if (xb_ld((unsigned*)(ctl + CW_BAR) + XB_TMO)) break; if (sp > (1u << 20)) { atomicAdd((unsigned*)(ctl + CW_BAR) + XB_TMO, 1u); break; } } }
          __builtin_amdgcn_fence(__ATOMIC_ACQUIRE, "agent");
          asm volatile("s_waitcnt vmcnt(0)" ::: "memory"); }
      __syncthreads();
      for (;;) {
          int base = 0; if (lane == 0) base = (int)__hip_atomic_fetch_add((unsigned*)(ctl + CW_QUEUE2), 2u, RLX_AGENT);
          base = __builtin_amdgcn_readfirstlane(base);
          if (base >= NTC) break;
#pragma unroll 1
          for (int t = base; t < base + 2; ++t) s5_pass_c(scr, t, TAB, args.in[I_BRE], args.in[I_BIM], args.in[I_CRE], args.in[I_CIM], args.in[I_S5D], UA, XEND, GA, lane);
      }
      for (;;) {
          int base = 0; if (lane == 0) base = (int)__hip_atomic_fetch_add((unsigned*)(ctl + CW_QUEUE3), 8u, RLX_AGENT);
          base = __builtin_amdgcn_readfirstlane(base);
          if (base >= CONV6_ITEMS) break;
          const int i0 = T_ITEMS - IT_FF - CONV6_ITEMS + base;
          convert_range(args, ws, i0, i0 + 8, 1, (LAS float*)scr, lane);
      }
    }
    xcd_barrier(bar);
    const bool glu_split = (G == 256);
    if (glu_split && bx < 128) {
      pg8::Gemm g{GA, WGLU, RT, D_A, D_A}; pg8::TileOrder S; S.init(32, 4, 128, bx, 1); pg8::EpiGlu E{GA, YY + D_B};
      pg8::gemm_phase<pg8::EpiGlu, pg8::TileOrder, true, true>(lds + RING_OFF, g, S, E);
    } else { PHASE_LANE();
    const int gw7 = glu_split ? (bx - 128) * NWAVES + wave : gw, ngw7 = glu_split ? NGW - 128 * NWAVES : NGW;
    for (int t = gw7; t < BATCH * SEQ; t += ngw7) hg_finalize_row(t, OHG, OGB, args.in[I_HGNORM], YY, lane);
    }
    xcd_barrier(bar);
    if (!glu_split) { pg8::Gemm g{GA, WGLU, RT, D_A, D_A}; pg8::TileOrder S; S.init(32, 4, G, bx, 1); pg8::EpiGlu E{GA, YY + D_B};
      pg8::gemm_phase<pg8::EpiGlu, pg8::TileOrder, true, true>(lds + RING_OFF, g, S, E); xcd_barrier(bar); }
    { pg8::Gemm g{YY, WP, RT, D_MODEL, D_B + D_A}; pg8::TileOrder S; S.init(32, 16, G, bx, 1); pg8::EpiMerge E{SGA, SGB, MRG};
      pg8::gemm_phase<pg8::EpiMerge, pg8::TileOrder, true, true>(lds + RING_OFF, g, S, E); }
    xcd_barrier(bar);
    { pg8::Gemm g{MRG, WOUT, RT, D_MODEL, D_MODEL}; pg8::TileOrder S; S.init(32, 16, G, bx, 1); pg8::EpiResid<1, 0> E{nullptr, nullptr, HB, nullptr, MOD, 5, 1.0f};
      pg8::gemm_phase<pg8::EpiResid<1, 0>, pg8::TileOrder, true, true>(lds + RING_OFF, g, S, E); }
    xcd_barrier(bar);
    { PHASE_LANE();
    for (int lr = gw; lr < BATCH * SEQ; lr += NGW) { const int b = lr >> 11, m = b * RPB + CTX_LEN + (lr & 2047);
        const float* mv = MOD + (size_t)b * NMODC_;
        norm_mod_row_h(HB + (size_t)m * D_MODEL, args.in[I_NORM2], mv + 6 * D_MODEL, mv + 7 * D_MODEL, ZN + (size_t)m * D_MODEL, lane); } }
    xcd_barrier(bar);
    { pg8::Gemm g{ZN, W13B, RT, 2 * D_FF, D_MODEL}; pg8::TileOrder S; S.init(32, 86, G, bx, 1); pg8::EpiSwiGLU E{HID, D_FFP};
      pg8::gemm_phase<pg8::EpiSwiGLU, pg8::TileOrder, true, true>(lds + RING_OFF, g, S, E); }
    tail_convert(args, ws, T_ITEMS - IT_FF + TAIL5_ITEMS, T_ITEMS, (32 * 86) % 256, G, bx, wave, (LAS float*)scr);
    xcd_barrier(bar);
    { pg8::Gemm g{HID, W2B, RT, D_MODEL, D_FF, D_FFP}; pg8::HalfRowsOrder S; S.init(G, bx); pg8::EpiResid<1, 0> E{nullptr, nullptr, HB, nullptr, MOD, 8, 0.5f};
      pg8::gemm_phase<pg8::EpiResid<1, 0>, pg8::HalfRowsOrder, true, true>(lds + RING_OFF, g, S, E); }
    xcd_barrier(bar);
    { PHASE_LANE();
    const bool tmo_set = __hip_atomic_load((unsigned*)(ctl + CW_BAR) + XB_TMO, RLX_AGENT) != 0u;
    for (int lr = gw; lr < BATCH * SEQ; lr += NGW) { norm_final_row_h(HB + ((size_t)(lr >> 11) * RPB + CTX_LEN + (lr & 2047)) * D_MODEL, args.out + (size_t)lr * D_MODEL, args.in[I_NORMF], lane);
        if (tmo_set) { GAS f32x4* xr = (GAS f32x4*)(args.out + (size_t)lr * D_MODEL) + lane;
#pragma unroll
            for (int j = 0; j < 16; ++j) xr[64 * j] = (f32x4){1e30f, 1e30f, 1e30f, 1e30f}; } } }
}

extern "C" void kernel_launch(void* const* d_in, const int* in_sizes, int n_in, void* d_out, int out_size, void* d_ws, size_t ws_size, hipStream_t stream) {
    static int grid = 0;
    if (grid == 0) {
        if (n_in != 31 || out_size != BATCH * SEQ * D_MODEL || ws_size < WS_END) { fprintf(stderr, "kernel_launch: unexpected shapes (n_in %d, out %d, ws %zu)\n", n_in, out_size, ws_size); grid = -1; return; }
        int dev = 0, cus = 0, per_cu = 0;
        if (hipGetDevice(&dev) != hipSuccess || hipDeviceGetAttribute(&cus, hipDeviceAttributeMultiprocessorCount, dev) != hipSuccess) { grid = -1; return; }
        if (hipFuncSetAttribute((const void*)fwd_kernel, hipFuncAttributeMaxDynamicSharedMemorySize, LDS_BYTES) != hipSuccess) { fprintf(stderr, "kernel_launch: hipFuncSetAttribute failed\n"); grid = -1; return; }
        if (hipOccupancyMaxActiveBlocksPerMultiprocessor(&per_cu, (const void*)fwd_kernel, NWAVES * 64, LDS_BYTES) != hipSuccess || per_cu < 1)
            fprintf(stderr, "kernel_launch: note: occupancy query reports %d workgroups per CU\n", per_cu);
        (void)hipGetLastError();
        grid = cus;
    }
    if (grid < 0) return;
    if (hipMemsetAsync((char*)d_ws + WS_CTL, 0, CTL_ZERO_BYTES, stream) != hipSuccess) { fprintf(stderr, "kernel_launch: memset failed\n"); return; }
    Args a{};
    for (int i = 0; i < 31; ++i) a.in[i] = (const float*)d_in[i];
    a.out = (float*)d_out; a.ws = (unsigned char*)d_ws;
    hipLaunchKernelGGL(fwd_kernel, dim3(grid), dim3(NWAVES * 64), LDS_BYTES, stream, a);
    const hipError_t le = hipPeekAtLastError();
    if (le != hipSuccess) fprintf(stderr, "kernel_launch: launch failed: %s\n", hipGetErrorName(le));
}
```

```cpp
#include <hip/hip_runtime.h>
#include <cstdio>
#include <cstdint>

namespace pg8 {
#define PG8_LAS __attribute__((address_space(3)))
typedef unsigned short bf16_t;
typedef short bf16x8 __attribute__((ext_vector_type(8)));
typedef float f32x4 __attribute__((ext_vector_type(4)));
typedef unsigned u32x4 __attribute__((ext_vector_type(4)));
constexpr int BM = 256, BK = 64, HALF = 128, HTB = HALF * BK * 2  , STAGE_BYTES = 8 * HTB, NXCD = 8, WGM = 8;

__host__ __device__ __forceinline__ int lds_byte(int r, int c) { const int st = (r >> 4) * 2 + (c >> 5), rr = r & 15, cc = c & 31, ob = rr * 64 + cc * 2; return st * 1024 + (ob ^ (((ob >> 9) & 1) << 5)); }
__host__ __device__ __forceinline__ void stage_rc(int b, int& R, int& C) { const int st = b / 1024, sb = b % 1024, swz = sb ^ (((sb >> 9) & 1) << 5); R = (st >> 1) * 16 + swz / 64; C = (st & 1) * 32 + (swz % 64) / 2; }
__host__ __device__ __forceinline__ int perm32(int rho) { const int n = rho >> 4, i = rho & 15; return 8 * (i >> 2) + 4 * n + (i & 3); }

struct Unit { int pm, pn; };
struct Gemm { const bf16_t* A; const bf16_t* Bt; int M, N, K, LD = 0; };

struct StaticOrder {
    static constexpr bool SPLITK = false;
    int nM, nN, nwg, G, c;
    __host__ __device__ void init(int M, int N, int G_, int c_) { nM = M / BM; nN = N / BM; nwg = nM * nN; G = G_; c = c_; }
    __host__ __device__ bool next(int i, Unit& u) const {
        const long L = (long)i * G + c; if (L >= nwg) return false;
        int wgid = (int)L; { const int q = nwg / NXCD, r = nwg % NXCD, xcd = wgid % NXCD, off = wgid / NXCD; wgid = (xcd < r ? xcd * (q + 1) : r * (q + 1) + (xcd - r) * q) + off; }
        const int nig = WGM * nN, gid = wgid / nig, fm = gid * WGM, gsz = (nM - fm) < WGM ? (nM - fm) : WGM;
        u.pm = fm + ((wgid % nig) % gsz); u.pn = (wgid % nig) / gsz; return true;
    }
    __device__ __forceinline__ void a_ready(const Unit&) const {}
    __device__ __forceinline__ void done(const Unit&) const {}
};


struct TileOrder2 {
    static constexpr bool SPLITK = false;
    int n1c, n2c, nwg1, nwg, G, c;
    __host__ __device__ void init(int n1c_, int n2c_, int G_, int c_) { n1c = n1c_; n2c = n2c_; nwg1 = 36 * n1c; nwg = nwg1 + 32 * n2c; G = G_; c = c_; }
    __host__ __device__ static void map(int L, int nM, int nN, int& pm, int& pn) {
        const int nwg = nM * nN; int wgid = L; { const int q = nwg / NXCD, r = nwg % NXCD, xcd = wgid % NXCD, off = wgid / NXCD; wgid = (xcd < r ? xcd * (q + 1) : r * (q + 1) + (xcd - r) * q) + off; }
        const int nig = WGM * nN, gid = wgid / nig, fm = gid * WGM, gsz = (nM - fm) < WGM ? (nM - fm) : WGM;
        pm = fm + ((wgid % nig) % gsz); pn = (wgid % nig) / gsz; }
    __host__ __device__ bool next(int i, Unit& u) const {
        const long L = (long)i * G + c; if (L >= nwg) return false;
        int pm, pn;
        if (L < nwg1) map((int)L, 36, n1c, pm, pn);
        else { map((int)L - nwg1, 32, n2c, pm, pn); pm = (pm >> 3) * 9 + 1 + (pm & 7); pn += n1c; }
        u.pm = pm; u.pn = pn; return true;
    }
    __device__ __forceinline__ void a_ready(const Unit&) const {}
    __device__ __forceinline__ void done(const Unit&) const {}
};
struct TileOrder {
    static constexpr bool SPLITK = false;
    int nM, nN, nwg, G, c, lat_only;
    __host__ __device__ void init(int nM_, int nN_, int G_, int c_, int lat_only_) { nM = nM_; nN = nN_; nwg = nM * nN; G = G_; c = c_; lat_only = lat_only_; }
    __host__ __device__ bool next(int i, Unit& u) const {
        const long L = (long)i * G + c; if (L >= nwg) return false;
        int wgid = (int)L; { const int q = nwg / NXCD, r = nwg % NXCD, xcd = wgid % NXCD, off = wgid / NXCD; wgid = (xcd < r ? xcd * (q + 1) : r * (q + 1) + (xcd - r) * q) + off; }
        const int nig = WGM * nN, gid = wgid / nig, fm = gid * WGM, gsz = (nM - fm) < WGM ? (nM - fm) : WGM;
        int pm = fm + ((wgid % nig) % gsz); u.pn = (wgid % nig) / gsz;
        if (lat_only) pm = (pm >> 3) * 9 + 1 + (pm & 7);
        u.pm = pm; return true;
    }
    __device__ __forceinline__ void a_ready(const Unit&) const {}
    __device__ __forceinline__ void done(const Unit&) const {}
};

struct HalfRowsOrder {
    static constexpr bool SPLITK = false, STAGGER = false;
    TileOrder fb; int G, c;
    __host__ __device__ void init(int G_, int c_) { fb.init(32, 16, G_, c_, 1); G = G_; c = c_; }
    __host__ __device__ bool next(int i, Unit& u) const {
        if (G != 256) return fb.next(i, u);
        if (i >= 2) return false;
        const int x = c & 7, j = c >> 3, pl = 16 * i + 4 * (x >> 1) + (j & 3);
        u.pm = (pl >> 3) * 9 + 1 + (pl & 7); u.pn = 8 * (x & 1) + (j >> 2); return true;
    }
    __device__ __forceinline__ void a_ready(const Unit&) const {}
    __device__ __forceinline__ void done(const Unit&) const {}
};
struct DownSplitOrder {
    static constexpr bool SPLITK = true;
    HalfRowsOrder lat; int G, c;
    __host__ __device__ void init(int G_, int c_) { lat.init(G_, c_); G = G_; c = c_; }
    __host__ __device__ bool next(int i, Unit& u) const {
        const long L = (long)i * G + c; if (L >= 512 + 256) return false;
        if (L < 512) return lat.next(i, u);
        const int idx = (int)L - 512;
        u.pm = 9 * (idx >> 6); u.pn = ((idx >> 2) & 15) | (((idx & 3) + 1) << 8); return true;
    }
    __host__ __device__ static int kt0(const Unit& u) { const int q = u.pn >> 8; return q == 0 ? 0 : (q - 1) * 44 - (q == 4 ? 2 : 0); }
    __host__ __device__ static int cnt(const Unit& u, int full) { const int q = u.pn >> 8; return q == 0 ? full : (q <= 2 ? 44 : 42); }
    __device__ __forceinline__ void a_ready(const Unit&) const {}
    __device__ __forceinline__ void done(const Unit&) const {}
};

typedef float f32x2_cv __attribute__((ext_vector_type(2)));
typedef __bf16 bf16x2_cv __attribute__((ext_vector_type(2)));
__device__ __forceinline__ unsigned cvt_pk_bf16(float lo, float hi) { const f32x2_cv v = {lo, hi}; const bf16x2_cv b = __builtin_convertvector(v, bf16x2_cv); return __builtin_bit_cast(unsigned, b); }
typedef _Float16 h16x2_cv __attribute__((ext_vector_type(2)));
typedef unsigned short h16_t;
__device__ __forceinline__ unsigned cvt_pk_f16(float lo, float hi) { const f32x2_cv v = {lo, hi}; const h16x2_cv h = __builtin_convertvector(v, h16x2_cv); return __builtin_bit_cast(unsigned, h); }
__device__ __forceinline__ f32x2_cv unpk_f16(unsigned w) { const h16x2_cv h = __builtin_bit_cast(h16x2_cv, w); return __builtin_convertvector(h, f32x2_cv); }
__device__ __forceinline__ float bf_lo(unsigned w) { return __uint_as_float(w << 16); }
__device__ __forceinline__ float bf_hi(unsigned w) { return __uint_as_float(w & 0xffff0000u); }
__device__ __forceinline__ float sigmoid_f(float x) { return __builtin_amdgcn_rcpf(1.0f + __builtin_amdgcn_exp2f(-1.4426950408889634f * x)); }
__device__ __forceinline__ float silu_f(float x) { return x * sigmoid_f(x); }

constexpr int TOK_ROWS = 9216, ROWS_PER_B = 2304, CTXR = 256, LATR = 2048, DM = 4096, NMODC = 36864, DY = 3072;


#define EPI_PIN(x) do { asm volatile("" : "+v"(x)); __builtin_amdgcn_sched_barrier(0); } while (0)
struct EpiSwiGLU {
    static constexpr bool PERM = true, AFTER_DRAIN = false;
    bf16_t* H; int ldh;
    __device__ __forceinline__ void operator()(const f32x4 (&acc)[2][2][4][2], const Unit& u, int wr, int wc, int fr, int fq) const {
        size_t off = (size_t)(u.pm * BM + wr * 64 + fr) * ldh + u.pn * HALF + wc * 32 + 8 * fq;
#pragma unroll
        for (int ai = 0; ai < 2; ++ai) {
#pragma unroll
            for (int m = 0; m < 4; ++m) { EPI_PIN(off);
                const f32x4 a0 = acc[ai][0][m][0], a1 = acc[ai][0][m][1], b0 = acc[ai][1][m][0], b1 = acc[ai][1][m][1];
                u32x4 w; w.x = cvt_pk_bf16(silu_f(a0[0]) * b0[0], silu_f(a0[1]) * b0[1]); w.y = cvt_pk_bf16(silu_f(a0[2]) * b0[2], silu_f(a0[3]) * b0[3]);
                w.z = cvt_pk_bf16(silu_f(a1[0]) * b1[0], silu_f(a1[1]) * b1[1]); w.w = cvt_pk_bf16(silu_f(a1[2]) * b1[2], silu_f(a1[3]) * b1[3]);
                *(u32x4*)(H + off) = w; off += (size_t)16 * ldh; }
            off += (size_t)64 * ldh; }
    }
};

template <int BASE_MODE, int OUT_MODE> struct EpiResid {
    static constexpr bool PERM = true, AFTER_DRAIN = false;
    const float* x; const float* ctx; h16_t* hbuf; float* dout; const float* mod; int mchunk; float coef;
    __device__ __forceinline__ void operator()(const f32x4 (&acc)[2][2][4][2], const Unit& u, int wr, int wc, int fr, int fq) const {
        const int b = u.pm / 9, tt = u.pm - 9 * b; const bool isctx = (tt == 0);
        const float* basep = nullptr; const h16_t* baseh = nullptr; float* outp = nullptr; h16_t* outh = nullptr;
        if (BASE_MODE == 0) basep = isctx ? ctx + (size_t)b * CTXR * DM : x + ((size_t)b * LATR + (size_t)(tt - 1) * BM) * DM; else baseh = hbuf + (size_t)u.pm * BM * DM;
        if (OUT_MODE == 0) outh = hbuf + (size_t)u.pm * BM * DM; else outp = dout + ((size_t)b * LATR + (size_t)(tt - 1) * BM) * DM;
        const float* mv = mod + (size_t)(isctx ? 4 : b) * NMODC + (size_t)mchunk * DM;
        const int col0 = u.pn * BM + wc * 32 + 8 * fq;
        f32x4 g[2][2];
#pragma unroll
        for (int bj = 0; bj < 2; ++bj)
#pragma unroll
            for (int n = 0; n < 2; ++n) g[bj][n] = *(const f32x4*)(mv + col0 + bj * HALF + 4 * n) * coef;
        const size_t off0 = (size_t)(wr * 64 + fr) * DM + col0;
        f32x4 bs[4][2][2][2]; u32x4 bh[4][2][2];
#define ERES_LOAD(bt) _Pragma("unroll") for (int mm = 0; mm < 2; ++mm) { const size_t o = off0 + (size_t)(((bt) >> 1) * HALF + (((bt) & 1) * 2 + mm) * 16) * DM; \
            _Pragma("unroll") for (int bj = 0; bj < 2; ++bj) { if constexpr (BASE_MODE == 0) { _Pragma("unroll") for (int n = 0; n < 2; ++n) bs[bt][mm][bj][n] = *(const f32x4*)(basep + o + bj * HALF + 4 * n); } \
                else bh[bt][mm][bj] = *(const u32x4*)(baseh + o + bj * HALF); } }
#define ERES_DONE(bt) _Pragma("unroll") for (int mm = 0; mm < 2; ++mm) { const size_t o = off0 + (size_t)(((bt) >> 1) * HALF + (((bt) & 1) * 2 + mm) * 16) * DM; \
            _Pragma("unroll") for (int bj = 0; bj < 2; ++bj) { f32x4 b0, b1; \
                if constexpr (BASE_MODE == 0) { b0 = bs[bt][mm][bj][0]; b1 = bs[bt][mm][bj][1]; } \
                else { const u32x4 w = bh[bt][mm][bj]; const f32x2_cv p0 = unpk_f16(w.x), p1 = unpk_f16(w.y), p2 = unpk_f16(w.z), p3 = unpk_f16(w.w); b0 = (f32x4){p0.x, p0.y, p1.x, p1.y}; b1 = (f32x4){p2.x, p2.y, p3.x, p3.y}; } \
                const f32x4 r0 = b0 + g[bj][0] * acc[(bt) >> 1][bj][((bt) & 1) * 2 + mm][0], r1 = b1 + g[bj][1] * acc[(bt) >> 1][bj][((bt) & 1) * 2 + mm][1]; \
                if constexpr (OUT_MODE == 0) { u32x4 w; w.x = cvt_pk_f16(r0[0], r0[1]); w.y = cvt_pk_f16(r0[2], r0[3]); w.z = cvt_pk_f16(r1[0], r1[1]); w.w = cvt_pk_f16(r1[2], r1[3]); *(u32x4*)(outh + o + bj * HALF) = w; } \
                else { *(f32x4*)(outp + o + bj * HALF) = r0; *(f32x4*)(outp + o + bj * HALF + 4) = r1; } } }
        ERES_LOAD(0) __builtin_amdgcn_sched_barrier(0);
        ERES_LOAD(1) __builtin_amdgcn_sched_barrier(0);
        ERES_DONE(0) __builtin_amdgcn_sched_barrier(0);
        ERES_LOAD(2) __builtin_amdgcn_sched_barrier(0);
        ERES_DONE(1) __builtin_amdgcn_sched_barrier(0);
        ERES_LOAD(3) __builtin_amdgcn_sched_barrier(0);
        ERES_DONE(2) __builtin_amdgcn_sched_barrier(0);
        ERES_DONE(3)
#undef ERES_LOAD
#undef ERES_DONE
    }
};

struct EpiDown1 {
    static constexpr bool PERM = true, AFTER_DRAIN = false;
    EpiResid<0, 0> R; h16_t* part;
    __device__ __forceinline__ void operator()(const f32x4 (&acc)[2][2][4][2], const Unit& u, int wr, int wc, int fr, int fq) const {
        const int q = u.pn >> 8;
        if (q == 0) { R(acc, u, wr, wc, fr, fq); return; }
        size_t off = ((size_t)(q - 1) * 1024 + (size_t)(u.pm / 9) * CTXR + wr * 64 + fr) * DM + (u.pn & 255) * BM + wc * 32 + 8 * fq;
#pragma unroll
        for (int ai = 0; ai < 2; ++ai) {
#pragma unroll
            for (int m = 0; m < 4; ++m) { EPI_PIN(off);
#pragma unroll
                for (int bj = 0; bj < 2; ++bj) { const f32x4 v0 = acc[ai][bj][m][0], v1 = acc[ai][bj][m][1];
                    u32x4 w; w.x = cvt_pk_f16(v0[0], v0[1]); w.y = cvt_pk_f16(v0[2], v0[3]); w.z = cvt_pk_f16(v1[0], v1[1]); w.w = cvt_pk_f16(v1[2], v1[3]);
                    *(u32x4*)(part + off + bj * HALF) = w; }
                off += (size_t)16 * DM; }
            off += (size_t)64 * DM; }
    }
};

struct EpiWin {
    static constexpr bool PERM = true, AFTER_DRAIN = false;
    h16_t* UA; bf16_t* Q; h16_t* LFF; bf16_t* SGA; const float* lbt;
    static constexpr size_t QSTRIDE = (size_t)36 * 1048576 / 2, LFSTRIDE = (size_t)72 * 1048576 / 2, SGSTRIDE = (size_t)72 * 1048576 / 2;
    __device__ __forceinline__ void operator()(const f32x4 (&acc)[2][2][4][2], const Unit& u, int wr, int wc, int fr, int fq) const {
        const int pn = u.pn, row0 = u.pm * BM + wr * 64 + fr, cl = wc * 32 + 8 * fq;
        if (pn < 4) {
            size_t off = (size_t)row0 * 1024 + pn * BM + cl;
#pragma unroll
            for (int ai = 0; ai < 2; ++ai) {
#pragma unroll
                for (int m = 0; m < 4; ++m) { EPI_PIN(off);
#pragma unroll
                    for (int bj = 0; bj < 2; ++bj) { const f32x4 v0 = acc[ai][bj][m][0], v1 = acc[ai][bj][m][1];
                        u32x4 w; w.x = cvt_pk_f16(v0[0], v0[1]); w.y = cvt_pk_f16(v0[2], v0[3]); w.z = cvt_pk_f16(v1[0], v1[1]); w.w = cvt_pk_f16(v1[2], v1[3]);
                        *(u32x4*)(UA + off + bj * HALF) = w; }
                    off += (size_t)16 * 1024; }
                off += (size_t)64 * 1024; }
        } else if (pn < 12 || (pn >= 28 && pn < 44)) {
            const int sel = (pn < 12) ? 1 : ((pn >= 36) ? 2 : 0), cb = (pn - (sel == 1 ? 4 : (sel == 2 ? 36 : 28))) * BM;
            size_t off = (size_t)sel * QSTRIDE + (size_t)row0 * 2048 + cb + cl;
#pragma unroll
            for (int ai = 0; ai < 2; ++ai) {
#pragma unroll
                for (int m = 0; m < 4; ++m) { EPI_PIN(off);
#pragma unroll
                    for (int bj = 0; bj < 2; ++bj) { const f32x4 v0 = acc[ai][bj][m][0], v1 = acc[ai][bj][m][1];
                        u32x4 w; w.x = cvt_pk_bf16(v0[0], v0[1]); w.y = cvt_pk_bf16(v0[2], v0[3]); w.z = cvt_pk_bf16(v1[0], v1[1]); w.w = cvt_pk_bf16(v1[2], v1[3]);
                        *(u32x4*)(Q + off + bj * HALF) = w; }
                    off += (size_t)16 * 2048; }
                off += (size_t)64 * 2048; }
        } else if (pn < 28) {
            const int dirb = (pn >= 20) ? 1 : 0, cb = (pn - (dirb ? 20 : 12)) * BM;
            const float* lb = lbt + dirb * 2048 + cb + cl;
            f32x4 l[2][2];
#pragma unroll
            for (int bj = 0; bj < 2; ++bj)
#pragma unroll
                for (int n = 0; n < 2; ++n) l[bj][n] = *(const f32x4*)(lb + bj * HALF + 4 * n);
            size_t off = (size_t)dirb * LFSTRIDE + (size_t)row0 * 2048 + cb + cl;
#pragma unroll
            for (int ai = 0; ai < 2; ++ai) {
#pragma unroll
                for (int m = 0; m < 4; ++m) { EPI_PIN(off);
#pragma unroll
                    for (int bj = 0; bj < 2; ++bj) { f32x4 o[2];
#pragma unroll
                        for (int n = 0; n < 2; ++n) { f32x4 a = acc[ai][bj][m][n]; asm volatile("" : "+v"(a));
#pragma unroll
                            for (int j = 0; j < 4; ++j) { const float lbv = l[bj][n][j]; o[n][j] = __logf(lbv + (1.0f - lbv) * sigmoid_f(a[j])); } }
                        u32x4 w; w.x = cvt_pk_f16(o[0][0], o[0][1]); w.y = cvt_pk_f16(o[0][2], o[0][3]); w.z = cvt_pk_f16(o[1][0], o[1][1]); w.w = cvt_pk_f16(o[1][2], o[1][3]);
                        *(u32x4*)(LFF + off + bj * HALF) = w; }
                    off += (size_t)16 * 2048; }
                off += (size_t)64 * 2048; }
        } else {
            size_t off = (size_t)row0 * DM + (pn - 44) * HALF + cl;
#pragma unroll
            for (int ai = 0; ai < 2; ++ai) {
#pragma unroll
                for (int m = 0; m < 4; ++m) { EPI_PIN(off);
                    const f32x4 a0 = acc[ai][0][m][0], a1 = acc[ai][0][m][1], b0 = acc[ai][1][m][0], b1 = acc[ai][1][m][1];
                    u32x4 wa; wa.x = cvt_pk_bf16(sigmoid_f(a0[0]), sigmoid_f(a0[1])); wa.y = cvt_pk_bf16(sigmoid_f(a0[2]), sigmoid_f(a0[3]));
                    wa.z = cvt_pk_bf16(sigmoid_f(a1[0]), sigmoid_f(a1[1])); wa.w = cvt_pk_bf16(sigmoid_f(a1[2]), sigmoid_f(a1[3]));
                    *(u32x4*)(SGA + off) = wa;
#define GRATIO(bv, gw_) (sigmoid_f(bv) * __builtin_amdgcn_rcpf(fmaxf(gw_, 1e-20f)))
                    u32x4 wb; wb.x = cvt_pk_bf16(GRATIO(b0[0], bf_lo(wa.x)), GRATIO(b0[1], bf_hi(wa.x))); wb.y = cvt_pk_bf16(GRATIO(b0[2], bf_lo(wa.y)), GRATIO(b0[3], bf_hi(wa.y)));
                    wb.z = cvt_pk_bf16(GRATIO(b1[0], bf_lo(wa.z)), GRATIO(b1[1], bf_hi(wa.z))); wb.w = cvt_pk_bf16(GRATIO(b1[2], bf_lo(wa.w)), GRATIO(b1[3], bf_hi(wa.w)));
#undef GRATIO
                    *(u32x4*)(SGA + SGSTRIDE + off) = wb;
                    off += (size_t)16 * DM; }
                off += (size_t)64 * DM; }
        }
    }
};

struct EpiGlu {
    static constexpr bool PERM = true, AFTER_DRAIN = false;
    const bf16_t* GA; bf16_t* YA;
    __device__ __forceinline__ void operator()(const f32x4 (&acc)[2][2][4][2], const Unit& u, int wr, int wc, int fr, int fq) const {
        size_t off = (size_t)(u.pm * BM + wr * 64 + fr) * 1024 + u.pn * BM + wc * 32 + 8 * fq, offy = (size_t)(u.pm * BM + wr * 64 + fr) * DY + u.pn * BM + wc * 32 + 8 * fq;
#pragma unroll
        for (int ai = 0; ai < 2; ++ai) {
#pragma unroll
            for (int m = 0; m < 4; ++m) { EPI_PIN(off); EPI_PIN(offy);
#pragma unroll
                for (int bj = 0; bj < 2; ++bj) { const size_t o = off + bj * HALF;
                    const u32x4 gq = *(const u32x4*)(GA + o); const f32x4 v0 = acc[ai][bj][m][0], v1 = acc[ai][bj][m][1];
                    u32x4 w; w.x = cvt_pk_bf16(bf_lo(gq.x) * sigmoid_f(v0[0]), bf_hi(gq.x) * sigmoid_f(v0[1])); w.y = cvt_pk_bf16(bf_lo(gq.y) * sigmoid_f(v0[2]), bf_hi(gq.y) * sigmoid_f(v0[3]));
                    w.z = cvt_pk_bf16(bf_lo(gq.z) * sigmoid_f(v1[0]), bf_hi(gq.z) * sigmoid_f(v1[1])); w.w = cvt_pk_bf16(bf_lo(gq.w) * sigmoid_f(v1[2]), bf_hi(gq.w) * sigmoid_f(v1[3]));
                    *(u32x4*)(YA + offy + bj * HALF) = w; }
                off += (size_t)16 * 1024; offy += (size_t)16 * DY; }
            off += (size_t)64 * 1024; offy += (size_t)64 * DY; }
    }
};

struct EpiMerge {
    static constexpr bool PERM = true, AFTER_DRAIN = false; static constexpr int MID_T = 32;
    const bf16_t* SGA; const bf16_t* SGB; bf16_t* MRG;
    __device__ __forceinline__ void mid(f32x4 (&acc)[2][2][4][2], const Unit& u, int wr, int wc, int fr, int fq) const {
        size_t off = (size_t)(u.pm * BM + wr * 64 + fr) * DM + u.pn * BM + wc * 32 + 8 * fq;
#pragma unroll
        for (int ai = 0; ai < 2; ++ai) {
#pragma unroll
            for (int m = 0; m < 4; ++m) { EPI_PIN(off);
#pragma unroll
                for (int bj = 0; bj < 2; ++bj) { const size_t o = off + bj * HALF;
                    const u32x4 rq = *(const u32x4*)(SGB + o);
                    f32x4 r0, r1; r0[0] = bf_lo(rq.x); r0[1] = bf_hi(rq.x); r0[2] = bf_lo(rq.y); r0[3] = bf_hi(rq.y); r1[0] = bf_lo(rq.z); r1[1] = bf_hi(rq.z); r1[2] = bf_lo(rq.w); r1[3] = bf_hi(rq.w);
                    acc[ai][bj][m][0] *= r0; acc[ai][bj][m][1] *= r1; }
                off += (size_t)16 * DM; }
            off += (size_t)64 * DM; }
    }
    __device__ __forceinline__ void operator()(const f32x4 (&acc)[2][2][4][2], const Unit& u, int wr, int wc, int fr, int fq) const {
        size_t off = (size_t)(u.pm * BM + wr * 64 + fr) * DM + u.pn * BM + wc * 32 + 8 * fq;
#pragma unroll
        for (int ai = 0; ai < 2; ++ai) {
#pragma unroll
            for (int m = 0; m < 4; ++m) { EPI_PIN(off);
#pragma unroll
                for (int bj = 0; bj < 2; ++bj) { const size_t o = off + bj * HALF;
                    const u32x4 ga = *(const u32x4*)(SGA + o);
                    const f32x4 v0 = acc[ai][bj][m][0], v1 = acc[ai][bj][m][1];
                    u32x4 w; w.x = cvt_pk_bf16(fmaxf(bf_lo(ga.x), 1e-20f) * v0[0], fmaxf(bf_hi(ga.x), 1e-20f) * v0[1]); w.y = cvt_pk_bf16(fmaxf(bf_lo(ga.y), 1e-20f) * v0[2], fmaxf(bf_hi(ga.y), 1e-20f) * v0[3]);
                    w.z = cvt_pk_bf16(fmaxf(bf_lo(ga.z), 1e-20f) * v1[0], fmaxf(bf_hi(ga.z), 1e-20f) * v1[1]); w.w = cvt_pk_bf16(fmaxf(bf_lo(ga.w), 1e-20f) * v1[2], fmaxf(bf_hi(ga.w), 1e-20f) * v1[3]);
                    *(u32x4*)(MRG + o) = w; }
                off += (size_t)16 * DM; }
            off += (size_t)64 * DM; }
    }
};
template <class E, class = void> struct HasMid { static constexpr bool value = false; };
template <class E> struct HasMid<E, decltype((void)E::MID_T)> { static constexpr bool value = true; };

template <class Epi, class Sched, bool ALIGN_EPI = false, bool SP2 = false>
__device__ __forceinline__ void gemm_phase(PG8_LAS unsigned char* lds, const Gemm g, const Sched& S, const Epi& E) {
    int tid_ = threadIdx.x; asm volatile("" : "+v"(tid_));
    const int tid = tid_, wid = __builtin_amdgcn_readfirstlane(tid >> 6), lane = tid & 63, wr = wid >> 2, wc = wid & 3, fr = lane & 15, fq = lane >> 4;
    const int K = g.K, nt = K / BK, LD = g.LD ? g.LD : g.K;
    unsigned voffA[2], voffB[2];
#pragma unroll
    for (int i = 0; i < 2; ++i) { int R, C; stage_rc(tid * 16 + i * 8192, R, C); const int Rb = Epi::PERM ? ((R & ~31) + perm32(R & 31)) : R;
        voffA[i] = (unsigned)(R * LD + C) * 2u; voffB[i] = (unsigned)(Rb * LD + C) * 2u; }
    const size_t kstep = (size_t)(BK * 2);
    const size_t hstep = (size_t)HALF * LD * 2;
    const size_t tstep = 2 * hstep;
    const unsigned ldsw = (unsigned)wid * 1024u;
    const int aoff = lds_byte(wr * 64 + fr, fq * 8), boff = lds_byte(wc * 32 + fr, fq * 8);
#define PG8_SA(b, h) (((b) * 2 + (h)) * HTB)
#define PG8_SB(b, h) ((4 + (b) * 2 + (h)) * HTB)
#define PG8_STAGE(bufoff, gbase, voff) do { _Pragma("unroll") for (int _i = 0; _i < 2; ++_i) \
        __builtin_amdgcn_global_load_lds((const unsigned*)((const char*)(gbase) + (voff)[_i]), (PG8_LAS unsigned*)(lds + (bufoff) + ldsw + _i * 8192), 16, 0, 0); } while (0)
#define PG8_LDA(dst, b, h) do { _Pragma("unroll") for (int m = 0; m < 4; ++m) _Pragma("unroll") for (int k = 0; k < 2; ++k) dst[m][k] = *(const PG8_LAS bf16x8*)(lds + PG8_SA(b, h) + aoff + m * 2048 + k * 1024); } while (0)
#define PG8_LDB(dst, b, h) do { _Pragma("unroll") for (int n = 0; n < 2; ++n) _Pragma("unroll") for (int k = 0; k < 2; ++k) dst[n][k] = *(const PG8_LAS bf16x8*)(lds + PG8_SB(b, h) + boff + n * 2048 + k * 1024); } while (0)
#define PG8_MMA(ai, bj, At, Bt) do { __builtin_amdgcn_s_setprio(1); _Pragma("unroll") for (int m = 0; m < 4; ++m) _Pragma("unroll") for (int n = 0; n < 2; ++n) _Pragma("unroll") for (int k = 0; k < 2; ++k) \
        acc[ai][bj][m][n] = __builtin_amdgcn_mfma_f32_16x16x32_bf16(Bt[n][k], At[m][k], acc[ai][bj][m][n], 0, 0, 0); __builtin_amdgcn_s_setprio(0); } while (0)
#define PG8_WAIT_V(n) asm volatile("s_waitcnt vmcnt(" #n ")" ::: "memory")
#define PG8_WAIT_L(n) asm volatile("s_waitcnt lgkmcnt(" #n ")" ::: "memory")
#define PG8_BAR __builtin_amdgcn_s_barrier()
#define PG8_SCHED __builtin_amdgcn_sched_barrier(0)
    Unit cur, nxt; int ui = 0;
    if (!S.next(0, cur)) return;
    f32x4 acc[2][2][4][2];
#pragma unroll
    for (int a = 0; a < 2; ++a)
#pragma unroll
        for (int b = 0; b < 2; ++b)
#pragma unroll
            for (int m = 0; m < 4; ++m)
#pragma unroll
                for (int n = 0; n < 2; ++n) acc[a][b][m][n] = (f32x4){0.f, 0.f, 0.f, 0.f};
    bf16x8 At[4][2], B0[2][2], B1[2][2];
    const char* cA = (const char*)g.A + (size_t)cur.pm * tstep; const char* cB;
    if constexpr (Sched::SPLITK) { cA += (size_t)Sched::kt0(cur) * kstep; cB = (const char*)g.Bt + (size_t)(cur.pn & 255) * tstep + (size_t)Sched::kt0(cur) * kstep; } else cB = (const char*)g.Bt + (size_t)cur.pn * tstep;
    S.a_ready(cur);
    if constexpr (SP2) {
        PG8_STAGE(PG8_SB(0, 0), cB, voffB); PG8_STAGE(PG8_SB(0, 1), cB + hstep, voffB); PG8_STAGE(PG8_SA(0, 0), cA, voffA); PG8_STAGE(PG8_SA(0, 1), cA + hstep, voffA);
        if (wr == 1) PG8_BAR;
        PG8_WAIT_V(2); PG8_BAR;
        PG8_STAGE(PG8_SB(1, 0), cB + kstep, voffB); PG8_STAGE(PG8_SA(1, 0), cA + kstep, voffA); PG8_STAGE(PG8_SB(1, 1), cB + hstep + kstep, voffB);
        PG8_WAIT_V(6); PG8_BAR;
    } else {
        PG8_STAGE(PG8_SB(0, 0), cB, voffB); PG8_STAGE(PG8_SA(0, 0), cA, voffA); PG8_STAGE(PG8_SB(0, 1), cB + hstep, voffB); PG8_STAGE(PG8_SA(0, 1), cA + hstep, voffA);
        if (wr == 1) PG8_BAR;
        PG8_WAIT_V(4); PG8_BAR;
        PG8_STAGE(PG8_SB(1, 0), cB + kstep, voffB); PG8_STAGE(PG8_SA(1, 0), cA + kstep, voffA); PG8_STAGE(PG8_SB(1, 1), cB + hstep + kstep, voffB);
        PG8_WAIT_V(6); PG8_BAR;
    }
    for (;;) {
        const bool has_next = S.next(ui + 1, nxt);
        const char* nA = cA; const char* nB = cB; int cnt = nt;
        if constexpr (Sched::SPLITK) { if (has_next) { nA = (const char*)g.A + (size_t)nxt.pm * tstep + (size_t)Sched::kt0(nxt) * kstep; nB = (const char*)g.Bt + (size_t)(nxt.pn & 255) * tstep + (size_t)Sched::kt0(nxt) * kstep; } cnt = Sched::cnt(cur, nt); }
        else { if (has_next) { nA = (const char*)g.A + (size_t)nxt.pm * tstep; nB = (const char*)g.Bt + (size_t)nxt.pn * tstep; } }
        for (int t = 0; t < cnt; t += 2) {
            if constexpr (HasMid<Epi>::value) { if (t == Epi::MID_T) E.mid(acc, cur, wr, wc, fr, fq); }
            const bool last = (t == cnt - 2);
            const char* a1 = cA + (size_t)(t + 1) * kstep;
            const char* a2 = last ? nA : cA + (size_t)(t + 2) * kstep; const char* b2 = last ? nB : cB + (size_t)(t + 2) * kstep;
            const char* a3 = a2 + kstep; const char* b3 = b2 + kstep;
            if (last && has_next) S.a_ready(nxt);
            if constexpr (SP2) {
            PG8_LDB(B0, 0, 0); PG8_LDB(B1, 0, 1); PG8_SCHED; PG8_LDA(At, 0, 0); PG8_STAGE(PG8_SA(1, 1), a1 + hstep, voffA);
            PG8_WAIT_V(8); PG8_WAIT_L(0); PG8_BAR; PG8_MMA(0, 0, At, B0); PG8_MMA(0, 1, At, B1); PG8_BAR; PG8_SCHED;
            PG8_LDA(At, 0, 1); PG8_STAGE(PG8_SB(0, 0), b2, voffB); PG8_STAGE(PG8_SB(0, 1), b2 + hstep, voffB); PG8_STAGE(PG8_SA(0, 0), a2, voffA);
            PG8_WAIT_V(8); PG8_WAIT_L(0); PG8_BAR; PG8_MMA(1, 0, At, B0); PG8_MMA(1, 1, At, B1); PG8_BAR; PG8_SCHED;
            PG8_LDB(B0, 1, 0); PG8_LDB(B1, 1, 1); PG8_SCHED; PG8_LDA(At, 1, 0); PG8_STAGE(PG8_SA(0, 1), a2 + hstep, voffA);
            PG8_WAIT_V(8); PG8_WAIT_L(0); PG8_BAR; PG8_MMA(0, 0, At, B0); PG8_MMA(0, 1, At, B1); PG8_BAR; PG8_SCHED;
            PG8_LDA(At, 1, 1); PG8_STAGE(PG8_SB(1, 0), b3, voffB); PG8_STAGE(PG8_SB(1, 1), b3 + hstep, voffB); PG8_STAGE(PG8_SA(1, 0), a3, voffA);
            PG8_WAIT_V(8); PG8_WAIT_L(0); PG8_BAR; PG8_MMA(1, 0, At, B0); PG8_MMA(1, 1, At, B1); PG8_BAR; PG8_SCHED;
            } else {
            PG8_LDB(B0, 0, 0); PG8_SCHED; PG8_LDA(At, 0, 0); PG8_STAGE(PG8_SA(1, 1), a1 + hstep, voffA);
            PG8_WAIT_L(8); PG8_BAR; PG8_WAIT_L(0); PG8_MMA(0, 0, At, B0); PG8_BAR; PG8_SCHED;
            PG8_LDB(B1, 0, 1); PG8_STAGE(PG8_SB(0, 0), b2, voffB);
            PG8_BAR; PG8_WAIT_L(0); PG8_MMA(0, 1, At, B1); PG8_BAR;
            PG8_LDA(At, 0, 1); PG8_STAGE(PG8_SA(0, 0), a2, voffA);
            PG8_BAR; PG8_WAIT_L(0); PG8_MMA(1, 0, At, B0); PG8_BAR; PG8_SCHED;
            PG8_STAGE(PG8_SB(0, 1), b2 + hstep, voffB);
            PG8_WAIT_V(6); PG8_BAR; PG8_MMA(1, 1, At, B1); PG8_BAR;
            PG8_LDB(B0, 1, 0); PG8_SCHED; PG8_LDA(At, 1, 0); PG8_STAGE(PG8_SA(0, 1), a2 + hstep, voffA);
            PG8_WAIT_L(8); PG8_BAR; PG8_WAIT_L(0); PG8_MMA(0, 0, At, B0); PG8_BAR; PG8_SCHED;
            PG8_LDB(B1, 1, 1); PG8_STAGE(PG8_SB(1, 0), b3, voffB);
            PG8_BAR; PG8_WAIT_L(0); PG8_MMA(0, 1, At, B1); PG8_BAR;
            PG8_LDA(At, 1, 1); PG8_STAGE(PG8_SA(1, 0), a3, voffA);
            PG8_BAR; PG8_WAIT_L(0); PG8_MMA(1, 0, At, B0); PG8_BAR; PG8_SCHED;
            PG8_STAGE(PG8_SB(1, 1), b3 + hstep, voffB);
            PG8_WAIT_V(6); PG8_BAR; PG8_MMA(1, 1, At, B1); PG8_BAR;
            }
        }
        if constexpr (ALIGN_EPI) { if (wr == 0) PG8_BAR; }
        if constexpr (!Epi::AFTER_DRAIN) { E(acc, cur, wr, wc, fr, fq); S.done(cur); }
        if (!has_next) break;
#pragma unroll
        for (int a = 0; a < 2; ++a)
#pragma unroll
            for (int b = 0; b < 2; ++b)
#pragma unroll
                for (int m = 0; m < 4; ++m)
#pragma unroll
                    for (int n = 0; n < 2; ++n) acc[a][b][m][n] = (f32x4){0.f, 0.f, 0.f, 0.f};
        cur = nxt; cA = nA; cB = nB; ++ui;
        if constexpr (ALIGN_EPI) { if (wr == 1) PG8_BAR; }
    }
    PG8_WAIT_V(0);
    if constexpr (!ALIGN_EPI) { if (wr == 0) PG8_BAR; }
    PG8_BAR;
    if constexpr (Epi::AFTER_DRAIN) { E.fused(acc, cur, wr, wc, fr, fq, lds, wid, lane); S.done(cur); }
#undef PG8_SA
#undef PG8_SB
#undef PG8_STAGE
#undef PG8_LDA
#undef PG8_LDB
#undef PG8_MMA
#undef PG8_WAIT_V
#undef PG8_WAIT_L
#undef PG8_BAR
#undef PG8_SCHED
}
}


constexpr int NWAVES = 8;
constexpr int D_MODEL = 4096, BATCH = 4, SEQ = 2048, CTX_LEN = 256, D_FF = 11008, D_A = 1024, D_B = 2048, N_IN = 19456, N_MOD = 9;
constexpr int D_FFP = D_FF + 64;
constexpr int RT = 9216;
constexpr int RPB = 2304;
constexpr int S5_G = 64, S5_P = 64, S5_H = 16, NCHUNK = 36;
constexpr float EPS = 1e-6f;
constexpr int ADA_KS = 8, NMODC_ = 36864;

constexpr size_t MiB = 1u << 20;
constexpr size_t WS_CTL = 0, CTL_ZERO_BYTES = 1 * MiB;
constexpr size_t WS_MODP = 2 * MiB;
constexpr size_t WS_MOD = 14 * MiB;
constexpr size_t WS_TAB = 15 * MiB;
constexpr size_t WS_Y = 188 * MiB  , WS_WP = 656 * MiB  ;
constexpr size_t WS_W13A = 16 * MiB, WS_W2A = 814 * MiB, WS_WIN = 274 * MiB, WS_WGLU = 426 * MiB, WS_WPA = 428 * MiB, WS_WPB = 436 * MiB, WS_WOUT = 452 * MiB, WS_W13B = 484 * MiB, WS_W2B = 901 * MiB;
constexpr size_t WS_ZN = 742 * MiB, WS_HID = 2026 * MiB, WS_H = 1008 * MiB, WS_UA = 1152 * MiB, WS_Q = 1188 * MiB, WS_V = 1224 * MiB, WS_OG = 1260 * MiB, WS_LFF = 1296 * MiB, WS_LFB = 1368 * MiB;
constexpr size_t WS_SGA = 1440 * MiB, WS_SGB = 1512 * MiB, WS_XEND = 1584 * MiB, WS_GA = 1594 * MiB, WS_YA = 1612 * MiB, WS_OHG = 1630 * MiB, WS_YB = 1774 * MiB, WS_PT = 1810 * MiB, WS_MRG = 1954 * MiB, WS_END = 2221 * MiB;
static_assert(WS_W13A + (size_t)2 * D_FF * D_MODEL * 2 <= WS_WIN && WS_W2A + (size_t)D_MODEL * D_FFP * 2 <= WS_W2B && WS_W2B + (size_t)D_MODEL * D_FFP * 2 <= WS_H && WS_WIN + (size_t)N_IN * D_MODEL * 2 <= WS_WGLU, "ws map 1");
static_assert(WS_W13B + (size_t)2 * D_FF * D_MODEL * 2 <= WS_ZN && WS_ZN + (size_t)RT * D_MODEL * 2 <= WS_W2A && WS_MRG + (size_t)RT * D_MODEL * 2 <= WS_HID && WS_HID + (size_t)RT * D_FFP * 2 <= WS_END, "ws map 2");
static_assert(WS_H + (size_t)RT * D_MODEL * 4 <= WS_UA && WS_UA + (size_t)RT * D_A * 4 <= WS_Q && WS_Q + (size_t)RT * D_B * 2 <= WS_V && WS_LFF + (size_t)RT * D_B * 4 <= WS_LFB && WS_SGA + (size_t)RT * D_MODEL * 2 <= WS_SGB, "ws map 3");
static_assert(WS_XEND + (size_t)BATCH * 2 * S5_G * NCHUNK * S5_P * 8 <= WS_GA && WS_OHG + (size_t)2 * RT * D_B * 4 <= WS_YB && WS_PT + (size_t)RT * D_MODEL * 4 <= WS_MRG && WS_MRG + (size_t)RT * D_MODEL * 2 <= WS_END, "ws map 4");
static_assert(WS_MODP + (size_t)ADA_KS * 5 * 36864 * 4 <= WS_MOD, "ws map 5");
constexpr int CW_BAR = 4096;
constexpr int CW_QUEUE = 8192, CW_DONE = 8192 + 64, CW_QUEUE2 = 8192 + 128, CW_QUEUE3 = 8192 + 192;

constexpr int RING_OFF = 0, RING_BYTES = 131072;
constexpr int LDSCTL_OFF = RING_BYTES, MISC_OFF = LDSCTL_OFF + 320;
constexpr int LDS_BYTES = 147456;
static_assert(MISC_OFF + 128 <= LDS_BYTES, "LDS map");

#define GAS __attribute__((address_space(1)))
#define LAS __attribute__((address_space(3)))
typedef unsigned short bf16;
typedef unsigned v4u __attribute__((ext_vector_type(4)));
typedef unsigned v2u __attribute__((ext_vector_type(2)));
typedef float f32x4 __attribute__((ext_vector_type(4)));
typedef float f32x2 __attribute__((ext_vector_type(2)));
typedef short bf16x8 __attribute__((ext_vector_type(8)));
typedef GAS unsigned gu32;
#define RLX_AGENT __ATOMIC_RELAXED, __HIP_MEMORY_SCOPE_AGENT
#define LDS_WAIT() asm volatile("s_waitcnt lgkmcnt(0)" ::: "memory")
#define VM_WAIT() asm volatile("s_waitcnt vmcnt(0)" ::: "memory")
using pg8::cvt_pk_bf16; using pg8::bf_lo; using pg8::bf_hi; using pg8::sigmoid_f; using pg8::silu_f;
__device__ __forceinline__ float wave_sum(float v) {
#pragma unroll
    for (int o = 1; o < 64; o <<= 1) v += __shfl_xor(v, o);
    return v;
}

#define XB_TMO      128
#define XB_XCNT(j)  (256  + 64 * (j))
#define XB_XSUB(j)  (1280 + 64 * (j))
#define XB_XGEN(j)  (2304 + 64 * (j))
#define XB_TOP      3328
#define XB_TOPGEN   3392
#define XCD_BAR_WORDS 3456
#define XB_SPIN_CAP (1u << 18)

__device__ __forceinline__ unsigned xb_ld(unsigned* p)              { return __hip_atomic_load(p, __ATOMIC_RELAXED, __HIP_MEMORY_SCOPE_AGENT); }
__device__ __forceinline__ unsigned xb_add(unsigned* p, unsigned v) { return __hip_atomic_fetch_add(p, v, __ATOMIC_RELAXED, __HIP_MEMORY_SCOPE_AGENT); }
__device__ __forceinline__ unsigned xb_xcc_id() { return (unsigned)__builtin_amdgcn_s_getreg((3 << 11) | 20) & 0xFu; }
#define XB_SPIN(cond, bar) do { unsigned _sp = 0; while (cond) { __builtin_amdgcn_s_sleep(1); \
    if ((++_sp & 255u) == 0u) { if (xb_ld(&(bar)[XB_TMO])) break; if (_sp > XB_SPIN_CAP) { atomicAdd(&(bar)[XB_TMO], 1u); break; } } } } while (0)

struct XcdBarrier {
    unsigned* bar; unsigned x;
    volatile LAS unsigned* st;
};

__device__ __forceinline__ XcdBarrier xcd_barrier_post(unsigned* bar, volatile LAS unsigned* st) {
    XcdBarrier b; b.bar = bar; b.x = xb_xcc_id(); b.st = st;
    if (threadIdx.x == 0) (void)xb_add(&bar[XB_XCNT(b.x)], 1u);
    return b;
}
__device__ __forceinline__ void xcd_barrier_complete(unsigned* bar, unsigned x, unsigned& nloc, unsigned& nx) {
    const unsigned G = gridDim.x * gridDim.y * gridDim.z;
    unsigned sum, cnt, mine, sp = 0u;
    for (;;) {
        sum = 0u; cnt = 0u; mine = 0u;
#pragma unroll
        for (unsigned j = 0; j < 16; ++j) { const unsigned c = xb_ld(&bar[XB_XCNT(j)]); sum += c; cnt += (c > 0u) ? 1u : 0u; mine = (j == x) ? c : mine; }
        if (sum == G) break;
        __builtin_amdgcn_s_sleep(1);
        if ((++sp & 255u) == 0u) { if (xb_ld(&bar[XB_TMO])) break; if (sp > XB_SPIN_CAP) { atomicAdd(&bar[XB_TMO], 1u); break; } }
    }
    nloc = mine > 0u ? mine : 1u; nx = cnt > 0u ? cnt : 1u;
}

__device__ __forceinline__ void xcd_barrier(const XcdBarrier& b) {
    asm volatile("s_waitcnt vmcnt(0)" ::: "memory");
    __syncthreads();
    if (threadIdx.x == 0) {
        unsigned* bar = b.bar;
        __builtin_amdgcn_s_waitcnt(0);
        unsigned nloc = b.st[0], nx = b.st[1];
        if (nloc == 0u) { xcd_barrier_complete(bar, b.x, nloc, nx); b.st[0] = nloc; b.st[1] = nx; }
        const unsigned old = xb_add(&bar[XB_XSUB(b.x)], 1u);
        const unsigned gen = old / nloc;
        if (old + 1u == (gen + 1u) * nloc) {
            __builtin_amdgcn_fence(__ATOMIC_RELEASE, "agent");
            asm volatile("s_waitcnt vmcnt(0)" ::: "memory");
            const unsigned og = xb_add(&bar[XB_TOP], 1u);
            const unsigned tg = og / nx;
            if (og + 1u == (tg + 1u) * nx) xb_add(&bar[XB_TOPGEN], 1u);
            else XB_SPIN(xb_ld(&bar[XB_TOPGEN]) == tg, bar);
            __builtin_amdgcn_fence(__ATOMIC_ACQUIRE, "agent");
            xb_add(&bar[XB_XGEN(b.x)], 1u);
            asm volatile("s_waitcnt vmcnt(0)" ::: "memory");
        } else {
            XB_SPIN(xb_ld(&bar[XB_XGEN(b.x)]) == gen, bar);
            __builtin_amdgcn_fence(__ATOMIC_ACQUIRE, "agent");
            asm volatile("s_waitcnt vmcnt(0)" ::: "memory");
        }
    }
    __syncthreads();
}


struct Args { const float* in[31]; float* out; unsigned char* ws; };
enum { I_X = 0, I_C, I_CTX, I_CCTX, I_WADA, I_BADA, I_NORM1, I_W1A, I_W3A, I_W2A, I_NORMMIX, I_WIN, I_LAMRE, I_LAMIM, I_LOGDT, I_BRE, I_BIM, I_CRE, I_CIM, I_S5D, I_WGLU,
       I_LBLOG, I_HGNORM, I_WPA, I_WPB, I_WOUT, I_NORM2, I_W1B, I_W3B, I_W2B, I_NORMF };

struct ItemDesc { const float* src; bf16* dst; int N, K; };
__device__ __forceinline__ ItemDesc make_item(const float* W, int K, int N, bf16* WT, int kind, int item, int ld = 0) {
    if (ld) K = ld;
    const int nblk = N / 32, kb = item / nblk, nb = item - kb * nblk, k0 = 64 * kb, n0 = 32 * nb;
    int drow = (kind == 0) ? n0 : ((n0 >> 7) * 256 + (n0 & 127) + (kind == 2 ? 128 : 0));
    if (kind == 3) { const int st = n0 >> 8; const int dt = (st < 4) ? st : (st < 12) ? st + 24 : (st < 36) ? st - 8 : st;
        drow = dt * 256 + (n0 & 255);
        if (st >= 44) { const int isb = (st >= 60) ? 1 : 0, c = (st - 44 - 16 * isb) * 256 + (n0 & 255); drow = (44 + (c >> 7)) * 256 + (c & 127) + 128 * isb; } }
    ItemDesc d; d.src = W + (size_t)k0 * N + n0; d.dst = WT + (size_t)drow * K + k0; d.N = N; d.K = K; return d;
}
__device__ __forceinline__ void item_load(const ItemDesc& d, f32x4 (&v)[8], int lane) {
    const float* p = d.src + (size_t)(lane >> 3) * d.N + 4 * (lane & 7);
#pragma unroll
    for (int i = 0; i < 8; ++i) v[i] = __builtin_nontemporal_load((const GAS f32x4*)(p + (size_t)(8 * i) * d.N));
}
__device__ __forceinline__ void item_store(const ItemDesc& d, const f32x4 (&v)[8], LAS float* scr, int lane) {
#pragma unroll
    for (int i = 0; i < 8; ++i) { LAS float* s = scr + (8 * i + (lane >> 3)) * 33 + 4 * (lane & 7); s[0] = v[i].x; s[1] = v[i].y; s[2] = v[i].z; s[3] = v[i].w; }
    LDS_WAIT(); asm volatile("" ::: "memory");
    const int c = lane & 7;
#pragma unroll
    for (int j = 0; j < 4; ++j) { const int n = (lane >> 3) + 8 * j; const LAS float* s = scr + (8 * c) * 33 + n;
        v4u o; o.x = cvt_pk_bf16(s[0 * 33], s[1 * 33]); o.y = cvt_pk_bf16(s[2 * 33], s[3 * 33]); o.z = cvt_pk_bf16(s[4 * 33], s[5 * 33]); o.w = cvt_pk_bf16(s[6 * 33], s[7 * 33]);
        __builtin_nontemporal_store(o, (GAS v4u*)(d.dst + (size_t)n * d.K + 8 * c)); }
    LDS_WAIT(); asm volatile("" ::: "memory");
}
constexpr int IT_FF = (D_MODEL / 64) * (D_FF / 32), IT_WIN = (D_MODEL / 64) * (N_IN / 32), IT_GLU = (D_A / 64) * (D_A / 32), IT_PA = (D_A / 64) * (D_MODEL / 32), IT_PB = (D_B / 64) * (D_MODEL / 32), IT_OUT = (D_MODEL / 64) * (D_MODEL / 32);
constexpr int T_ITEMS = 6 * IT_FF + IT_WIN + IT_GLU + IT_PA + IT_PB + IT_OUT;
constexpr int ADA_TASKS = 144 * ADA_KS, ADA_KLEN = D_MODEL / ADA_KS;

__device__ __forceinline__ void p0_ada_task(const float* cvec, const float* cctx, const float* wada, float* modp, int task, LAS float* scr, int lane) {
    const int cg = task % 144, ks = task / 144, k0 = ks * ADA_KLEN, n0 = cg * 256 + lane * 4;
#pragma unroll
    for (int i = 0; i < 5; ++i)
        for (int kk = lane; kk < ADA_KLEN; kk += 64) { const float v = (i < 4) ? cvec[i * D_MODEL + k0 + kk] : cctx[k0 + kk]; scr[kk * 8 + i] = silu_f(v); }
    LDS_WAIT(); asm volatile("" ::: "memory");
    f32x4 a0 = {0.f, 0.f, 0.f, 0.f}, a1 = a0, a2 = a0, a3 = a0, a4 = a0;
    const float* wp = wada + (size_t)k0 * NMODC_ + n0;
#pragma unroll 32
    for (int k = 0; k < ADA_KLEN; ++k) {
        const f32x4 w = __builtin_nontemporal_load((const GAS f32x4*)(wp + (size_t)k * NMODC_));
        const f32x4 s = *(const LAS f32x4*)(scr + k * 8); const float s4 = scr[k * 8 + 4];
        a0 += w * s[0]; a1 += w * s[1]; a2 += w * s[2]; a3 += w * s[3]; a4 += w * s4;
    }
    float* o = modp + (size_t)ks * 5 * NMODC_ + n0;
    *(f32x4*)(o) = a0; *(f32x4*)(o + NMODC_) = a1; *(f32x4*)(o + 2 * NMODC_) = a2; *(f32x4*)(o + 3 * NMODC_) = a3; *(f32x4*)(o + 4 * NMODC_) = a4;
    LDS_WAIT(); asm volatile("" ::: "memory");
}

__device__ __forceinline__ void norm_mod_row(const float* src, const float* gain, const float* shift, const float* scale, bf16* dst, int lane) {
    const GAS f32x4* xr = (const GAS f32x4*)src + lane;
    f32x4 v[16]; float s = 0.f;
#pragma unroll
    for (int j = 0; j < 16; ++j) { v[j] = xr[64 * j]; s += (v[j].x * v[j].x + v[j].y * v[j].y) + (v[j].z * v[j].z + v[j].w * v[j].w); }
    const float rstd = 1.0f / sqrtf(wave_sum(s) * (1.f / D_MODEL) + EPS);
    const GAS f32x4* gp = (const GAS f32x4*)gain + lane; const GAS f32x4* hp = (const GAS f32x4*)shift + lane; const GAS f32x4* cp = (const GAS f32x4*)scale + lane;
    GAS v2u* o8 = (GAS v2u*)dst + lane;
#pragma unroll
    for (int j = 0; j < 16; ++j) { const f32x4 g = gp[64 * j], sh = hp[64 * j], sc = cp[64 * j]; const f32x4 y = (v[j] * rstd * g) * (sc + 1.0f) + sh;
        v2u w; w.x = cvt_pk_bf16(y.x, y.y); w.y = cvt_pk_bf16(y.z, y.w); o8[64 * j] = w; }
}
__device__ __forceinline__ void norm_mod_row_h(const pg8::h16_t* src, const float* gain, const float* shift, const float* scale, bf16* dst, int lane) {
    const GAS v2u* xr = (const GAS v2u*)src + lane;
    f32x4 v[16]; float s = 0.f;
#pragma unroll
    for (int j = 0; j < 16; ++j) { const v2u w = xr[64 * j]; const f32x2 a = pg8::unpk_f16(w.x), c = pg8::unpk_f16(w.y); v[j] = (f32x4){a.x, a.y, c.x, c.y};
        s += (v[j].x * v[j].x + v[j].y * v[j].y) + (v[j].z * v[j].z + v[j].w * v[j].w); }
    const float rstd = 1.0f / sqrtf(wave_sum(s) * (1.f / D_MODEL) + EPS);
    const GAS f32x4* gp = (const GAS f32x4*)gain + lane; const GAS f32x4* hp = (const GAS f32x4*)shift + lane; const GAS f32x4* cp = (const GAS f32x4*)scale + lane;
    GAS v2u* o8 = (GAS v2u*)dst + lane;
#pragma unroll
    for (int j = 0; j < 16; ++j) { const f32x4 g = gp[64 * j], sh = hp[64 * j], sc = cp[64 * j]; const f32x4 y = (v[j] * rstd * g) * (sc + 1.0f) + sh;
        v2u w; w.x = cvt_pk_bf16(y.x, y.y); w.y = cvt_pk_bf16(y.z, y.w); o8[64 * j] = w; }
}
__device__ __forceinline__ void norm_mod_row_part(const float* base, const pg8::h16_t* part, const float* m2, const float* gain, const float* shift, const float* scale, bf16* dst, int lane) {
    const GAS f32x4* xr = (const GAS f32x4*)base + lane; const GAS v2u* pr = (const GAS v2u*)part + lane; const GAS f32x4* mr = (const GAS f32x4*)m2 + lane;
    constexpr size_t QS = (size_t)BATCH * CTX_LEN * D_MODEL / 4;
    f32x4 v[16]; float s = 0.f;
#pragma unroll
    for (int j = 0; j < 16; ++j) { f32x4 p = (f32x4){0.f, 0.f, 0.f, 0.f};
#pragma unroll
        for (int k = 0; k < 4; ++k) { const v2u w = pr[k * QS + 64 * j]; const f32x2 a = pg8::unpk_f16(w.x), c = pg8::unpk_f16(w.y); p += (f32x4){a.x, a.y, c.x, c.y}; }
        v[j] = xr[64 * j] + (mr[64 * j] * 0.5f) * p; s += (v[j].x * v[j].x + v[j].y * v[j].y) + (v[j].z * v[j].z + v[j].w * v[j].w);
        if ((j & 3) == 3) asm volatile("" ::: "memory"); }
    const float rstd = 1.0f / sqrtf(wave_sum(s) * (1.f / D_MODEL) + EPS);
    const GAS f32x4* gp = (const GAS f32x4*)gain + lane; const GAS f32x4* hp = (const GAS f32x4*)shift + lane; const GAS f32x4* cp = (const GAS f32x4*)scale + lane;
    GAS v2u* o8 = (GAS v2u*)dst + lane;
#pragma unroll
    for (int j = 0; j < 16; ++j) { const f32x4 g = gp[64 * j], sh = hp[64 * j], sc = cp[64 * j]; const f32x4 y = (v[j] * rstd * g) * (sc + 1.0f) + sh;
        v2u w; w.x = cvt_pk_bf16(y.x, y.y); w.y = cvt_pk_bf16(y.z, y.w); o8[64 * j] = w; }
}
__device__ __forceinline__ void norm_final_row_h(const pg8::h16_t* src, float* dst, const float* gain, int lane) {
    const GAS v2u* xr = (const GAS v2u*)src + lane; GAS f32x4* o = (GAS f32x4*)dst + lane;
    f32x4 v[16]; float s = 0.f;
#pragma unroll
    for (int j = 0; j < 16; ++j) { const v2u w = xr[64 * j]; const f32x2 a = pg8::unpk_f16(w.x), c = pg8::unpk_f16(w.y); v[j] = (f32x4){a.x, a.y, c.x, c.y};
        s += (v[j].x * v[j].x + v[j].y * v[j].y) + (v[j].z * v[j].z + v[j].w * v[j].w); }
    const float rstd = 1.0f / sqrtf(wave_sum(s) * (1.f / D_MODEL) + EPS);
    const GAS f32x4* gp = (const GAS f32x4*)gain + lane;
#pragma unroll
    for (int j = 0; j < 16; ++j) o[64 * j] = v[j] * rstd * gp[64 * j];
}
__device__ __forceinline__ void norm_final_row(float* io, const float* gain, int lane) {
    GAS f32x4* xr = (GAS f32x4*)io + lane;
    f32x4 v[16]; float s = 0.f;
#pragma unroll
    for (int j = 0; j < 16; ++j) { v[j] = xr[64 * j]; s += (v[j].x * v[j].x + v[j].y * v[j].y) + (v[j].z * v[j].z + v[j].w * v[j].w); }
    const float rstd = 1.0f / sqrtf(wave_sum(s) * (1.f / D_MODEL) + EPS);
    const GAS f32x4* gp = (const GAS f32x4*)gain + lane;
#pragma unroll
    for (int j = 0; j < 16; ++j) xr[64 * j] = v[j] * rstd * gp[64 * j];
}

__device__ __forceinline__ void s5_table_entry(const float* lam_re, const float* lam_im, const float* log_dt, float* TAB, int idx) {
    const int dg = idx >> 6;
    const double dt = exp((double)log_dt[dg]);
    const double lr = (double)lam_re[idx], li = (double)lam_im[idx];
    const double mag = exp(lr * dt), th = li * dt;
    const double TWO_PI = 6.283185307179586476925286766559;
    const double rr = th - TWO_PI * rint(th * (1.0 / TWO_PI));
    const double abr = mag * cos(rr), abi = mag * sin(rr);
    const double den = lr * lr + li * li, nr = abr - 1.0;
    const double kr = (nr * lr + abi * li) / den, ki = (abi * lr - nr * li) / den;
    double pr = abr, pi = abi;
#pragma unroll
    for (int i = 0; i < 6; ++i) { const double tr = pr * pr - pi * pi, ti = 2.0 * pr * pi; pr = tr; pi = ti; }
    float* o = TAB + (size_t)idx * 8;
    o[0] = (float)abr; o[1] = (float)abi; o[2] = (float)kr; o[3] = (float)ki; o[4] = (float)pr; o[5] = (float)pi; o[6] = 0.f; o[7] = 0.f;
}
#define S5_LOAD_BK(d_, g_, p_) \
    float ar, ai, a64r, a64i; f32x2 bk2[16]; \
    { const f32x4 t0 = *(const f32x4*)(TAB + ((size_t)(((d_) * 64 + (g_)) * 64 + (p_))) * 8), t1 = *(const f32x4*)(TAB + ((size_t)(((d_) * 64 + (g_)) * 64 + (p_))) * 8 + 4); \
      ar = t0[0]; ai = t0[1]; a64r = t1[0]; a64i = t1[1]; const float kr = t0[2], ki = t0[3]; \
      const f32x4* br = (const f32x4*)(b_re + ((size_t)((g_) * 64 + (p_))) * 16); const f32x4* bi = (const f32x4*)(b_im + ((size_t)((g_) * 64 + (p_))) * 16); \
      _Pragma("unroll") for (int q = 0; q < 4; ++q) { const f32x4 x = br[q], y = bi[q]; \
          _Pragma("unroll") for (int j = 0; j < 4; ++j) { bk2[4 * q + j] = (f32x2){kr * x[j] - ki * y[j], kr * y[j] + ki * x[j]}; } } }
#define S5_STEP(tl_) { const f32x4 u0 = UL[(tl_) * 4 + 0], u1 = UL[(tl_) * 4 + 1], u2 = UL[(tl_) * 4 + 2], u3 = UL[(tl_) * 4 + 3]; \
        f32x2 e0 = bk2[0] * u0[0], e1 = bk2[1] * u0[1]; \
        e0 += bk2[2] * u0[2]; e1 += bk2[3] * u0[3]; e0 += bk2[4] * u1[0]; e1 += bk2[5] * u1[1]; e0 += bk2[6] * u1[2]; e1 += bk2[7] * u1[3]; \
        e0 += bk2[8] * u2[0]; e1 += bk2[9] * u2[1]; e0 += bk2[10] * u2[2]; e1 += bk2[11] * u2[3]; e0 += bk2[12] * u3[0]; e1 += bk2[13] * u3[1]; e0 += bk2[14] * u3[2]; e1 += bk2[15] * u3[3]; \
        e0 += e1; \
        const float nr_ = ar * xr - ai * xi + e0.x, ni_ = ar * xi + ai * xr + e0.y; xr = nr_; xi = ni_; }

typedef float f32x16 __attribute__((ext_vector_type(16)));
__device__ __forceinline__ void s5_make_ef(bf16x8 (&Ef)[4], const float* TAB, const float* b_re, const float* b_im, int d, int g, int lane) {
    const int half = lane >> 5, l31 = lane & 31;
#pragma unroll
    for (int s2 = 0; s2 < 2; ++s2) { const int ps = 32 * s2 + l31;
        const f32x4 tt = *(const f32x4*)(TAB + ((size_t)((d * 64 + g) * 64 + ps)) * 8); const float kr = tt[2], ki = tt[3];
        const float* brp = b_re + ((size_t)(g * 64 + ps)) * 16 + 8 * half; const float* bip = b_im + ((size_t)(g * 64 + ps)) * 16 + 8 * half;
        const f32x4 r0 = *(const f32x4*)brp, r1 = *(const f32x4*)(brp + 4), i0 = *(const f32x4*)bip, i1 = *(const f32x4*)(bip + 4);
        v4u wr_, wi_;
        wr_.x = cvt_pk_bf16(kr * r0[0] - ki * i0[0], kr * r0[1] - ki * i0[1]); wr_.y = cvt_pk_bf16(kr * r0[2] - ki * i0[2], kr * r0[3] - ki * i0[3]);
        wr_.z = cvt_pk_bf16(kr * r1[0] - ki * i1[0], kr * r1[1] - ki * i1[1]); wr_.w = cvt_pk_bf16(kr * r1[2] - ki * i1[2], kr * r1[3] - ki * i1[3]);
        wi_.x = cvt_pk_bf16(kr * i0[0] + ki * r0[0], kr * i0[1] + ki * r0[1]); wi_.y = cvt_pk_bf16(kr * i0[2] + ki * r0[2], kr * i0[3] + ki * r0[3]);
        wi_.z = cvt_pk_bf16(kr * i1[0] + ki * r1[0], kr * i1[1] + ki * r1[1]); wi_.w = cvt_pk_bf16(kr * i1[2] + ki * r1[2], kr * i1[3] + ki * r1[3]);
        Ef[s2] = __builtin_bit_cast(bf16x8, wr_); Ef[2 + s2] = __builtin_bit_cast(bf16x8, wi_); }
}
#define S5_E_TILES(blk_) \
    const int tk_ = 16 * (blk_) + (l31 & 3) + 4 * (l31 >> 3); \
    const f32x4 ua_ = UL[tk_ * 4 + 2 * half], ub_ = UL[tk_ * 4 + 2 * half + 1]; \
    v4u aw_; aw_.x = cvt_pk_bf16(ua_[0], ua_[1]); aw_.y = cvt_pk_bf16(ua_[2], ua_[3]); aw_.z = cvt_pk_bf16(ub_[0], ub_[1]); aw_.w = cvt_pk_bf16(ub_[2], ub_[3]); \
    const bf16x8 Af_ = __builtin_bit_cast(bf16x8, aw_); \
    f32x16 zero16_; _Pragma("unroll") for (int q_ = 0; q_ < 16; ++q_) zero16_[q_] = 0.f; \
    const f32x16 D0 = __builtin_amdgcn_mfma_f32_32x32x16_bf16(Af_, Ef[0], zero16_, 0, 0, 0), D1 = __builtin_amdgcn_mfma_f32_32x32x16_bf16(Af_, Ef[1], zero16_, 0, 0, 0); \
    const f32x16 D2 = __builtin_amdgcn_mfma_f32_32x32x16_bf16(Af_, Ef[2], zero16_, 0, 0, 0), D3 = __builtin_amdgcn_mfma_f32_32x32x16_bf16(Af_, Ef[3], zero16_, 0, 0, 0);

__device__ __forceinline__ void s5_pass_a(LAS unsigned char* scr, int task, const float* TAB, const float* b_re, const float* b_im, const pg8::h16_t* UA, float* XEND, int lane) {
    const int c = task % NCHUNK; int r = task / NCHUNK; const int g = r & 63; r >>= 6; const int d = r & 1; const int b = r >> 1;
    const int half = lane >> 5, l31 = lane & 31;
    const f32x4 t0 = *(const f32x4*)(TAB + ((size_t)((d * 64 + g) * 64 + lane)) * 8); const float ar = t0[0], ai = t0[1];
    bf16x8 Ef[4]; s5_make_ef(Ef, TAB, b_re, b_im, d, g, lane);
    const int j0 = 64 * c;
    const int trow = (d == 0) ? (j0 + lane) : ((j0 < CTX_LEN ? 255 - j0 : 2559 - j0) - lane);
    const v4u* up = (const v4u*)(UA + ((size_t)(b * RPB + trow)) * D_A + g * 16);
    LAS f32x4* UL = (LAS f32x4*)scr;
#pragma unroll
    for (int q = 0; q < 2; ++q) { const v4u w = up[q]; const f32x2 p0 = pg8::unpk_f16(w.x), p1 = pg8::unpk_f16(w.y), p2 = pg8::unpk_f16(w.z), p3 = pg8::unpk_f16(w.w);
        UL[lane * 4 + 2 * q] = (f32x4){p0.x, p0.y, p1.x, p1.y}; UL[lane * 4 + 2 * q + 1] = (f32x4){p2.x, p2.y, p3.x, p3.y}; }
    LDS_WAIT(); asm volatile("" ::: "memory");
    float xr = 0.f, xi = 0.f;
#pragma unroll
    for (int i = 0; i < 4; ++i) {
        S5_E_TILES(i)
#pragma unroll
        for (int ss = 0; ss < 16; ++ss) { const float er = half ? D1[ss] : D0[ss], ei = half ? D3[ss] : D2[ss];
            const float nr_ = ar * xr - ai * xi + er, ni_ = ar * xi + ai * xr + ei; xr = nr_; xi = ni_; }
    }
    __hip_atomic_store((unsigned long long*)(XEND + ((size_t)task * 64 + lane) * 2), ((unsigned long long)__float_as_uint(xi) << 32) | (unsigned long long)__float_as_uint(xr), __ATOMIC_RELAXED, __HIP_MEMORY_SCOPE_AGENT);
    LDS_WAIT(); asm volatile("" ::: "memory");
}

__device__ __forceinline__ float gelu_tanh_f(float y) { const float z = 1.5957691216057308f * (y + 0.044715f * y * y * y); return y * sigmoid_f(z); }
__device__ __forceinline__ unsigned short f2bf_rne(float f) { unsigned u = __float_as_uint(f); return (unsigned short)((u + 0x7fffu + ((u >> 16) & 1u)) >> 16); }

__device__ __forceinline__ void s5_pass_c(LAS unsigned char* scr, int task, const float* TAB, const float* b_re, const float* b_im, const float* c_re, const float* c_im, const float* dskip,
                                          const pg8::h16_t* UA, const float* XEND, bf16* GA, int lane) {
    const int c = 4 + (task & 31), g = (task >> 5) & 63, b = task >> 11;
    const int r16 = lane & 15, q4 = lane >> 4;
    LAS f32x4* UL = (LAS f32x4*)scr;
    LAS unsigned char* XB = scr + 4096;
    const int row0 = b * RPB + 64 * c;
    { const v4u* up = (const v4u*)(UA + ((size_t)(row0 + lane)) * D_A + g * 16);
#pragma unroll
      for (int q = 0; q < 2; ++q) { const v4u w = up[q]; const f32x2 p0 = pg8::unpk_f16(w.x), p1 = pg8::unpk_f16(w.y), p2 = pg8::unpk_f16(w.z), p3 = pg8::unpk_f16(w.w);
          UL[lane * 4 + 2 * q] = (f32x4){p0.x, p0.y, p1.x, p1.y}; UL[lane * 4 + 2 * q + 1] = (f32x4){p2.x, p2.y, p3.x, p3.y}; } }
    bf16x8 Cf[4];
#pragma unroll
    for (int ks = 0; ks < 4; ++ks) { const int k0 = 32 * ks + 8 * q4; const bool im = (ks >= 2);
        const float* src = (im ? c_im : c_re) + ((size_t)(g * 16 + r16)) * 64 + (k0 & 63); const float sg = im ? -1.f : 1.f;
        const f32x4 a = *(const f32x4*)src, bb = *(const f32x4*)(src + 4);
        v4u w; w.x = cvt_pk_bf16(sg * a[0], sg * a[1]); w.y = cvt_pk_bf16(sg * a[2], sg * a[3]); w.z = cvt_pk_bf16(sg * bb[0], sg * bb[1]); w.w = cvt_pk_bf16(sg * bb[2], sg * bb[3]);
        Cf[ks] = __builtin_bit_cast(bf16x8, w); }
    f32x4 ya[4];
#pragma unroll
    for (int i = 0; i < 4; ++i) ya[i] = (f32x4){0.f, 0.f, 0.f, 0.f};
    LDS_WAIT(); asm volatile("" ::: "memory");
    const int half = lane >> 5, l31 = lane & 31;
#pragma unroll
    for (int d = 0; d < 2; ++d) {
        float ar, ai, a64r, a64i;
        { const f32x4 t0 = *(const f32x4*)(TAB + ((size_t)((d * 64 + g) * 64 + lane)) * 8), t1 = *(const f32x4*)(TAB + ((size_t)((d * 64 + g) * 64 + lane)) * 8 + 4);
          ar = t0[0]; ai = t0[1]; a64r = t1[0]; a64i = t1[1]; }
        bf16x8 Ef[4]; s5_make_ef(Ef, TAB, b_re, b_im, d, g, lane);
        const int nprev = (d == 0) ? c : (39 - c);
        const f32x2* xe = (const f32x2*)(XEND + ((size_t)(((b * 2 + d) * 64 + g) * NCHUNK)) * 128) + lane;
        float xr = 0.f, xi = 0.f;
#pragma unroll 8
        for (int cc = 0; cc < nprev; ++cc) { const f32x2 e = xe[cc * 64]; const float nr_ = a64r * xr - a64i * xi + e.x, ni_ = a64r * xi + a64i * xr + e.y; xr = nr_; xi = ni_; }
#pragma unroll
        for (int ii = 0; ii < 4; ++ii) {
            const int i = (d == 0) ? ii : (3 - ii);
            S5_E_TILES(i)
#pragma unroll
            for (int ss = 0; ss < 16; ++ss) {
                const int s16 = (d == 0) ? ss : (15 - ss);
                const float er = half ? D1[s16] : D0[s16], ei = half ? D3[s16] : D2[s16];
                const float nr_ = ar * xr - ai * xi + er, ni_ = ar * xi + ai * xr + ei; xr = nr_; xi = ni_;
                *(LAS unsigned short*)(XB + s16 * 272 + 2 * lane) = f2bf_rne(xr);
                *(LAS unsigned short*)(XB + s16 * 272 + 128 + 2 * lane) = f2bf_rne(xi);
            }
            LDS_WAIT(); asm volatile("" ::: "memory");
#pragma unroll
            for (int ks = 0; ks < 4; ++ks) { const bf16x8 Bf = *(const LAS bf16x8*)(XB + r16 * 272 + 64 * ks + 16 * q4);
                ya[i] = __builtin_amdgcn_mfma_f32_16x16x32_bf16(Cf[ks], Bf, ya[i], 0, 0, 0); }
            LDS_WAIT(); asm volatile("" ::: "memory");
        }
    }
    const f32x4 dk = *(const f32x4*)(dskip + g * 16 + 4 * q4);
#pragma unroll
    for (int i = 0; i < 4; ++i) { const int tl = 16 * i + r16; const f32x4 u4 = UL[tl * 4 + q4];
        const f32x4 y = ya[i] + dk * u4;
        v2u w; w.x = cvt_pk_bf16(gelu_tanh_f(y[0]), gelu_tanh_f(y[1])); w.y = cvt_pk_bf16(gelu_tanh_f(y[2]), gelu_tanh_f(y[3]));
        *(GAS v2u*)(GA + ((size_t)(row0 + tl)) * D_A + g * 16 + 4 * q4) = w; }
    LDS_WAIT(); asm volatile("" ::: "memory");
}

__device__ __forceinline__ int hg_row(int b, int dir, int j) {
    const int jf = dir ? (j < CTX_LEN ? (CTX_LEN - 1 - j) : (2559 - j)) : j;
    int t = jf; if (jf >= CTX_LEN) { const int jj = jf - CTX_LEN; t = CTX_LEN + (jj & 31) * 64 + (jj >> 5); }
    return b * RPB + t;
}
constexpr int HG_TOT = 0, HG_DEC = 8192, HG_ROWS = 8704, HG_QS = 9216, HG_KS = 26624, HG_QB = 44032, HG_K2T = 61440, HG_VT = 79872, HG_P = 98304;
__device__ __forceinline__ void hgrn2_unit(LAS unsigned char* lds, int unit, const bf16* Q, const bf16* V, const pg8::h16_t* LFF, const pg8::h16_t* LFB, bf16* OHG, int tid) {
    const int b = unit >> 5, head = (unit >> 1) & 15, dir = unit & 1;
    const pg8::h16_t* LF = dir ? LFB : LFF;
    bf16* O = OHG + (size_t)dir * RT * D_B;
    const int lane = tid & 63, w = __builtin_amdgcn_readfirstlane(tid >> 6), kp = lane, tq = w, r16 = lane & 15, q4 = lane >> 4;
    const int colb = head * 128;
    LAS float* TOT = (LAS float*)(lds + HG_TOT); LAS float* DEC = (LAS float*)(lds + HG_DEC); LAS int* ROWS = (LAS int*)(lds + HG_ROWS); LAS float* EREF = (LAS float*)(lds + HG_QB);
    f32x4 S[8];
#pragma unroll
    for (int i = 0; i < 8; ++i) S[i] = (f32x4){0.f, 0.f, 0.f, 0.f};
    f32x2 lf[8]; unsigned qv[8], vv[8]; int rows[8];
#pragma unroll
    for (int i = 0; i < 8; ++i) { rows[i] = hg_row(b, dir, 8 * tq + i); const size_t o = (size_t)rows[i] * D_B + colb + 2 * kp;
        lf[i] = pg8::unpk_f16(*(const GAS unsigned*)(LF + o)); qv[i] = *(const GAS unsigned*)(Q + o); vv[i] = *(const GAS unsigned*)(V + o); }
    { float s0 = 0.f, s1 = 0.f;
#pragma unroll
      for (int i = 0; i < 8; ++i) { s0 += lf[i].x; s1 += lf[i].y; }
      *(LAS f32x2*)(TOT + tq * 128 + 2 * kp) = (f32x2){s0, s1}; }
    LDS_WAIT(); __builtin_amdgcn_s_barrier(); asm volatile("" ::: "memory");
    for (int c = 0; c < NCHUNK; ++c) {
        const LAS float* TC = TOT + (c & 1) * 1024;
        float off0 = 0.f, off1 = 0.f, ref0 = 0.f, ref1 = 0.f, all0 = 0.f, all1 = 0.f;
#pragma unroll
        for (int t2 = 0; t2 < 8; ++t2) { const f32x2 tt = *(const LAS f32x2*)(TC + t2 * 128 + 2 * kp);
            if (t2 < tq) { off0 += tt.x; off1 += tt.y; } if (t2 < 4) { ref0 += tt.x; ref1 += tt.y; } all0 += tt.x; all1 += tt.y; }
        const bool outp = (c >= 4);
        float k20[8], k21[8];
        { float b0 = off0, b1 = off1; const float ca0 = __expf(all0 - ref0), ca1 = __expf(all1 - ref1);
#pragma unroll
          for (int i = 0; i < 8; ++i) {
            b0 += lf[i].x; b1 += lf[i].y;
            const float kk0 = 1.0f - __expf(lf[i].x), kk1 = 1.0f - __expf(lf[i].y);
            const float ks0 = kk0 * __expf(ref0 - b0), ks1 = kk1 * __expf(ref1 - b1);
            k20[i] = ks0 * ca0; k21[i] = ks1 * ca1;
            if (outp) { const float q0 = bf_lo(qv[i]), q1 = bf_hi(qv[i]); const int t = 8 * tq + i;
                *(LAS unsigned*)(lds + HG_QS + t * 272 + 4 * kp) = cvt_pk_bf16(q0 * __expf(b0 - ref0), q1 * __expf(b1 - ref1));
                *(LAS unsigned*)(lds + HG_KS + t * 272 + 4 * kp) = cvt_pk_bf16(ks0, ks1); }
          } }
        { v4u a, bq; a.x = cvt_pk_bf16(k20[0], k20[1]); a.y = cvt_pk_bf16(k20[2], k20[3]); a.z = cvt_pk_bf16(k20[4], k20[5]); a.w = cvt_pk_bf16(k20[6], k20[7]);
          bq.x = cvt_pk_bf16(k21[0], k21[1]); bq.y = cvt_pk_bf16(k21[2], k21[3]); bq.z = cvt_pk_bf16(k21[4], k21[5]); bq.w = cvt_pk_bf16(k21[6], k21[7]);
          *(LAS v4u*)(lds + HG_K2T + (2 * kp) * 144 + 16 * tq) = a; *(LAS v4u*)(lds + HG_K2T + (2 * kp + 1) * 144 + 16 * tq) = bq;
          v4u lo, hi;
          lo.x = __builtin_amdgcn_perm(vv[1], vv[0], 0x05040100u); lo.y = __builtin_amdgcn_perm(vv[3], vv[2], 0x05040100u); lo.z = __builtin_amdgcn_perm(vv[5], vv[4], 0x05040100u); lo.w = __builtin_amdgcn_perm(vv[7], vv[6], 0x05040100u);
          hi.x = __builtin_amdgcn_perm(vv[1], vv[0], 0x07060302u); hi.y = __builtin_amdgcn_perm(vv[3], vv[2], 0x07060302u); hi.z = __builtin_amdgcn_perm(vv[5], vv[4], 0x07060302u); hi.w = __builtin_amdgcn_perm(vv[7], vv[6], 0x07060302u);
          *(LAS v4u*)(lds + HG_VT + (2 * kp) * 144 + 16 * tq) = lo; *(LAS v4u*)(lds + HG_VT + (2 * kp + 1) * 144 + 16 * tq) = hi; }
        if (tq == 0) { *(LAS f32x2*)(DEC + 2 * kp) = (f32x2){__expf(all0), __expf(all1)}; *(LAS f32x2*)(EREF + 2 * kp) = (f32x2){__expf(ref0), __expf(ref1)}; }
        if (kp == 0) {
#pragma unroll
            for (int i = 0; i < 8; ++i) ROWS[8 * tq + i] = rows[i]; }
        if (c + 1 < NCHUNK) {
#pragma unroll
            for (int i = 0; i < 8; ++i) { rows[i] = hg_row(b, dir, 64 * (c + 1) + 8 * tq + i); const size_t o = (size_t)rows[i] * D_B + colb + 2 * kp;
                lf[i] = pg8::unpk_f16(*(const GAS unsigned*)(LF + o)); qv[i] = *(const GAS unsigned*)(Q + o); vv[i] = *(const GAS unsigned*)(V + o); } }
        LDS_WAIT(); __builtin_amdgcn_s_barrier(); asm volatile("" ::: "memory");
        bf16x8 Vf[2];
#pragma unroll
        for (int ks2 = 0; ks2 < 2; ++ks2) Vf[ks2] = *(const LAS bf16x8*)(lds + HG_VT + (16 * w + r16) * 144 + 64 * ks2 + 16 * q4);
        f32x4 oacc[4]; int orow[4][4];
#pragma unroll
        for (int ti = 0; ti < 4; ++ti) oacc[ti] = (f32x4){0.f, 0.f, 0.f, 0.f};
        if (outp) {
            bf16x8 Af[4], Bf[2][4];
#pragma unroll
            for (int ks = 0; ks < 4; ++ks) Af[ks] = *(const LAS bf16x8*)(lds + HG_KS + (16 * (w >> 1) + r16) * 272 + 64 * ks + 16 * q4);
#pragma unroll
            for (int tsel = 0; tsel < 2; ++tsel) { const int ti = 2 * (w & 1) + tsel;
#pragma unroll
                for (int ks = 0; ks < 4; ++ks) Bf[tsel][ks] = *(const LAS bf16x8*)(lds + HG_QS + (16 * ti + r16) * 272 + 64 * ks + 16 * q4); }
#pragma unroll
            for (int ti = 0; ti < 4; ++ti) { typedef int i32x4 __attribute__((ext_vector_type(4))); const i32x4 rr = *(const LAS i32x4*)(ROWS + 16 * ti + 4 * q4);
                orow[ti][0] = rr.x; orow[ti][1] = rr.y; orow[ti][2] = rr.z; orow[ti][3] = rr.w; }
#pragma unroll
            for (int tsel = 0; tsel < 2; ++tsel) { const int idx = 2 * w + tsel, si = idx >> 2, ti = idx & 3;
                f32x4 dacc = (f32x4){0.f, 0.f, 0.f, 0.f};
#pragma unroll
                for (int ks = 0; ks < 4; ++ks) dacc = __builtin_amdgcn_mfma_f32_16x16x32_bf16(Af[ks], Bf[tsel][ks], dacc, 0, 0, 0);
                const int t = 16 * ti + r16, s0 = 16 * si + 4 * q4;
#pragma unroll
                for (int j = 0; j < 4; ++j) if (s0 + j > t) dacc[j] = 0.f;
                v2u pw; pw.x = cvt_pk_bf16(dacc[0], dacc[1]); pw.y = cvt_pk_bf16(dacc[2], dacc[3]);
                *(LAS v2u*)(lds + HG_P + t * 144 + 2 * s0) = pw; }
            v2u alo[4][4], ahi[4][4]; f32x4 er[8];
#pragma unroll
            for (int kt = 0; kt < 8; ++kt) er[kt] = *(const LAS f32x4*)(EREF + 16 * kt + 4 * q4);
#pragma unroll
            for (int ks = 0; ks < 4; ++ks)
#pragma unroll
                for (int ti = 0; ti < 4; ++ti) { alo[ks][ti] = *(const LAS v2u*)(lds + HG_QS + (16 * ti + r16) * 272 + 64 * ks + 8 * q4);
                    ahi[ks][ti] = *(const LAS v2u*)(lds + HG_QS + (16 * ti + r16) * 272 + 64 * ks + 32 + 8 * q4); }
#pragma unroll
            for (int ks = 0; ks < 4; ++ks) { const f32x4 s0 = S[2 * ks] * er[2 * ks], s1 = S[2 * ks + 1] * er[2 * ks + 1];
                v4u sw; sw.x = cvt_pk_bf16(s0[0], s0[1]); sw.y = cvt_pk_bf16(s0[2], s0[3]); sw.z = cvt_pk_bf16(s1[0], s1[1]); sw.w = cvt_pk_bf16(s1[2], s1[3]);
                const bf16x8 Sf = __builtin_bit_cast(bf16x8, sw);
#pragma unroll
                for (int ti = 0; ti < 4; ++ti) { v4u aw; aw.x = alo[ks][ti].x; aw.y = alo[ks][ti].y; aw.z = ahi[ks][ti].x; aw.w = ahi[ks][ti].y;
                    oacc[ti] = __builtin_amdgcn_mfma_f32_16x16x32_bf16(__builtin_bit_cast(bf16x8, aw), Sf, oacc[ti], 0, 0, 0); } }
        }
        { bf16x8 Kf[8][2]; f32x4 dc[8];
#pragma unroll
          for (int kt = 0; kt < 8; ++kt) { dc[kt] = *(const LAS f32x4*)(DEC + 16 * kt + 4 * q4);
#pragma unroll
              for (int ks2 = 0; ks2 < 2; ++ks2) Kf[kt][ks2] = *(const LAS bf16x8*)(lds + HG_K2T + (16 * kt + r16) * 144 + 64 * ks2 + 16 * q4); }
#pragma unroll
          for (int kt = 0; kt < 8; ++kt) { S[kt] = S[kt] * dc[kt];
#pragma unroll
              for (int ks2 = 0; ks2 < 2; ++ks2) S[kt] = __builtin_amdgcn_mfma_f32_16x16x32_bf16(Kf[kt][ks2], Vf[ks2], S[kt], 0, 0, 0); } }
        if (c + 1 < NCHUNK) { float s0 = 0.f, s1 = 0.f;
#pragma unroll
            for (int i = 0; i < 8; ++i) { s0 += lf[i].x; s1 += lf[i].y; }
            *(LAS f32x2*)(TOT + ((c + 1) & 1) * 1024 + tq * 128 + 2 * kp) = (f32x2){s0, s1}; }
        LDS_WAIT(); __builtin_amdgcn_s_barrier(); asm volatile("" ::: "memory");
        if (outp) {
            bf16x8 Pf[4][2];
#pragma unroll
            for (int ti = 0; ti < 4; ++ti)
#pragma unroll
                for (int ks2 = 0; ks2 < 2; ++ks2) Pf[ti][ks2] = *(const LAS bf16x8*)(lds + HG_P + (16 * ti + r16) * 144 + 64 * ks2 + 16 * q4);
#pragma unroll
            for (int ti = 0; ti < 4; ++ti)
#pragma unroll
                for (int ks2 = 0; ks2 < 2; ++ks2) oacc[ti] = __builtin_amdgcn_mfma_f32_16x16x32_bf16(Pf[ti][ks2], Vf[ks2], oacc[ti], 0, 0, 0);
#pragma unroll
            for (int ti = 0; ti < 4; ++ti)
#pragma unroll
                for (int j = 0; j < 4; ++j) O[(size_t)orow[ti][j] * D_B + colb + 16 * w + r16] = (bf16)(cvt_pk_bf16(oacc[ti][j], 0.f) & 0xffffu);
        }
    }
    LDS_WAIT(); __builtin_amdgcn_s_barrier(); asm volatile("" ::: "memory");
}
__device__ __forceinline__ void hg_finalize_row(int lr, const bf16* OHG, const bf16* OG, const float* gn, bf16* YB, int lane) {
    const int row = (lr >> 11) * RPB + CTX_LEN + (lr & 2047);
    const size_t o = (size_t)row * D_B + 2 * lane;
    unsigned a[16], bq[16], og[16];
#pragma unroll
    for (int h = 0; h < 16; ++h) { a[h] = *(const GAS unsigned*)(OHG + o + h * 128); bq[h] = *(const GAS unsigned*)(OHG + (size_t)RT * D_B + o + h * 128); og[h] = *(const GAS unsigned*)(OG + o + h * 128); }
#pragma unroll
    for (int h = 0; h < 16; ++h) { const float o0 = bf_lo(a[h]) + bf_lo(bq[h]), o1 = bf_hi(a[h]) + bf_hi(bq[h]);
        const float r = 1.0f / sqrtf(wave_sum(o0 * o0 + o1 * o1) * (1.f / 128.f) + EPS);
        const f32x2 g = *(const GAS f32x2*)(gn + h * 128 + 2 * lane);
        *(GAS unsigned*)(YB + (size_t)row * pg8::DY + 2 * lane + h * 128) = cvt_pk_bf16(o0 * r * g.x * silu_f(bf_lo(og[h])), o1 * r * g.y * silu_f(bf_hi(og[h])));
    }
}

constexpr int ITB_WIN = 3 * IT_FF, ITB_GLU = ITB_WIN + IT_WIN, ITB_FF2 = ITB_GLU + IT_GLU + IT_PA + IT_PB + IT_OUT;
constexpr int TAIL2_ITEMS = 30912, TAIL5_ITEMS = 3000;
constexpr int CONV6_ITEMS = 24000;
constexpr int P0_HOLE = ITB_WIN, P0_ITEMS = T_ITEMS - IT_FF - TAIL2_ITEMS - CONV6_ITEMS;
static_assert(ITB_FF2 + 3 * IT_FF == T_ITEMS, "item list");
__device__ __forceinline__ ItemDesc item_desc(const Args& args, unsigned char* ws, int it) {
    int r = it;
    if (r < IT_FF) return make_item(args.in[I_W1A], D_MODEL, D_FF, (bf16*)(ws + WS_W13A), 1, r); r -= IT_FF;
    if (r < IT_FF) return make_item(args.in[I_W3A], D_MODEL, D_FF, (bf16*)(ws + WS_W13A), 2, r); r -= IT_FF;
    if (r < IT_FF) return make_item(args.in[I_W2A], D_FF, D_MODEL, (bf16*)(ws + WS_W2A), 0, r, D_FFP); r -= IT_FF;
    if (r < IT_WIN) return make_item(args.in[I_WIN], D_MODEL, N_IN, (bf16*)(ws + WS_WIN), 3, r); r -= IT_WIN;
    if (r < IT_GLU) return make_item(args.in[I_WGLU], D_A, D_A, (bf16*)(ws + WS_WGLU), 0, r); r -= IT_GLU;
    if (r < IT_PA) return make_item(args.in[I_WPA], D_A, D_MODEL, (bf16*)(ws + WS_WP) + D_B, 0, r, pg8::DY); r -= IT_PA;
    if (r < IT_PB) return make_item(args.in[I_WPB], D_B, D_MODEL, (bf16*)(ws + WS_WP), 0, r, pg8::DY); r -= IT_PB;
    if (r < IT_OUT) return make_item(args.in[I_WOUT], D_MODEL, D_MODEL, (bf16*)(ws + WS_WOUT), 0, r); r -= IT_OUT;
    if (r < IT_FF) return make_item(args.in[I_W1B], D_MODEL, D_FF, (bf16*)(ws + WS_W13B), 1, r); r -= IT_FF;
    if (r < IT_FF) return make_item(args.in[I_W3B], D_MODEL, D_FF, (bf16*)(ws + WS_W13B), 2, r); r -= IT_FF;
    return make_item(args.in[I_W2B], D_FF, D_MODEL, (bf16*)(ws + WS_W2B), 0, r, D_FFP);
}
__device__ __forceinline__ void convert_range(const Args& args, unsigned char* ws, int first, int end, int step, LAS float* s, int lane, int hole_at = 0x7fffffff, int hole_len = 0) {
    if (first >= end) return;
    ItemDesc d0 = item_desc(args, ws, first < hole_at ? first : first + hole_len), d1 = d0; f32x4 va[8], vb[8]; item_load(d0, va, lane);
    if (first + step < end) { const int n1 = first + step; d1 = item_desc(args, ws, n1 < hole_at ? n1 : n1 + hole_len); item_load(d1, vb, lane); }
    else {
#pragma unroll
        for (int i = 0; i < 8; ++i) vb[i] = va[i]; }
    for (int it = first; it < end; it += step) {
        const int n2 = it + 2 * step; ItemDesc d2 = d1; f32x4 vc[8];
        if (n2 < end) { d2 = item_desc(args, ws, n2 < hole_at ? n2 : n2 + hole_len); item_load(d2, vc, lane); }
        else {
#pragma unroll
            for (int i = 0; i < 8; ++i) vc[i] = vb[i]; }
        item_store(d0, va, s, lane);
        d0 = d1; d1 = d2;
#pragma unroll
        for (int i = 0; i < 8; ++i) { va[i] = vb[i]; vb[i] = vc[i]; }
    }
}
__device__ __forceinline__ void tail_convert(const Args& args, unsigned char* ws, int begin, int end, int first_block, int G, int bx, int wave, LAS float* s) {
    int tl = threadIdx.x; asm volatile("" : "+v"(tl));
    if (first_block >= G) { convert_range(args, ws, begin + bx * NWAVES + wave, end, G * NWAVES, s, tl & 63); return; }
    if (bx < first_block) return;
    convert_range(args, ws, begin + (bx - first_block) * NWAVES + wave, end, (G - first_block) * NWAVES, s, tl & 63);
}

__global__ void __launch_bounds__(NWAVES * 64, 2) fwd_kernel(Args args) {
    extern __shared__ __attribute__((aligned(16))) unsigned char lds_raw[];
    LAS unsigned char* lds = (LAS unsigned char*)lds_raw;
    volatile LAS unsigned* MISC = (volatile LAS unsigned*)(lds + MISC_OFF);
    const int tid = threadIdx.x, wave = __builtin_amdgcn_readfirstlane(tid >> 6);
#define PHASE_LANE() int tidp = threadIdx.x; asm volatile("" : "+v"(tidp)); const int lane = tidp & 63; (void)lane
    const int G = gridDim.x, bx = blockIdx.x;
    const int vcu = (G % 8 == 0) ? (bx % 8) * (G / 8) + bx / 8 : bx;
    const int gw = vcu * NWAVES + wave, NGW = G * NWAVES;
    unsigned char* ws = args.ws;
    gu32* ctl = (gu32*)(ws + WS_CTL);
    for (int u = tid; u < (LDS_BYTES - LDSCTL_OFF) / 4; u += NWAVES * 64) ((LAS unsigned*)(lds + LDSCTL_OFF))[u] = 0u;
    __syncthreads();
    XcdBarrier bar = xcd_barrier_post((unsigned*)(ctl + CW_BAR), MISC + 8);
    LAS unsigned char* scr = lds + RING_OFF + wave * 16384;

    float* MODP = (float*)(ws + WS_MODP); float* MOD = (float*)(ws + WS_MOD); float* TAB = (float*)(ws + WS_TAB); float* LBT = (float*)(ws + WS_TAB + 512 * 1024);
    bf16* W13A = (bf16*)(ws + WS_W13A); bf16* W2A = (bf16*)(ws + WS_W2A); bf16* WIN = (bf16*)(ws + WS_WIN); bf16* WGLU = (bf16*)(ws + WS_WGLU); bf16* WPA = (bf16*)(ws + WS_WPA);
    bf16* WPB = (bf16*)(ws + WS_WPB); bf16* WOUT = (bf16*)(ws + WS_WOUT); bf16* W13B = (bf16*)(ws + WS_W13B); bf16* W2B = (bf16*)(ws + WS_W2B);
    bf16* ZN = (bf16*)(ws + WS_ZN); bf16* HID = (bf16*)(ws + WS_HID); pg8::h16_t* HB = (pg8::h16_t*)(ws + WS_H); pg8::h16_t* UA = (pg8::h16_t*)(ws + WS_UA);
    bf16* QB_ = (bf16*)(ws + WS_Q); bf16* VB_ = (bf16*)(ws + WS_V); bf16* OGB = (bf16*)(ws + WS_OG); pg8::h16_t* LFF = (pg8::h16_t*)(ws + WS_LFF); pg8::h16_t* LFB = (pg8::h16_t*)(ws + WS_LFB);
    bf16* SGA = (bf16*)(ws + WS_SGA); bf16* SGB = (bf16*)(ws + WS_SGB); float* XEND = (float*)(ws + WS_XEND); bf16* GA = (bf16*)(ws + WS_GA); bf16* YY = (bf16*)(ws + WS_Y); bf16* WP = (bf16*)(ws + WS_WP);
    bf16* OHG = (bf16*)(ws + WS_OHG); float* PT = (float*)(ws + WS_PT); bf16* MRG = (bf16*)(ws + WS_MRG);

    {
        PHASE_LANE();
        for (int idx = bx * (NWAVES * 64) + tidp; idx < 8192 + 4096; idx += G * NWAVES * 64) {
            if (idx < 8192) s5_table_entry(args.in[I_LAMRE], args.in[I_LAMIM], args.in[I_LOGDT], TAB, idx);
            else { const int j = idx - 8192, d = j >> 11, cc = j & 2047; const float l0 = args.in[I_LBLOG][(d * 2 + 0) * D_B + cc], l1 = args.in[I_LBLOG][(d * 2 + 1) * D_B + cc]; LBT[j] = 1.0f / (1.0f + expf(l1 - l0)); }
        }
        if (NGW > ADA_TASKS) {
            int per = (P0_ITEMS + ADA_TASKS * 64 + NGW - 1) / NGW; if (per < 64) per = 64;
            const int a = per - 64, s1 = (a * NGW < P0_ITEMS) ? a * NGW : P0_ITEMS;
            convert_range(args, ws, gw, s1, NGW, (LAS float*)scr, lane, P0_HOLE, TAIL2_ITEMS);
            if (gw < ADA_TASKS) p0_ada_task(args.in[I_C], args.in[I_CCTX], args.in[I_WADA], MODP, gw, (LAS float*)scr, lane);
            else convert_range(args, ws, s1 + (gw - ADA_TASKS), P0_ITEMS, NGW - ADA_TASKS, (LAS float*)scr, lane, P0_HOLE, TAIL2_ITEMS);
        } else {
            for (int t = gw; t < ADA_TASKS; t += NGW) p0_ada_task(args.in[I_C], args.in[I_CCTX], args.in[I_WADA], MODP, t, (LAS float*)scr, lane);
            convert_range(args, ws, gw, P0_ITEMS, NGW, (LAS float*)scr, lane, P0_HOLE, TAIL2_ITEMS);
        }
    }
    xcd_barrier(bar);
    { PHASE_LANE();
    for (int idx = bx * (NWAVES * 64) + tidp; idx < 5 * NMODC_; idx += G * NWAVES * 64) {
        float s = args.in[I_BADA][idx % NMODC_];
#pragma unroll
        for (int k = 0; k < ADA_KS; ++k) s += MODP[(size_t)k * 5 * NMODC_ + idx];
        MOD[idx] = s;
    } }
    xcd_barrier(bar);
    { PHASE_LANE();
    for (int m = gw; m < RT; m += NGW) { const int b = m / RPB, t = m - b * RPB; const bool isctx = t < CTX_LEN;
        const float* src = isctx ? args.in[I_CTX] + ((size_t)b * CTX_LEN + t) * D_MODEL : args.in[I_X] + ((size_t)b * SEQ + (t - CTX_LEN)) * D_MODEL;
        const float* mv = MOD + (size_t)(isctx ? 4 : b) * NMODC_;
        norm_mod_row(src, args.in[I_NORM1], mv + 0 * D_MODEL, mv + 1 * D_MODEL, ZN + (size_t)m * D_MODEL, lane); } }
    xcd_barrier(bar);
    { pg8::Gemm g{ZN, W13A, RT, 2 * D_FF, D_MODEL}; pg8::TileOrder S; S.init(36, 86, G, bx, 0); pg8::EpiSwiGLU E{HID, D_FFP};
      pg8::gemm_phase<pg8::EpiSwiGLU, pg8::TileOrder, true, true>(lds + RING_OFF, g, S, E); }
    tail_convert(args, ws, ITB_WIN, ITB_WIN + TAIL2_ITEMS, (36 * 86) % 256, G, bx, wave, (LAS float*)scr);
    xcd_barrier(bar);
    { pg8::Gemm g{HID, W2A, RT, D_MODEL, D_FF, D_FFP}; pg8::DownSplitOrder S; S.init(G, bx); pg8::EpiDown1 E{{args.in[I_X], args.in[I_CTX], HB, nullptr, MOD, 2, 0.5f}, (pg8::h16_t*)PT};
      pg8::gemm_phase<pg8::EpiDown1, pg8::DownSplitOrder, true, true>(lds + RING_OFF, g, S, E); }
    xcd_barrier(bar);
    { PHASE_LANE();
    for (int m = gw; m < RT; m += NGW) { const int b = m / RPB, t = m - b * RPB; const bool isctx = t < CTX_LEN;
        const float* mv = MOD + (size_t)(isctx ? 4 : b) * NMODC_;
        int ln = lane; asm volatile("" : "+v"(ln));
        if (isctx) norm_mod_row_part(args.in[I_CTX] + ((size_t)b * CTX_LEN + t) * D_MODEL, (const pg8::h16_t*)PT + ((size_t)b * CTX_LEN + t) * D_MODEL, mv + 2 * D_MODEL, args.in[I_NORMMIX], mv + 3 * D_MODEL, mv + 4 * D_MODEL, ZN + (size_t)m * D_MODEL, ln);
        else norm_mod_row_h(HB + (size_t)m * D_MODEL, args.in[I_NORMMIX], mv + 3 * D_MODEL, mv + 4 * D_MODEL, ZN + (size_t)m * D_MODEL, ln);
    } }
    xcd_barrier(bar);
    { pg8::Gemm g{ZN, WIN, RT, N_IN, D_MODEL}; pg8::TileOrder2 S; S.init(28, 48, G, bx); pg8::EpiWin E{UA, QB_, LFF, SGA, LBT};
      pg8::gemm_phase<pg8::EpiWin, pg8::TileOrder2, true, true>(lds + RING_OFF, g, S, E); }
    tail_convert(args, ws, T_ITEMS - IT_FF, T_ITEMS - IT_FF + TAIL5_ITEMS, (36 * 28 + 32 * 48) % 256, G, bx, wave, (LAS float*)scr);
    xcd_barrier(bar);
    { PHASE_LANE();
      constexpr int NTA = BATCH * 2 * S5_G * NCHUNK, NTC = BATCH * S5_G * 32;
      const bool hgblk = (G > 128) && (bx < 128);
      const unsigned nprod = (G > 128) ? (unsigned)(G - 128) : (unsigned)G;
      for (int u = bx; u < 128; u += G) hgrn2_unit(lds + RING_OFF, u, QB_, VB_, LFF, LFB, OHG, tidp);
      if (!hgblk) {
          for (;;) {
              int base = 0; if (lane == 0) base = (int)__hip_atomic_fetch_add((unsigned*)(ctl + CW_QUEUE), 4u, RLX_AGENT);
              base = __builtin_amdgcn_readfirstlane(base);
              if (base >= NTA) break;
#pragma unroll 1
              for (int t = base; t < base + 4; ++t) s5_pass_a(scr, t, TAB, args.in[I_BRE], args.in[I_BIM], UA, XEND, lane);
          }
          asm volatile("s_waitcnt vmcnt(0)" ::: "memory");
          __syncthreads();
          if (tidp == 0) (void)__hip_atomic_fetch_add((unsigned*)(ctl + CW_DONE), 1u, RLX_AGENT);
      }
      if (tidp == 0) { unsigned sp = 0;
          while (__hip_atomic_load((unsigned*)(ctl + CW_DONE), RLX_AGENT) < nprod) { __builtin_amdgcn_s_sleep(8);
              if ((++sp & 255u) == 0u) { if (xb_ld((unsigned*)(ctl + CW_BAR) + XB_TMO)) break; if (sp > (1u << 20)) { atomicAdd((unsigned*)(ctl + CW_BAR) + XB_TMO, 1u); break; } } }
          __builtin_amdgcn_fence(__ATOMIC_ACQUIRE, "agent");
          asm volatile("s_waitcnt vmcnt(0)" ::: "memory"); }
      __syncthreads();
      for (;;) {
          int base = 0; if (lane == 0) base = (int)__hip_atomic_fetch_add((unsigned*)(ctl + CW_QUEUE2), 2u, RLX_AGENT);
          base = __builtin_amdgcn_readfirstlane(base);
          if (base >= NTC) break;
#pragma unroll 1
          for (int t = base; t < base + 2; ++t) s5_pass_c(scr, t, TAB, args.in[I_BRE], args.in[I_BIM], args.in[I_CRE], args.in[I_CIM], args.in[I_S5D], UA, XEND, GA, lane);
      }
      for (;;) {
          int base = 0; if (lane == 0) base = (int)__hip_atomic_fetch_add((unsigned*)(ctl + CW_QUEUE3), 8u, RLX_AGENT);
          base = __builtin_amdgcn_readfirstlane(base);
          if (base >= CONV6_ITEMS) break;
          const int i0 = T_ITEMS - IT_FF - CONV6_ITEMS + base;
          convert_range(args, ws, i0, i0 + 8, 1, (LAS float*)scr, lane);
      }
    }
    xcd_barrier(bar);
    const bool glu_split = (G == 256);
    if (glu_split && bx < 128) {
      pg8::Gemm g{GA, WGLU, RT, D_A, D_A}; pg8::TileOrder S; S.init(32, 4, 128, bx, 1); pg8::EpiGlu E{GA, YY + D_B};
      pg8::gemm_phase<pg8::EpiGlu, pg8::TileOrder, true, true>(lds + RING_OFF, g, S, E);
    } else { PHASE_LANE();
    const int gw7 = glu_split ? (bx - 128) * NWAVES + wave : gw, ngw7 = glu_split ? NGW - 128 * NWAVES : NGW;
    for (int t = gw7; t < BATCH * SEQ; t += ngw7) hg_finalize_row(t, OHG, OGB, args.in[I_HGNORM], YY, lane);
    }
    xcd_barrier(bar);
    if (!glu_split) { pg8::Gemm g{GA, WGLU, RT, D_A, D_A}; pg8::TileOrder S; S.init(32, 4, G, bx, 1); pg8::EpiGlu E{GA, YY + D_B};
      pg8::gemm_phase<pg8::EpiGlu, pg8::TileOrder, true, true>(lds + RING_OFF, g, S, E); xcd_barrier(bar); }
    { pg8::Gemm g{YY, WP, RT, D_MODEL, D_B + D_A}; pg8::TileOrder S; S.init(32, 16, G, bx, 1); pg8::EpiMerge E{SGA, SGB, MRG};
      pg8::gemm_phase<pg8::EpiMerge, pg8::TileOrder, true, true>(lds + RING_OFF, g, S, E); }
    xcd_barrier(bar);
    { pg8::Gemm g{MRG, WOUT, RT, D_MODEL, D_MODEL}; pg8::TileOrder S; S.init(32, 16, G, bx, 1); pg8::EpiResid<1, 0> E{nullptr, nullptr, HB, nullptr, MOD, 5, 1.0f};
      pg8::gemm_phase<pg8::EpiResid<1, 0>, pg8::TileOrder, true, true>(lds + RING_OFF, g, S, E); }
    xcd_barrier(bar);
    { PHASE_LANE();
    for (int lr = gw; lr < BATCH * SEQ; lr += NGW) { const int b = lr >> 11, m = b * RPB + CTX_LEN + (lr & 2047);
        const float* mv = MOD + (size_t)b * NMODC_;
        norm_mod_row_h(HB + (size_t)m * D_MODEL, args.in[I_NORM2], mv + 6 * D_MODEL, mv + 7 * D_MODEL, ZN + (size_t)m * D_MODEL, lane); } }
    xcd_barrier(bar);
    { pg8::Gemm g{ZN, W13B, RT, 2 * D_FF, D_MODEL}; pg8::TileOrder S; S.init(32, 86, G, bx, 1); pg8::EpiSwiGLU E{HID, D_FFP};
      pg8::gemm_phase<pg8::EpiSwiGLU, pg8::TileOrder, true, true>(lds + RING_OFF, g, S, E); }
    tail_convert(args, ws, T_ITEMS - IT_FF + TAIL5_ITEMS, T_ITEMS, (32 * 86) % 256, G, bx, wave, (LAS float*)scr);
    xcd_barrier(bar);
    { pg8::Gemm g{HID, W2B, RT, D_MODEL, D_FF, D_FFP}; pg8::HalfRowsOrder S; S.init(G, bx); pg8::EpiResid<1, 0> E{nullptr, nullptr, HB, nullptr, MOD, 8, 0.5f};
      pg8::gemm_phase<pg8::EpiResid<1, 0>, pg8::HalfRowsOrder, true, true>(lds + RING_OFF, g, S, E); }
    xcd_barrier(bar);
    { PHASE_LANE();
    const bool tmo_set = __hip_atomic_load((unsigned*)(ctl + CW_BAR) + XB_TMO, RLX_AGENT) != 0u;
    for (int lr = gw; lr < BATCH * SEQ; lr += NGW) { norm_final_row_h(HB + ((size_t)(lr >> 11) * RPB + CTX_LEN + (lr & 2047)) * D_MODEL, args.out + (size_t)lr * D_MODEL, args.in[I_NORMF], lane);
        if (tmo_set) { GAS f32x4* xr = (GAS f32x4*)(args.out + (size_t)lr * D_MODEL) + lane;
#pragma unroll
            for (int j = 0; j < 16; ++j) xr[64 * j] = (f32x4){1e30f, 1e30f, 1e30f, 1e30f}; } } }
}

extern "C" void kernel_launch(void* const* d_in, const int* in_sizes, int n_in, void* d_out, int out_size, void* d_ws, size_t ws_size, hipStream_t stream) {
    static int grid = 0;
    if (grid == 0) {
        if (n_in != 31 || out_size != BATCH * SEQ * D_MODEL || ws_size < WS_END) { fprintf(stderr, "kernel_launch: unexpected shapes (n_in %d, out %d, ws %zu)\n", n_in, out_size, ws_size); grid = -1; return; }
        int dev = 0, cus = 0, per_cu = 0;
        if (hipGetDevice(&dev) != hipSuccess || hipDeviceGetAttribute(&cus, hipDeviceAttributeMultiprocessorCount, dev) != hipSuccess) { grid = -1; return; }
        if (hipFuncSetAttribute((const void*)fwd_kernel, hipFuncAttributeMaxDynamicSharedMemorySize, LDS_BYTES) != hipSuccess) { fprintf(stderr, "kernel_launch: hipFuncSetAttribute failed\n"); grid = -1; return; }
        if (hipOccupancyMaxActiveBlocksPerMultiprocessor(&per_cu, (const void*)fwd_kernel, NWAVES * 64, LDS_BYTES) != hipSuccess || per_cu < 1)
            fprintf(stderr, "kernel_launch: note: occupancy query reports %d workgroups per CU\n", per_cu);
        (void)hipGetLastError();
        grid = cus;
    }
    if (grid < 0) return;
    if (hipMemsetAsync((char*)d_ws + WS_CTL, 0, CTL_ZERO_BYTES, stream) != hipSuccess) { fprintf(stderr, "kernel_launch: memset failed\n"); return; }
    Args a{};
    for (int i = 0; i < 31; ++i) a.in[i] = (const float*)d_in[i];
    a.out = (float*)d_out; a.ws = (unsigned char*)d_ws;
    hipLaunchKernelGGL(fwd_kernel, dim3(grid), dim3(NWAVES * 64), LDS_BYTES, stream, a);
    const hipError_t le = hipPeekAtLastError();
    if (le != hipSuccess) fprintf(stderr, "kernel_launch: launch failed: %s\n", hipGetErrorName(le));
}
```

```cpp
#include <hip/hip_runtime.h>
#include <cstdio>
#include <cstdint>

namespace pg8 {
#define PG8_LAS __attribute__((address_space(3)))
typedef unsigned short bf16_t;
typedef short bf16x8 __attribute__((ext_vector_type(8)));
typedef float f32x4 __attribute__((ext_vector_type(4)));
typedef unsigned u32x4 __attribute__((ext_vector_type(4)));
constexpr int BM = 256, BK = 64, HALF = 128, HTB = HALF * BK * 2  , STAGE_BYTES = 8 * HTB, NXCD = 8, WGM = 8;

__host__ __device__ __forceinline__ int lds_byte(int r, int c) { const int st = (r >> 4) * 2 + (c >> 5), rr = r & 15, cc = c & 31, ob = rr * 64 + cc * 2; return st * 1024 + (ob ^ (((ob >> 9) & 1) << 5)); }
__host__ __device__ __forceinline__ void stage_rc(int b, int& R, int& C) { const int st = b / 1024, sb = b % 1024, swz = sb ^ (((sb >> 9) & 1) << 5); R = (st >> 1) * 16 + swz / 64; C = (st & 1) * 32 + (swz % 64) / 2; }
__host__ __device__ __forceinline__ int perm32(int rho) { const int n = rho >> 4, i = rho & 15; return 8 * (i >> 2) + 4 * n + (i & 3); }

struct Unit { int pm, pn; };
struct Gemm { const bf16_t* A; const bf16_t* Bt; int M, N, K, LD = 0; };

struct StaticOrder {
    static constexpr bool SPLITK = false;
    int nM, nN, nwg, G, c;
    __host__ __device__ void init(int M, int N, int G_, int c_) { nM = M / BM; nN = N / BM; nwg = nM * nN; G = G_; c = c_; }
    __host__ __device__ bool next(int i, Unit& u) const {
        const long L = (long)i * G + c; if (L >= nwg) return false;
        int wgid = (int)L; { const int q = nwg / NXCD, r = nwg % NXCD, xcd = wgid % NXCD, off = wgid / NXCD; wgid = (xcd < r ? xcd * (q + 1) : r * (q + 1) + (xcd - r) * q) + off; }
        const int nig = WGM * nN, gid = wgid / nig, fm = gid * WGM, gsz = (nM - fm) < WGM ? (nM - fm) : WGM;
        u.pm = fm + ((wgid % nig) % gsz); u.pn = (wgid % nig) / gsz; return true;
    }
    __device__ __forceinline__ void a_ready(const Unit&) const {}
    __device__ __forceinline__ void done(const Unit&) const {}
};


struct TileOrder2 {
    static constexpr bool SPLITK = false;
    int n1c, n2c, nwg1, nwg, G, c;
    __host__ __device__ void init(int n1c_, int n2c_, int G_, int c_) { n1c = n1c_; n2c = n2c_; nwg1 = 36 * n1c; nwg = nwg1 + 32 * n2c; G = G_; c = c_; }
    __host__ __device__ static void map(int L, int nM, int nN, int& pm, int& pn) {
        const int nwg = nM * nN; int wgid = L; { const int q = nwg / NXCD, r = nwg % NXCD, xcd = wgid % NXCD, off = wgid / NXCD; wgid = (xcd < r ? xcd * (q + 1) : r * (q + 1) + (xcd - r) * q) + off; }
        const int nig = WGM * nN, gid = wgid / nig, fm = gid * WGM, gsz = (nM - fm) < WGM ? (nM - fm) : WGM;
        pm = fm + ((wgid % nig) % gsz); pn = (wgid % nig) / gsz; }
    __host__ __device__ bool next(int i, Unit& u) const {
        const long L = (long)i * G + c; if (L >= nwg) return false;
        int pm, pn;
        if (L < nwg1) map((int)L, 36, n1c, pm, pn);
        else { map((int)L - nwg1, 32, n2c, pm, pn); pm = (pm >> 3) * 9 + 1 + (pm & 7); pn += n1c; }
        u.pm = pm; u.pn = pn; return true;
    }
    __device__ __forceinline__ void a_ready(const Unit&) const {}
    __device__ __forceinline__ void done(const Unit&) const {}
};
struct TileOrder {
    static constexpr bool SPLITK = false;
    int nM, nN, nwg, G, c, lat_only;
    __host__ __device__ void init(int nM_, int nN_, int G_, int c_, int lat_only_) { nM = nM_; nN = nN_; nwg = nM * nN; G = G_; c = c_; lat_only = lat_only_; }
    __host__ __device__ bool next(int i, Unit& u) const {
        const long L = (long)i * G + c; if (L >= nwg) return false;
        int wgid = (int)L; { const int q = nwg / NXCD, r = nwg % NXCD, xcd = wgid % NXCD, off = wgid / NXCD; wgid = (xcd < r ? xcd * (q + 1) : r * (q + 1) + (xcd - r) * q) + off; }
        const int nig = WGM * nN, gid = wgid / nig, fm = gid * WGM, gsz = (nM - fm) < WGM ? (nM - fm) : WGM;
        int pm = fm + ((wgid % nig) % gsz); u.pn = (wgid % nig) / gsz;
        if (lat_only) pm = (pm >> 3) * 9 + 1 + (pm & 7);
        u.pm = pm; return true;
    }
    __device__ __forceinline__ void a_ready(const Unit&) const {}
    __device__ __forceinline__ void done(const Unit&) const {}
};

struct HalfRowsOrder {
    static constexpr bool SPLITK = false, STAGGER = false;
    TileOrder fb; int G, c;
    __host__ __device__ void init(int G_, int c_) { fb.init(32, 16, G_, c_, 1); G = G_; c = c_; }
    __host__ __device__ bool next(int i, Unit& u) const {
        if (G != 256) return fb.next(i, u);
        if (i >= 2) return false;
        const int x = c & 7, j = c >> 3, pl = 16 * i + 4 * (x >> 1) + (j & 3);
        u.pm = (pl >> 3) * 9 + 1 + (pl & 7); u.pn = 8 * (x & 1) + (j >> 2); return true;
    }
    __device__ __forceinline__ void a_ready(const Unit&) const {}
    __device__ __forceinline__ void done(const Unit&) const {}
};
struct DownSplitOrder {
    static constexpr bool SPLITK = true;
    HalfRowsOrder lat; int G, c;
    __host__ __device__ void init(int G_, int c_) { lat.init(G_, c_); G = G_; c = c_; }
    __host__ __device__ bool next(int i, Unit& u) const {
        const long L = (long)i * G + c; if (L >= 512 + 256) return false;
        if (L < 512) return lat.next(i, u);
        const int idx = (int)L - 512;
        u.pm = 9 * (idx >> 6); u.pn = ((idx >> 2) & 15) | (((idx & 3) + 1) << 8); return true;
    }
    __host__ __device__ static int kt0(const Unit& u) { const int q = u.pn >> 8; return q == 0 ? 0 : (q - 1) * 44 - (q == 4 ? 2 : 0); }
    __host__ __device__ static int cnt(const Unit& u, int full) { const int q = u.pn >> 8; return q == 0 ? full : (q <= 2 ? 44 : 42); }
    __device__ __forceinline__ void a_ready(const Unit&) const {}
    __device__ __forceinline__ void done(const Unit&) const {}
};

typedef float f32x2_cv __attribute__((ext_vector_type(2)));
typedef __bf16 bf16x2_cv __attribute__((ext_vector_type(2)));
__device__ __forceinline__ unsigned cvt_pk_bf16(float lo, float hi) { const f32x2_cv v = {lo, hi}; const bf16x2_cv b = __builtin_convertvector(v, bf16x2_cv); return __builtin_bit_cast(unsigned, b); }
typedef _Float16 h16x2_cv __attribute__((ext_vector_type(2)));
typedef unsigned short h16_t;
__device__ __forceinline__ unsigned cvt_pk_f16(float lo, float hi) { const f32x2_cv v = {lo, hi}; const h16x2_cv h = __builtin_convertvector(v, h16x2_cv); return __builtin_bit_cast(unsigned, h); }
__device__ __forceinline__ f32x2_cv unpk_f16(unsigned w) { const h16x2_cv h = __builtin_bit_cast(h16x2_cv, w); return __builtin_convertvector(h, f32x2_cv); }
__device__ __forceinline__ float bf_lo(unsigned w) { return __uint_as_float(w << 16); }
__device__ __forceinline__ float bf_hi(unsigned w) { return __uint_as_float(w & 0xffff0000u); }
__device__ __forceinline__ float sigmoid_f(float x) { return __builtin_amdgcn_rcpf(1.0f + __builtin_amdgcn_exp2f(-1.4426950408889634f * x)); }
__device__ __forceinline__ float silu_f(float x) { return x * sigmoid_f(x); }

constexpr int TOK_ROWS = 9216, ROWS_PER_B = 2304, CTXR = 256, LATR = 2048, DM = 4096, NMODC = 36864, DY = 3072;


#define EPI_PIN(x) do { asm volatile("" : "+v"(x)); __builtin_amdgcn_sched_barrier(0); } while (0)
struct EpiSwiGLU {
    static constexpr bool PERM = true, AFTER_DRAIN = false;
    bf16_t* H; int ldh;
    __device__ __forceinline__ void operator()(const f32x4 (&acc)[2][2][4][2], const Unit& u, int wr, int wc, int fr, int fq) const {
        size_t off = (size_t)(u.pm * BM + wr * 64 + fr) * ldh + u.pn * HALF + wc * 32 + 8 * fq;
#pragma unroll
        for (int ai = 0; ai < 2; ++ai) {
#pragma unroll
            for (int m = 0; m < 4; ++m) { EPI_PIN(off);
                const f32x4 a0 = acc[ai][0][m][0], a1 = acc[ai][0][m][1], b0 = acc[ai][1][m][0], b1 = acc[ai][1][m][1];
                u32x4 w; w.x = cvt_pk_bf16(silu_f(a0[0]) * b0[0], silu_f(a0[1]) * b0[1]); w.y = cvt_pk_bf16(silu_f(a0[2]) * b0[2], silu_f(a0[3]) * b0[3]);
                w.z = cvt_pk_bf16(silu_f(a1[0]) * b1[0], silu_f(a1[1]) * b1[1]); w.w = cvt_pk_bf16(silu_f(a1[2]) * b1[2], silu_f(a1[3]) * b1[3]);
                *(u32x4*)(H + off) = w; off += (size_t)16 * ldh; }
            off += (size_t)64 * ldh; }
    }
};

template <int BASE_MODE, int OUT_MODE> struct EpiResid {
    static constexpr bool PERM = true, AFTER_DRAIN = false;
    const float* x; const float* ctx; h16_t* hbuf; float* dout; const float* mod; int mchunk; float coef;
    __device__ __forceinline__ void operator()(const f32x4 (&acc)[2][2][4][2], const Unit& u, int wr, int wc, int fr, int fq) const {
        const int b = u.pm / 9, tt = u.pm - 9 * b; const bool isctx = (tt == 0);
        const float* basep = nullptr; const h16_t* baseh = nullptr; float* outp = nullptr; h16_t* outh = nullptr;
        if (BASE_MODE == 0) basep = isctx ? ctx + (size_t)b * CTXR * DM : x + ((size_t)b * LATR + (size_t)(tt - 1) * BM) * DM; else baseh = hbuf + (size_t)u.pm * BM * DM;
        if (OUT_MODE == 0) outh = hbuf + (size_t)u.pm * BM * DM; else outp = dout + ((size_t)b * LATR + (size_t)(tt - 1) * BM) * DM;
        const float* mv = mod + (size_t)(isctx ? 4 : b) * NMODC + (size_t)mchunk * DM;
        const int col0 = u.pn * BM + wc * 32 + 8 * fq;
        f32x4 g[2][2];
#pragma unroll
        for (int bj = 0; bj < 2; ++bj)
#pragma unroll
            for (int n = 0; n < 2; ++n) g[bj][n] = *(const f32x4*)(mv + col0 + bj * HALF + 4 * n) * coef;
        const size_t off0 = (size_t)(wr * 64 + fr) * DM + col0;
        f32x4 bs[4][2][2][2]; u32x4 bh[4][2][2];
#define ERES_LOAD(bt) _Pragma("unroll") for (int mm = 0; mm < 2; ++mm) { const size_t o = off0 + (size_t)(((bt) >> 1) * HALF + (((bt) & 1) * 2 + mm) * 16) * DM; \
            _Pragma("unroll") for (int bj = 0; bj < 2; ++bj) { if constexpr (BASE_MODE == 0) { _Pragma("unroll") for (int n = 0; n < 2; ++n) bs[bt][mm][bj][n] = *(const f32x4*)(basep + o + bj * HALF + 4 * n); } \
                else bh[bt][mm][bj] = *(const u32x4*)(baseh + o + bj * HALF); } }
#define ERES_DONE(bt) _Pragma("unroll") for (int mm = 0; mm < 2; ++mm) { const size_t o = off0 + (size_t)(((bt) >> 1) * HALF + (((bt) & 1) * 2 + mm) * 16) * DM; \
            _Pragma("unroll") for (int bj = 0; bj < 2; ++bj) { f32x4 b0, b1; \
                if constexpr (BASE_MODE == 0) { b0 = bs[bt][mm][bj][0]; b1 = bs[bt][mm][bj][1]; } \
                else { const u32x4 w = bh[bt][mm][bj]; const f32x2_cv p0 = unpk_f16(w.x), p1 = unpk_f16(w.y), p2 = unpk_f16(w.z), p3 = unpk_f16(w.w); b0 = (f32x4){p0.x, p0.y, p1.x, p1.y}; b1 = (f32x4){p2.x, p2.y, p3.x, p3.y}; } \
                const f32x4 r0 = b0 + g[bj][0] * acc[(bt) >> 1][bj][((bt) & 1) * 2 + mm][0], r1 = b1 + g[bj][1] * acc[(bt) >> 1][bj][((bt) & 1) * 2 + mm][1]; \
                if constexpr (OUT_MODE == 0) { u32x4 w; w.x = cvt_pk_f16(r0[0], r0[1]); w.y = cvt_pk_f16(r0[2], r0[3]); w.z = cvt_pk_f16(r1[0], r1[1]); w.w = cvt_pk_f16(r1[2], r1[3]); *(u32x4*)(outh + o + bj * HALF) = w; } \
                else { *(f32x4*)(outp + o + bj * HALF) = r0; *(f32x4*)(outp + o + bj * HALF + 4) = r1; } } }
        ERES_LOAD(0) __builtin_amdgcn_sched_barrier(0);
        ERES_LOAD(1) __builtin_amdgcn_sched_barrier(0);
        ERES_DONE(0) __builtin_amdgcn_sched_barrier(0);
        ERES_LOAD(2) __builtin_amdgcn_sched_barrier(0);
        ERES_DONE(1) __builtin_amdgcn_sched_barrier(0);
        ERES_LOAD(3) __builtin_amdgcn_sched_barrier(0);
        ERES_DONE(2) __builtin_amdgcn_sched_barrier(0);
        ERES_DONE(3)
#undef ERES_LOAD
#undef ERES_DONE
    }
};

struct EpiDown1 {
    static constexpr bool PERM = true, AFTER_DRAIN = false;
    EpiResid<0, 0> R; h16_t* part;
    __device__ __forceinline__ void operator()(const f32x4 (&acc)[2][2][4][2], const Unit& u, int wr, int wc, int fr, int fq) const {
        const int q = u.pn >> 8;
        if (q == 0) { R(acc, u, wr, wc, fr, fq); return; }
        size_t off = ((size_t)(q - 1) * 1024 + (size_t)(u.pm / 9) * CTXR + wr * 64 + fr) * DM + (u.pn & 255) * BM + wc * 32 + 8 * fq;
#pragma unroll
        for (int ai = 0; ai < 2; ++ai) {
#pragma unroll
            for (int m = 0; m < 4; ++m) { EPI_PIN(off);
#pragma unroll
                for (int bj = 0; bj < 2; ++bj) { const f32x4 v0 = acc[ai][bj][m][0], v1 = acc[ai][bj][m][1];
                    u32x4 w; w.x = cvt_pk_f16(v0[0], v0[1]); w.y = cvt_pk_f16(v0[2], v0[3]); w.z = cvt_pk_f16(v1[0], v1[1]); w.w = cvt_pk_f16(v1[2], v1[3]);
                    *(u32x4*)(part + off + bj * HALF) = w; }
                off += (size_t)16 * DM; }
            off += (size_t)64 * DM; }
    }
};

struct EpiWin {
    static constexpr bool PERM = true, AFTER_DRAIN = false;
    h16_t* UA; bf16_t* Q; h16_t* LFF; bf16_t* SGA; const float* lbt;
    static constexpr size_t QSTRIDE = (size_t)36 * 1048576 / 2, LFSTRIDE = (size_t)72 * 1048576 / 2, SGSTRIDE = (size_t)72 * 1048576 / 2;
    __device__ __forceinline__ void operator()(const f32x4 (&acc)[2][2][4][2], const Unit& u, int wr, int wc, int fr, int fq) const {
        const int pn = u.pn, row0 = u.pm * BM + wr * 64 + fr, cl = wc * 32 + 8 * fq;
        if (pn < 4) {
            size_t off = (size_t)row0 * 1024 + pn * BM + cl;
#pragma unroll
            for (int ai = 0; ai < 2; ++ai) {
#pragma unroll
                for (int m = 0; m < 4; ++m) { EPI_PIN(off);
#pragma unroll
                    for (int bj = 0; bj < 2; ++bj) { const f32x4 v0 = acc[ai][bj][m][0], v1 = acc[ai][bj][m][1];
                        u32x4 w; w.x = cvt_pk_f16(v0[0], v0[1]); w.y = cvt_pk_f16(v0[2], v0[3]); w.z = cvt_pk_f16(v1[0], v1[1]); w.w = cvt_pk_f16(v1[2], v1[3]);
                        *(u32x4*)(UA + off + bj * HALF) = w; }
                    off += (size_t)16 * 1024; }
                off += (size_t)64 * 1024; }
        } else if (pn < 12 || (pn >= 28 && pn < 44)) {
            const int sel = (pn < 12) ? 1 : ((pn >= 36) ? 2 : 0), cb = (pn - (sel == 1 ? 4 : (sel == 2 ? 36 : 28))) * BM;
            size_t off = (size_t)sel * QSTRIDE + (size_t)row0 * 2048 + cb + cl;
#pragma unroll
            for (int ai = 0; ai < 2; ++ai) {
#pragma unroll
                for (int m = 0; m < 4; ++m) { EPI_PIN(off);
#pragma unroll
                    for (int bj = 0; bj < 2; ++bj) { const f32x4 v0 = acc[ai][bj][m][0], v1 = acc[ai][bj][m][1];
                        u32x4 w; w.x = cvt_pk_bf16(v0[0], v0[1]); w.y = cvt_pk_bf16(v0[2], v0[3]); w.z = cvt_pk_bf16(v1[0], v1[1]); w.w = cvt_pk_bf16(v1[2], v1[3]);
                        *(u32x4*)(Q + off + bj * HALF) = w; }
                    off += (size_t)16 * 2048; }
                off += (size_t)64 * 2048; }
        } else if (pn < 28) {
            const int dirb = (pn >= 20) ? 1 : 0, cb = (pn - (dirb ? 20 : 12)) * BM;
            const float* lb = lbt + dirb * 2048 + cb + cl;
            f32x4 l[2][2];
#pragma unroll
            for (int bj = 0; bj < 2; ++bj)
#pragma unroll
                for (int n = 0; n < 2; ++n) l[bj][n] = *(const f32x4*)(lb + bj * HALF + 4 * n);
            size_t off = (size_t)dirb * LFSTRIDE + (size_t)row0 * 2048 + cb + cl;
#pragma unroll
            for (int ai = 0; ai < 2; ++ai) {
#pragma unroll
                for (int m = 0; m < 4; ++m) { EPI_PIN(off);
#pragma unroll
                    for (int bj = 0; bj < 2; ++bj) { f32x4 o[2];
#pragma unroll
                        for (int n = 0; n < 2; ++n) { f32x4 a = acc[ai][bj][m][n]; asm volatile("" : "+v"(a));
#pragma unroll
                            for (int j = 0; j < 4; ++j) { const float lbv = l[bj][n][j]; o[n][j] = __logf(lbv + (1.0f - lbv) * sigmoid_f(a[j])); } }
                        u32x4 w; w.x = cvt_pk_f16(o[0][0], o[0][1]); w.y = cvt_pk_f16(o[0][2], o[0][3]); w.z = cvt_pk_f16(o[1][0], o[1][1]); w.w = cvt_pk_f16(o[1][2], o[1][3]);
                        *(u32x4*)(LFF + off + bj * HALF) = w; }
                    off += (size_t)16 * 2048; }
                off += (size_t)64 * 2048; }
        } else {
            size_t off = (size_t)row0 * DM + (pn - 44) * HALF + cl;
#pragma unroll
            for (int ai = 0; ai < 2; ++ai) {
#pragma unroll
                for (int m = 0; m < 4; ++m) { EPI_PIN(off);
                    const f32x4 a0 = acc[ai][0][m][0], a1 = acc[ai][0][m][1], b0 = acc[ai][1][m][0], b1 = acc[ai][1][m][1];
                    u32x4 wa; wa.x = cvt_pk_bf16(sigmoid_f(a0[0]), sigmoid_f(a0[1])); wa.y = cvt_pk_bf16(sigmoid_f(a0[2]), sigmoid_f(a0[3]));
                    wa.z = cvt_pk_bf16(sigmoid_f(a1[0]), sigmoid_f(a1[1])); wa.w = cvt_pk_bf16(sigmoid_f(a1[2]), sigmoid_f(a1[3]));
                    *(u32x4*)(SGA + off) = wa;
#define GRATIO(bv, gw_) (sigmoid_f(bv) * __builtin_amdgcn_rcpf(fmaxf(gw_, 1e-20f)))
                    u32x4 wb; wb.x = cvt_pk_bf16(GRATIO(b0[0], bf_lo(wa.x)), GRATIO(b0[1], bf_hi(wa.x))); wb.y = cvt_pk_bf16(GRATIO(b0[2], bf_lo(wa.y)), GRATIO(b0[3], bf_hi(wa.y)));
                    wb.z = cvt_pk_bf16(GRATIO(b1[0], bf_lo(wa.z)), GRATIO(b1[1], bf_hi(wa.z))); wb.w = cvt_pk_bf16(GRATIO(b1[2], bf_lo(wa.w)), GRATIO(b1[3], bf_hi(wa.w)));
#undef GRATIO
                    *(u32x4*)(SGA + SGSTRIDE + off) = wb;
                    off += (size_t)16 * DM; }
                off += (size_t)64 * DM; }
        }
    }
};

struct EpiGlu {
    static constexpr bool PERM = true, AFTER_DRAIN = false;
    const bf16_t* GA; bf16_t* YA;
    __device__ __forceinline__ void operator()(const f32x4 (&acc)[2][2][4][2], const Unit& u, int wr, int wc, int fr, int fq) const {
        size_t off = (size_t)(u.pm * BM + wr * 64 + fr) * 1024 + u.pn * BM + wc * 32 + 8 * fq, offy = (size_t)(u.pm * BM + wr * 64 + fr) * DY + u.pn * BM + wc * 32 + 8 * fq;
#pragma unroll
        for (int ai = 0; ai < 2; ++ai) {
#pragma unroll
            for (int m = 0; m < 4; ++m) { EPI_PIN(off); EPI_PIN(offy);
#pragma unroll
                for (int bj = 0; bj < 2; ++bj) { const size_t o = off + bj * HALF;
                    const u32x4 gq = *(const u32x4*)(GA + o); const f32x4 v0 = acc[ai][bj][m][0], v1 = acc[ai][bj][m][1];
                    u32x4 w; w.x = cvt_pk_bf16(bf_lo(gq.x) * sigmoid_f(v0[0]), bf_hi(gq.x) * sigmoid_f(v0[1])); w.y = cvt_pk_bf16(bf_lo(gq.y) * sigmoid_f(v0[2]), bf_hi(gq.y) * sigmoid_f(v0[3]));
                    w.z = cvt_pk_bf16(bf_lo(gq.z) * sigmoid_f(v1[0]), bf_hi(gq.z) * sigmoid_f(v1[1])); w.w = cvt_pk_bf16(bf_lo(gq.w) * sigmoid_f(v1[2]), bf_hi(gq.w) * sigmoid_f(v1[3]));
                    *(u32x4*)(YA + offy + bj * HALF) = w; }
                off += (size_t)16 * 1024; offy += (size_t)16 * DY; }
            off += (size_t)64 * 1024; offy += (size_t)64 * DY; }
    }
};

struct EpiMerge {
    static constexpr bool PERM = true, AFTER_DRAIN = false; static constexpr int MID_T = 32;
    const bf16_t* SGA; const bf16_t* SGB; bf16_t* MRG;
    __device__ __forceinline__ void mid(f32x4 (&acc)[2][2][4][2], const Unit& u, int wr, int wc, int fr, int fq) const {
        size_t lo = (size_t)(u.pm * BM + wr * 64 + fr) * DM + u.pn * BM + wc * 32 + 8 * fq;
        u32x4 rq[2][4][2];
#pragma unroll
        for (int ai = 0; ai < 2; ++ai) {
#pragma unroll
            for (int m = 0; m < 4; ++m) { EPI_PIN(lo);
#pragma unroll
                for (int bj = 0; bj < 2; ++bj) rq[ai][m][bj] = *(const u32x4*)(SGB + lo + bj * HALF);
                lo += (size_t)16 * DM; }
            lo += (size_t)64 * DM; }
        __builtin_amdgcn_sched_barrier(0);
#pragma unroll
        for (int ai = 0; ai < 2; ++ai)
#pragma unroll
            for (int m = 0; m < 4; ++m)
#pragma unroll
                for (int bj = 0; bj < 2; ++bj) { const u32x4 q = rq[ai][m][bj];
                    f32x4 r0, r1; r0[0] = bf_lo(q.x); r0[1] = bf_hi(q.x); r0[2] = bf_lo(q.y); r0[3] = bf_hi(q.y); r1[0] = bf_lo(q.z); r1[1] = bf_hi(q.z); r1[2] = bf_lo(q.w); r1[3] = bf_hi(q.w);
                    acc[ai][bj][m][0] *= r0; acc[ai][bj][m][1] *= r1; }
    }
    __device__ __forceinline__ void operator()(const f32x4 (&acc)[2][2][4][2], const Unit& u, int wr, int wc, int fr, int fq) const {
        const size_t off0 = (size_t)(u.pm * BM + wr * 64 + fr) * DM + u.pn * BM + wc * 32 + 8 * fq;
        u32x4 gq[2][4][2];
        { size_t lo = off0;
#pragma unroll
          for (int ai = 0; ai < 2; ++ai) {
#pragma unroll
              for (int m = 0; m < 4; ++m) { EPI_PIN(lo);
#pragma unroll
                  for (int bj = 0; bj < 2; ++bj) gq[ai][m][bj] = *(const u32x4*)(SGA + lo + bj * HALF);
                  lo += (size_t)16 * DM; }
              lo += (size_t)64 * DM; } }
        __builtin_amdgcn_sched_barrier(0);
        size_t off = off0;
#pragma unroll
        for (int ai = 0; ai < 2; ++ai) {
#pragma unroll
            for (int m = 0; m < 4; ++m) { EPI_PIN(off);
#pragma unroll
                for (int bj = 0; bj < 2; ++bj) { const size_t o = off + bj * HALF;
                    const u32x4 ga = gq[ai][m][bj];
                    const f32x4 v0 = acc[ai][bj][m][0], v1 = acc[ai][bj][m][1];
                    u32x4 w; w.x = cvt_pk_bf16(fmaxf(bf_lo(ga.x), 1e-20f) * v0[0], fmaxf(bf_hi(ga.x), 1e-20f) * v0[1]); w.y = cvt_pk_bf16(fmaxf(bf_lo(ga.y), 1e-20f) * v0[2], fmaxf(bf_hi(ga.y), 1e-20f) * v0[3]);
                    w.z = cvt_pk_bf16(fmaxf(bf_lo(ga.z), 1e-20f) * v1[0], fmaxf(bf_hi(ga.z), 1e-20f) * v1[1]); w.w = cvt_pk_bf16(fmaxf(bf_lo(ga.w), 1e-20f) * v1[2], fmaxf(bf_hi(ga.w), 1e-20f) * v1[3]);
                    *(u32x4*)(MRG + o) = w; }
                off += (size_t)16 * DM; }
            off += (size_t)64 * DM; }
    }
};
template <class E, class = void> struct HasMid { static constexpr bool value = false; };
template <class E> struct HasMid<E, decltype((void)E::MID_T)> { static constexpr bool value = true; };

template <class Epi, class Sched, bool ALIGN_EPI = false, bool SP2 = false>
__device__ __forceinline__ void gemm_phase(PG8_LAS unsigned char* lds, const Gemm g, const Sched& S, const Epi& E) {
    int tid_ = threadIdx.x; asm volatile("" : "+v"(tid_));
    const int tid = tid_, wid = __builtin_amdgcn_readfirstlane(tid >> 6), lane = tid & 63, wr = wid >> 2, wc = wid & 3, fr = lane & 15, fq = lane >> 4;
    const int K = g.K, nt = K / BK, LD = g.LD ? g.LD : g.K;
    unsigned voffA[2], voffB[2];
#pragma unroll
    for (int i = 0; i < 2; ++i) { int R, C; stage_rc(tid * 16 + i * 8192, R, C); const int Rb = Epi::PERM ? ((R & ~31) + perm32(R & 31)) : R;
        voffA[i] = (unsigned)(R * LD + C) * 2u; voffB[i] = (unsigned)(Rb * LD + C) * 2u; }
    const size_t kstep = (size_t)(BK * 2);
    const size_t hstep = (size_t)HALF * LD * 2;
    const size_t tstep = 2 * hstep;
    const unsigned ldsw = (unsigned)wid * 1024u;
    const int aoff = lds_byte(wr * 64 + fr, fq * 8), boff = lds_byte(wc * 32 + fr, fq * 8);
#define PG8_SA(b, h) (((b) * 2 + (h)) * HTB)
#define PG8_SB(b, h) ((4 + (b) * 2 + (h)) * HTB)
#define PG8_STAGE(bufoff, gbase, voff) do { _Pragma("unroll") for (int _i = 0; _i < 2; ++_i) \
        __builtin_amdgcn_global_load_lds((const unsigned*)((const char*)(gbase) + (voff)[_i]), (PG8_LAS unsigned*)(lds + (bufoff) + ldsw + _i * 8192), 16, 0, 0); } while (0)
#define PG8_LDA(dst, b, h) do { _Pragma("unroll") for (int m = 0; m < 4; ++m) _Pragma("unroll") for (int k = 0; k < 2; ++k) dst[m][k] = *(const PG8_LAS bf16x8*)(lds + PG8_SA(b, h) + aoff + m * 2048 + k * 1024); } while (0)
#define PG8_LDB(dst, b, h) do { _Pragma("unroll") for (int n = 0; n < 2; ++n) _Pragma("unroll") for (int k = 0; k < 2; ++k) dst[n][k] = *(const PG8_LAS bf16x8*)(lds + PG8_SB(b, h) + boff + n * 2048 + k * 1024); } while (0)
#define PG8_MMA(ai, bj, At, Bt) do { __builtin_amdgcn_s_setprio(1); _Pragma("unroll") for (int m = 0; m < 4; ++m) _Pragma("unroll") for (int n = 0; n < 2; ++n) _Pragma("unroll") for (int k = 0; k < 2; ++k) \
        acc[ai][bj][m][n] = __builtin_amdgcn_mfma_f32_16x16x32_bf16(Bt[n][k], At[m][k], acc[ai][bj][m][n], 0, 0, 0); __builtin_amdgcn_s_setprio(0); } while (0)
#define PG8_WAIT_V(n) asm volatile("s_waitcnt vmcnt(" #n ")" ::: "memory")
#define PG8_WAIT_L(n) asm volatile("s_waitcnt lgkmcnt(" #n ")" ::: "memory")
#define PG8_BAR __builtin_amdgcn_s_barrier()
#define PG8_SCHED __builtin_amdgcn_sched_barrier(0)
    Unit cur, nxt; int ui = 0;
    if (!S.next(0, cur)) return;
    f32x4 acc[2][2][4][2];
#pragma unroll
    for (int a = 0; a < 2; ++a)
#pragma unroll
        for (int b = 0; b < 2; ++b)
#pragma unroll
            for (int m = 0; m < 4; ++m)
#pragma unroll
                for (int n = 0; n < 2; ++n) acc[a][b][m][n] = (f32x4){0.f, 0.f, 0.f, 0.f};
    bf16x8 At[4][2], B0[2][2], B1[2][2];
    const char* cA = (const char*)g.A + (size_t)cur.pm * tstep; const char* cB;
    if constexpr (Sched::SPLITK) { cA += (size_t)Sched::kt0(cur) * kstep; cB = (const char*)g.Bt + (size_t)(cur.pn & 255) * tstep + (size_t)Sched::kt0(cur) * kstep; } else cB = (const char*)g.Bt + (size_t)cur.pn * tstep;
    S.a_ready(cur);
    if constexpr (SP2) {
        PG8_STAGE(PG8_SB(0, 0), cB, voffB); PG8_STAGE(PG8_SB(0, 1), cB + hstep, voffB); PG8_STAGE(PG8_SA(0, 0), cA, voffA); PG8_STAGE(PG8_SA(0, 1), cA + hstep, voffA);
        if (wr == 1) PG8_BAR;
        PG8_WAIT_V(2); PG8_BAR;
        PG8_STAGE(PG8_SB(1, 0), cB + kstep, voffB); PG8_STAGE(PG8_SA(1, 0), cA + kstep, voffA); PG8_STAGE(PG8_SB(1, 1), cB + hstep + kstep, voffB);
        PG8_WAIT_V(6); PG8_BAR;
    } else {
        PG8_STAGE(PG8_SB(0, 0), cB, voffB); PG8_STAGE(PG8_SA(0, 0), cA, voffA); PG8_STAGE(PG8_SB(0, 1), cB + hstep, voffB); PG8_STAGE(PG8_SA(0, 1), cA + hstep, voffA);
        if (wr == 1) PG8_BAR;
        PG8_WAIT_V(4); PG8_BAR;
        PG8_STAGE(PG8_SB(1, 0), cB + kstep, voffB); PG8_STAGE(PG8_SA(1, 0), cA + kstep, voffA); PG8_STAGE(PG8_SB(1, 1), cB + hstep + kstep, voffB);
        PG8_WAIT_V(6); PG8_BAR;
    }
    for (;;) {
        const bool has_next = S.next(ui + 1, nxt);
        const char* nA = cA; const char* nB = cB; int cnt = nt;
        if constexpr (Sched::SPLITK) { if (has_next) { nA = (const char*)g.A + (size_t)nxt.pm * tstep + (size_t)Sched::kt0(nxt) * kstep; nB = (const char*)g.Bt + (size_t)(nxt.pn & 255) * tstep + (size_t)Sched::kt0(nxt) * kstep; } cnt = Sched::cnt(cur, nt); }
        else { if (has_next) { nA = (const char*)g.A + (size_t)nxt.pm * tstep; nB = (const char*)g.Bt + (size_t)nxt.pn * tstep; } }
        for (int t = 0; t < cnt; t += 2) {
            if constexpr (HasMid<Epi>::value) { if (t == Epi::MID_T) E.mid(acc, cur, wr, wc, fr, fq); }
            const bool last = (t == cnt - 2);
            const char* a1 = cA + (size_t)(t + 1) * kstep;
            const char* a2 = last ? nA : cA + (size_t)(t + 2) * kstep; const char* b2 = last ? nB : cB + (size_t)(t + 2) * kstep;
            const char* a3 = a2 + kstep; const char* b3 = b2 + kstep;
            if (last && has_next) S.a_ready(nxt);
            if constexpr (SP2) {
            PG8_LDB(B0, 0, 0); PG8_LDB(B1, 0, 1); PG8_SCHED; PG8_LDA(At, 0, 0); PG8_STAGE(PG8_SA(1, 1), a1 + hstep, voffA);
            PG8_WAIT_V(8); PG8_WAIT_L(0); PG8_BAR; PG8_MMA(0, 0, At, B0); PG8_MMA(0, 1, At, B1); PG8_BAR; PG8_SCHED;
            PG8_LDA(At, 0, 1); PG8_STAGE(PG8_SB(0, 0), b2, voffB); PG8_STAGE(PG8_SB(0, 1), b2 + hstep, voffB); PG8_STAGE(PG8_SA(0, 0), a2, voffA);
            PG8_WAIT_V(8); PG8_WAIT_L(0); PG8_BAR; PG8_MMA(1, 0, At, B0); PG8_MMA(1, 1, At, B1); PG8_BAR; PG8_SCHED;
            PG8_LDB(B0, 1, 0); PG8_LDB(B1, 1, 1); PG8_SCHED; PG8_LDA(At, 1, 0); PG8_STAGE(PG8_SA(0, 1), a2 + hstep, voffA);
            PG8_WAIT_V(8); PG8_WAIT_L(0); PG8_BAR; PG8_MMA(0, 0, At, B0); PG8_MMA(0, 1, At, B1); PG8_BAR; PG8_SCHED;
            PG8_LDA(At, 1, 1); PG8_STAGE(PG8_SB(1, 0), b3, voffB); PG8_STAGE(PG8_SB(1, 1), b3 + hstep, voffB); PG8_STAGE(PG8_SA(1, 0), a3, voffA);
            PG8_WAIT_V(8); PG8_WAIT_L(0); PG8_BAR; PG8_MMA(1, 0, At, B0); PG8_MMA(1, 1, At, B1); PG8_BAR; PG8_SCHED;
            } else {
            PG8_LDB(B0, 0, 0); PG8_SCHED; PG8_LDA(At, 0, 0); PG8_STAGE(PG8_SA(1, 1), a1 + hstep, voffA);
            PG8_WAIT_L(8); PG8_BAR; PG8_WAIT_L(0); PG8_MMA(0, 0, At, B0); PG8_BAR; PG8_SCHED;
            PG8_LDB(B1, 0, 1); PG8_STAGE(PG8_SB(0, 0), b2, voffB);
            PG8_BAR; PG8_WAIT_L(0); PG8_MMA(0, 1, At, B1); PG8_BAR;
            PG8_LDA(At, 0, 1); PG8_STAGE(PG8_SA(0, 0), a2, voffA);
            PG8_BAR; PG8_WAIT_L(0); PG8_MMA(1, 0, At, B0); PG8_BAR; PG8_SCHED;
            PG8_STAGE(PG8_SB(0, 1), b2 + hstep, voffB);
            PG8_WAIT_V(6); PG8_BAR; PG8_MMA(1, 1, At, B1); PG8_BAR;
            PG8_LDB(B0, 1, 0); PG8_SCHED; PG8_LDA(At, 1, 0); PG8_STAGE(PG8_SA(0, 1), a2 + hstep, voffA);
            PG8_WAIT_L(8); PG8_BAR; PG8_WAIT_L(0); PG8_MMA(0, 0, At, B0); PG8_BAR; PG8_SCHED;
            PG8_LDB(B1, 1, 1); PG8_STAGE(PG8_SB(1, 0), b3, voffB);
            PG8_BAR; PG8_WAIT_L(0); PG8_MMA(0, 1, At, B1); PG8_BAR;
            PG8_LDA(At, 1, 1); PG8_STAGE(PG8_SA(1, 0), a3, voffA);
            PG8_BAR; PG8_WAIT_L(0); PG8_MMA(1, 0, At, B0); PG8_BAR; PG8_SCHED;
            PG8_STAGE(PG8_SB(1, 1), b3 + hstep, voffB);
            PG8_WAIT_V(6); PG8_BAR; PG8_MMA(1, 1, At, B1); PG8_BAR;
            }
        }
        if constexpr (ALIGN_EPI) { if (wr == 0) PG8_BAR; }
        if constexpr (!Epi::AFTER_DRAIN) { E(acc, cur, wr, wc, fr, fq); S.done(cur); }
        if (!has_next) break;
#pragma unroll
        for (int a = 0; a < 2; ++a)
#pragma unroll
            for (int b = 0; b < 2; ++b)
#pragma unroll
                for (int m = 0; m < 4; ++m)
#pragma unroll
                    for (int n = 0; n < 2; ++n) acc[a][b][m][n] = (f32x4){0.f, 0.f, 0.f, 0.f};
        cur = nxt; cA = nA; cB = nB; ++ui;
        if constexpr (ALIGN_EPI) { if (wr == 1) PG8_BAR; }
    }
    PG8_WAIT_V(0);
    if constexpr (!ALIGN_EPI) { if (wr == 0) PG8_BAR; }
    PG8_BAR;
    if constexpr (Epi::AFTER_DRAIN) { E.fused(acc, cur, wr, wc, fr, fq, lds, wid, lane); S.done(cur); }
#undef PG8_SA
#undef PG8_SB
#undef PG8_STAGE
#undef PG8_LDA
#undef PG8_LDB
#undef PG8_MMA
#undef PG8_WAIT_V
#undef PG8_WAIT_L
#undef PG8_BAR
#undef PG8_SCHED
}
}


constexpr int NWAVES = 8;
constexpr int D_MODEL = 4096, BATCH = 4, SEQ = 2048, CTX_LEN = 256, D_FF = 11008, D_A = 1024, D_B = 2048, N_IN = 19456, N_MOD = 9;
constexpr int D_FFP = D_FF + 64;
constexpr int RT = 9216;
constexpr int RPB = 2304;
constexpr int S5_G = 64, S5_P = 64, S5_H = 16, NCHUNK = 36;
constexpr float EPS = 1e-6f;
constexpr int ADA_KS = 8, NMODC_ = 36864;

constexpr size_t MiB = 1u << 20;
constexpr size_t WS_CTL = 0, CTL_ZERO_BYTES = 1 * MiB;
constexpr size_t WS_MODP = 2 * MiB;
constexpr size_t WS_MOD = 14 * MiB;
constexpr size_t WS_TAB = 15 * MiB;
constexpr size_t WS_Y = 188 * MiB  , WS_WP = 656 * MiB  ;
constexpr size_t WS_W13A = 16 * MiB, WS_W2A = 814 * MiB, WS_WIN = 274 * MiB, WS_WGLU = 426 * MiB, WS_WPA = 428 * MiB, WS_WPB = 436 * MiB, WS_WOUT = 452 * MiB, WS_W13B = 484 * MiB, WS_W2B = 901 * MiB;
constexpr size_t WS_ZN = 742 * MiB, WS_HID = 2026 * MiB, WS_H = 1008 * MiB, WS_UA = 1152 * MiB, WS_Q = 1188 * MiB, WS_V = 1224 * MiB, WS_OG = 1260 * MiB, WS_LFF = 1296 * MiB, WS_LFB = 1368 * MiB;
constexpr size_t WS_SGA = 1440 * MiB, WS_SGB = 1512 * MiB, WS_XEND = 1584 * MiB, WS_GA = 1594 * MiB, WS_YA = 1612 * MiB, WS_OHG = 1630 * MiB, WS_YB = 1774 * MiB, WS_PT = 1810 * MiB, WS_MRG = 1954 * MiB, WS_END = 2221 * MiB;
static_assert(WS_W13A + (size_t)2 * D_FF * D_MODEL * 2 <= WS_WIN && WS_W2A + (size_t)D_MODEL * D_FFP * 2 <= WS_W2B && WS_W2B + (size_t)D_MODEL * D_FFP * 2 <= WS_H && WS_WIN + (size_t)N_IN * D_MODEL * 2 <= WS_WGLU, "ws map 1");
static_assert(WS_W13B + (size_t)2 * D_FF * D_MODEL * 2 <= WS_ZN && WS_ZN + (size_t)RT * D_MODEL * 2 <= WS_W2A && WS_MRG + (size_t)RT * D_MODEL * 2 <= WS_HID && WS_HID + (size_t)RT * D_FFP * 2 <= WS_END, "ws map 2");
static_assert(WS_H + (size_t)RT * D_MODEL * 4 <= WS_UA && WS_UA + (size_t)RT * D_A * 4 <= WS_Q && WS_Q + (size_t)RT * D_B * 2 <= WS_V && WS_LFF + (size_t)RT * D_B * 4 <= WS_LFB && WS_SGA + (size_t)RT * D_MODEL * 2 <= WS_SGB, "ws map 3");
static_assert(WS_XEND + (size_t)BATCH * 2 * S5_G * NCHUNK * S5_P * 8 <= WS_GA && WS_OHG + (size_t)2 * RT * D_B * 4 <= WS_YB && WS_PT + (size_t)RT * D_MODEL * 4 <= WS_MRG && WS_MRG + (size_t)RT * D_MODEL * 2 <= WS_END, "ws map 4");
static_assert(WS_MODP + (size_t)ADA_KS * 5 * 36864 * 4 <= WS_MOD, "ws map 5");
constexpr int CW_BAR = 4096;
constexpr int CW_QUEUE = 8192, CW_DONE = 8192 + 64, CW_QUEUE2 = 8192 + 128, CW_QUEUE3 = 8192 + 192;

constexpr int RING_OFF = 0, RING_BYTES = 131072;
constexpr int LDSCTL_OFF = RING_BYTES, MISC_OFF = LDSCTL_OFF + 320;
constexpr int LDS_BYTES = 147456;
static_assert(MISC_OFF + 128 <= LDS_BYTES, "LDS map");

#define GAS __attribute__((address_space(1)))
#define LAS __attribute__((address_space(3)))
typedef unsigned short bf16;
typedef unsigned v4u __attribute__((ext_vector_type(4)));
typedef unsigned v2u __attribute__((ext_vector_type(2)));
typedef float f32x4 __attribute__((ext_vector_type(4)));
typedef float f32x2 __attribute__((ext_vector_type(2)));
typedef short bf16x8 __attribute__((ext_vector_type(8)));
typedef GAS unsigned gu32;
#define RLX_AGENT __ATOMIC_RELAXED, __HIP_MEMORY_SCOPE_AGENT
#define LDS_WAIT() asm volatile("s_waitcnt lgkmcnt(0)" ::: "memory")
#define VM_WAIT() asm volatile("s_waitcnt vmcnt(0)" ::: "memory")
using pg8::cvt_pk_bf16; using pg8::bf_lo; using pg8::bf_hi; using pg8::sigmoid_f; using pg8::silu_f;
__device__ __forceinline__ float wave_sum(float v) {
#pragma unroll
    for (int o = 1; o < 64; o <<= 1) v += __shfl_xor(v, o);
    return v;
}

#define XB_TMO      128
#define XB_XCNT(j)  (256  + 64 * (j))
#define XB_XSUB(j)  (1280 + 64 * (j))
#define XB_XGEN(j)  (2304 + 64 * (j))
#define XB_TOP      3328
#define XB_TOPGEN   3392
#define XCD_BAR_WORDS 3456
#define XB_SPIN_CAP (1u << 18)

__device__ __forceinline__ unsigned xb_ld(unsigned* p)              { return __hip_atomic_load(p, __ATOMIC_RELAXED, __HIP_MEMORY_SCOPE_AGENT); }
__device__ __forceinline__ unsigned xb_add(unsigned* p, unsigned v) { return __hip_atomic_fetch_add(p, v, __ATOMIC_RELAXED, __HIP_MEMORY_SCOPE_AGENT); }
__device__ __forceinline__ unsigned xb_xcc_id() { return (unsigned)__builtin_amdgcn_s_getreg((3 << 11) | 20) & 0xFu; }
#define XB_SPIN(cond, bar) do { unsigned _sp = 0; while (cond) { __builtin_amdgcn_s_sleep(1); \
    if ((++_sp & 255u) == 0u) { if (xb_ld(&(bar)[XB_TMO])) break; if (_sp > XB_SPIN_CAP) { atomicAdd(&(bar)[XB_TMO], 1u); break; } } } } while (0)

struct XcdBarrier {
    unsigned* bar; unsigned x;
    volatile LAS unsigned* st;
};

__device__ __forceinline__ XcdBarrier xcd_barrier_post(unsigned* bar, volatile LAS unsigned* st) {
    XcdBarrier b; b.bar = bar; b.x = xb_xcc_id(); b.st = st;
    if (threadIdx.x == 0) (void)xb_add(&bar[XB_XCNT(b.x)], 1u);
    return b;
}
__device__ __forceinline__ void xcd_barrier_complete(unsigned* bar, unsigned x, unsigned& nloc, unsigned& nx) {
    const unsigned G = gridDim.x * gridDim.y * gridDim.z;
    unsigned sum, cnt, mine, sp = 0u;
    for (;;) {
        sum = 0u; cnt = 0u; mine = 0u;
#pragma unroll
        for (unsigned j = 0; j < 16; ++j) { const unsigned c = xb_ld(&bar[XB_XCNT(j)]); sum += c; cnt += (c > 0u) ? 1u : 0u; mine = (j == x) ? c : mine; }
        if (sum == G) break;
        __builtin_amdgcn_s_sleep(1);
        if ((++sp & 255u) == 0u) { if (xb_ld(&bar[XB_TMO])) break; if (sp > XB_SPIN_CAP) { atomicAdd(&bar[XB_TMO], 1u); break; } }
    }
    nloc = mine > 0u ? mine : 1u; nx = cnt > 0u ? cnt : 1u;
}

__device__ __forceinline__ void xcd_barrier(const XcdBarrier& b) {
    asm volatile("s_waitcnt vmcnt(0)" ::: "memory");
    __syncthreads();
    if (threadIdx.x == 0) {
        unsigned* bar = b.bar;
        __builtin_amdgcn_s_waitcnt(0);
        unsigned nloc = b.st[0], nx = b.st[1];
        if (nloc == 0u) { xcd_barrier_complete(bar, b.x, nloc, nx); b.st[0] = nloc; b.st[1] = nx; }
        const unsigned old = xb_add(&bar[XB_XSUB(b.x)], 1u);
        const unsigned gen = old / nloc;
        if (old + 1u == (gen + 1u) * nloc) {
            __builtin_amdgcn_fence(__ATOMIC_RELEASE, "agent");
            asm volatile("s_waitcnt vmcnt(0)" ::: "memory");
            const unsigned og = xb_add(&bar[XB_TOP], 1u);
            const unsigned tg = og / nx;
            if (og + 1u == (tg + 1u) * nx) xb_add(&bar[XB_TOPGEN], 1u);
            else XB_SPIN(xb_ld(&bar[XB_TOPGEN]) == tg, bar);
            __builtin_amdgcn_fence(__ATOMIC_ACQUIRE, "agent");
            xb_add(&bar[XB_XGEN(b.x)], 1u);
            asm volatile("s_waitcnt vmcnt(0)" ::: "memory");
        } else {
            XB_SPIN(xb_ld(&bar[XB_XGEN(b.x)]) == gen, bar);
            __builtin_amdgcn_fence(__ATOMIC_ACQUIRE, "agent");
            asm volatile("s_waitcnt vmcnt(0)" ::: "memory");
        }
    }
    __syncthreads();
}


struct Args { const float* in[31]; float* out; unsigned char* ws; };
enum { I_X = 0, I_C, I_CTX, I_CCTX, I_WADA, I_BADA, I_NORM1, I_W1A, I_W3A, I_W2A, I_NORMMIX, I_WIN, I_LAMRE, I_LAMIM, I_LOGDT, I_BRE, I_BIM, I_CRE, I_CIM, I_S5D, I_WGLU,
       I_LBLOG, I_HGNORM, I_WPA, I_WPB, I_WOUT, I_NORM2, I_W1B, I_W3B, I_W2B, I_NORMF };

struct ItemDesc { const float* src; bf16* dst; int N, K; };
__device__ __forceinline__ ItemDesc make_item(const float* W, int K, int N, bf16* WT, int kind, int item, int ld = 0) {
    if (ld) K = ld;
    const int nblk = N / 32, kb = item / nblk, nb = item - kb * nblk, k0 = 64 * kb, n0 = 32 * nb;
    int drow = (kind == 0) ? n0 : ((n0 >> 7) * 256 + (n0 & 127) + (kind == 2 ? 128 : 0));
    if (kind == 3) { const int st = n0 >> 8; const int dt = (st < 4) ? st : (st < 12) ? st + 24 : (st < 36) ? st - 8 : st;
        drow = dt * 256 + (n0 & 255);
        if (st >= 44) { const int isb = (st >= 60) ? 1 : 0, c = (st - 44 - 16 * isb) * 256 + (n0 & 255); drow = (44 + (c >> 7)) * 256 + (c & 127) + 128 * isb; } }
    ItemDesc d; d.src = W + (size_t)k0 * N + n0; d.dst = WT + (size_t)drow * K + k0; d.N = N; d.K = K; return d;
}
__device__ __forceinline__ void item_load(const ItemDesc& d, f32x4 (&v)[8], int lane) {
    const float* p = d.src + (size_t)(lane >> 3) * d.N + 4 * (lane & 7);
#pragma unroll
    for (int i = 0; i < 8; ++i) v[i] = __builtin_nontemporal_load((const GAS f32x4*)(p + (size_t)(8 * i) * d.N));
}
__device__ __forceinline__ void item_store(const ItemDesc& d, const f32x4 (&v)[8], LAS float* scr, int lane) {
#pragma unroll
    for (int i = 0; i < 8; ++i) { LAS float* s = scr + (8 * i + (lane >> 3)) * 33 + 4 * (lane & 7); s[0] = v[i].x; s[1] = v[i].y; s[2] = v[i].z; s[3] = v[i].w; }
    LDS_WAIT(); asm volatile("" ::: "memory");
    const int c = lane & 7;
#pragma unroll
    for (int j = 0; j < 4; ++j) { const int n = (lane >> 3) + 8 * j; const LAS float* s = scr + (8 * c) * 33 + n;
        v4u o; o.x = cvt_pk_bf16(s[0 * 33], s[1 * 33]); o.y = cvt_pk_bf16(s[2 * 33], s[3 * 33]); o.z = cvt_pk_bf16(s[4 * 33], s[5 * 33]); o.w = cvt_pk_bf16(s[6 * 33], s[7 * 33]);
        __builtin_nontemporal_store(o, (GAS v4u*)(d.dst + (size_t)n * d.K + 8 * c)); }
    LDS_WAIT(); asm volatile("" ::: "memory");
}
constexpr int IT_FF = (D_MODEL / 64) * (D_FF / 32), IT_WIN = (D_MODEL / 64) * (N_IN / 32), IT_GLU = (D_A / 64) * (D_A / 32), IT_PA = (D_A / 64) * (D_MODEL / 32), IT_PB = (D_B / 64) * (D_MODEL / 32), IT_OUT = (D_MODEL / 64) * (D_MODEL / 32);
constexpr int T_ITEMS = 6 * IT_FF + IT_WIN + IT_GLU + IT_PA + IT_PB + IT_OUT;
constexpr int ADA_TASKS = 144 * ADA_KS, ADA_KLEN = D_MODEL / ADA_KS;

__device__ __forceinline__ void p0_ada_task(const float* cvec, const float* cctx, const float* wada, float* modp, int task, LAS float* scr, int lane) {
    const int cg = task % 144, ks = task / 144, k0 = ks * ADA_KLEN, n0 = cg * 256 + lane * 4;
#pragma unroll
    for (int i = 0; i < 5; ++i)
        for (int kk = lane; kk < ADA_KLEN; kk += 64) { const float v = (i < 4) ? cvec[i * D_MODEL + k0 + kk] : cctx[k0 + kk]; scr[kk * 8 + i] = silu_f(v); }
    LDS_WAIT(); asm volatile("" ::: "memory");
    f32x4 a0 = {0.f, 0.f, 0.f, 0.f}, a1 = a0, a2 = a0, a3 = a0, a4 = a0;
    const float* wp = wada + (size_t)k0 * NMODC_ + n0;
#pragma unroll 32
    for (int k = 0; k < ADA_KLEN; ++k) {
        const f32x4 w = __builtin_nontemporal_load((const GAS f32x4*)(wp + (size_t)k * NMODC_));
        const f32x4 s = *(const LAS f32x4*)(scr + k * 8); const float s4 = scr[k * 8 + 4];
        a0 += w * s[0]; a1 += w * s[1]; a2 += w * s[2]; a3 += w * s[3]; a4 += w * s4;
    }
    float* o = modp + (size_t)ks * 5 * NMODC_ + n0;
    *(f32x4*)(o) = a0; *(f32x4*)(o + NMODC_) = a1; *(f32x4*)(o + 2 * NMODC_) = a2; *(f32x4*)(o + 3 * NMODC_) = a3; *(f32x4*)(o + 4 * NMODC_) = a4;
    LDS_WAIT(); asm volatile("" ::: "memory");
}

__device__ __forceinline__ void norm_mod_row(const float* src, const float* gain, const float* shift, const float* scale, bf16* dst, int lane) {
    const GAS f32x4* xr = (const GAS f32x4*)src + lane;
    f32x4 v[16]; float s = 0.f;
#pragma unroll
    for (int j = 0; j < 16; ++j) { v[j] = xr[64 * j]; s += (v[j].x * v[j].x + v[j].y * v[j].y) + (v[j].z * v[j].z + v[j].w * v[j].w); }
    const float rstd = 1.0f / sqrtf(wave_sum(s) * (1.f / D_MODEL) + EPS);
    const GAS f32x4* gp = (const GAS f32x4*)gain + lane; const GAS f32x4* hp = (const GAS f32x4*)shift + lane; const GAS f32x4* cp = (const GAS f32x4*)scale + lane;
    GAS v2u* o8 = (GAS v2u*)dst + lane;
#pragma unroll
    for (int j = 0; j < 16; ++j) { const f32x4 g = gp[64 * j], sh = hp[64 * j], sc = cp[64 * j]; const f32x4 y = (v[j] * rstd * g) * (sc + 1.0f) + sh;
        v2u w; w.x = cvt_pk_bf16(y.x, y.y); w.y = cvt_pk_bf16(y.z, y.w); o8[64 * j] = w; }
}
__device__ __forceinline__ void norm_mod_row_h(const pg8::h16_t* src, const float* gain, const float* shift, const float* scale, bf16* dst, int lane) {
    const GAS v2u* xr = (const GAS v2u*)src + lane;
    f32x4 v[16]; float s = 0.f;
#pragma unroll
    for (int j = 0; j < 16; ++j) { const v2u w = xr[64 * j]; const f32x2 a = pg8::unpk_f16(w.x), c = pg8::unpk_f16(w.y); v[j] = (f32x4){a.x, a.y, c.x, c.y};
        s += (v[j].x * v[j].x + v[j].y * v[j].y) + (v[j].z * v[j].z + v[j].w * v[j].w); }
    const float rstd = 1.0f / sqrtf(wave_sum(s) * (1.f / D_MODEL) + EPS);
    const GAS f32x4* gp = (const GAS f32x4*)gain + lane; const GAS f32x4* hp = (const GAS f32x4*)shift + lane; const GAS f32x4* cp = (const GAS f32x4*)scale + lane;
    GAS v2u* o8 = (GAS v2u*)dst + lane;
#pragma unroll
    for (int j = 0; j < 16; ++j) { const f32x4 g = gp[64 * j], sh = hp[64 * j], sc = cp[64 * j]; const f32x4 y = (v[j] * rstd * g) * (sc + 1.0f) + sh;
        v2u w; w.x = cvt_pk_bf16(y.x, y.y); w.y = cvt_pk_bf16(y.z, y.w); o8[64 * j] = w; }
}
__device__ __forceinline__ void norm_mod_row_part(const float* base, const pg8::h16_t* part, const float* m2, const float* gain, const float* shift, const float* scale, bf16* dst, int lane) {
    const GAS f32x4* xr = (const GAS f32x4*)base + lane; const GAS v2u* pr = (const GAS v2u*)part + lane; const GAS f32x4* mr = (const GAS f32x4*)m2 + lane;
    constexpr size_t QS = (size_t)BATCH * CTX_LEN * D_MODEL / 4;
    f32x4 v[16]; float s = 0.f;
#pragma unroll
    for (int j = 0; j < 16; ++j) { f32x4 p = (f32x4){0.f, 0.f, 0.f, 0.f};
#pragma unroll
        for (int k = 0; k < 4; ++k) { const v2u w = pr[k * QS + 64 * j]; const f32x2 a = pg8::unpk_f16(w.x), c = pg8::unpk_f16(w.y); p += (f32x4){a.x, a.y, c.x, c.y}; }
        v[j] = xr[64 * j] + (mr[64 * j] * 0.5f) * p; s += (v[j].x * v[j].x + v[j].y * v[j].y) + (v[j].z * v[j].z + v[j].w * v[j].w);
        if ((j & 3) == 3) asm volatile("" ::: "memory"); }
    const float rstd = 1.0f / sqrtf(wave_sum(s) * (1.f / D_MODEL) + EPS);
    const GAS f32x4* gp = (const GAS f32x4*)gain + lane; const GAS f32x4* hp = (const GAS f32x4*)shift + lane; const GAS f32x4* cp = (const GAS f32x4*)scale + lane;
    GAS v2u* o8 = (GAS v2u*)dst + lane;
#pragma unroll
    for (int j = 0; j < 16; ++j) { const f32x4 g = gp[64 * j], sh = hp[64 * j], sc = cp[64 * j]; const f32x4 y = (v[j] * rstd * g) * (sc + 1.0f) + sh;
        v2u w; w.x = cvt_pk_bf16(y.x, y.y); w.y = cvt_pk_bf16(y.z, y.w); o8[64 * j] = w; }
}
__device__ __forceinline__ void norm_final_row_h(const pg8::h16_t* src, float* dst, const float* gain, int lane) {
    const GAS v2u* xr = (const GAS v2u*)src + lane; GAS f32x4* o = (GAS f32x4*)dst + lane;
    f32x4 v[16]; float s = 0.f;
#pragma unroll
    for (int j = 0; j < 16; ++j) { const v2u w = xr[64 * j]; const f32x2 a = pg8::unpk_f16(w.x), c = pg8::unpk_f16(w.y); v[j] = (f32x4){a.x, a.y, c.x, c.y};
        s += (v[j].x * v[j].x + v[j].y * v[j].y) + (v[j].z * v[j].z + v[j].w * v[j].w); }
    const float rstd = 1.0f / sqrtf(wave_sum(s) * (1.f / D_MODEL) + EPS);
    const GAS f32x4* gp = (const GAS f32x4*)gain + lane;
#pragma unroll
    for (int j = 0; j < 16; ++j) o[64 * j] = v[j] * rstd * gp[64 * j];
}
__device__ __forceinline__ void norm_final_row(float* io, const float* gain, int lane) {
    GAS f32x4* xr = (GAS f32x4*)io + lane;
    f32x4 v[16]; float s = 0.f;
#pragma unroll
    for (int j = 0; j < 16; ++j) { v[j] = xr[64 * j]; s += (v[j].x * v[j].x + v[j].y * v[j].y) + (v[j].z * v[j].z + v[j].w * v[j].w); }
    const float rstd = 1.0f / sqrtf(wave_sum(s) * (1.f / D_MODEL) + EPS);
    const GAS f32x4* gp = (const GAS f32x4*)gain + lane;
#pragma unroll
    for (int j = 0; j < 16; ++j) xr[64 * j] = v[j] * rstd * gp[64 * j];
}

__device__ __forceinline__ void s5_table_entry(const float* lam_re, const float* lam_im, const float* log_dt, float* TAB, int idx) {
    const int dg = idx >> 6;
    const double dt = exp((double)log_dt[dg]);
    const double lr = (double)lam_re[idx], li = (double)lam_im[idx];
    const double mag = exp(lr * dt), th = li * dt;
    const double TWO_PI = 6.283185307179586476925286766559;
    const double rr = th - TWO_PI * rint(th * (1.0 / TWO_PI));
    const double abr = mag * cos(rr), abi = mag * sin(rr);
    const double den = lr * lr + li * li, nr = abr - 1.0;
    const double kr = (nr * lr + abi * li) / den, ki = (abi * lr - nr * li) / den;
    double pr = abr, pi = abi;
#pragma unroll
    for (int i = 0; i < 6; ++i) { const double tr = pr * pr - pi * pi, ti = 2.0 * pr * pi; pr = tr; pi = ti; }
    float* o = TAB + (size_t)idx * 8;
    o[0] = (float)abr; o[1] = (float)abi; o[2] = (float)kr; o[3] = (float)ki; o[4] = (float)pr; o[5] = (float)pi; o[6] = 0.f; o[7] = 0.f;
}
#define S5_LOAD_BK(d_, g_, p_) \
    float ar, ai, a64r, a64i; f32x2 bk2[16]; \
    { const f32x4 t0 = *(const f32x4*)(TAB + ((size_t)(((d_) * 64 + (g_)) * 64 + (p_))) * 8), t1 = *(const f32x4*)(TAB + ((size_t)(((d_) * 64 + (g_)) * 64 + (p_))) * 8 + 4); \
      ar = t0[0]; ai = t0[1]; a64r = t1[0]; a64i = t1[1]; const float kr = t0[2], ki = t0[3]; \
      const f32x4* br = (const f32x4*)(b_re + ((size_t)((g_) * 64 + (p_))) * 16); const f32x4* bi = (const f32x4*)(b_im + ((size_t)((g_) * 64 + (p_))) * 16); \
      _Pragma("unroll") for (int q = 0; q < 4; ++q) { const f32x4 x = br[q], y = bi[q]; \
          _Pragma("unroll") for (int j = 0; j < 4; ++j) { bk2[4 * q + j] = (f32x2){kr * x[j] - ki * y[j], kr * y[j] + ki * x[j]}; } } }
#define S5_STEP(tl_) { const f32x4 u0 = UL[(tl_) * 4 + 0], u1 = UL[(tl_) * 4 + 1], u2 = UL[(tl_) * 4 + 2], u3 = UL[(tl_) * 4 + 3]; \
        f32x2 e0 = bk2[0] * u0[0], e1 = bk2[1] * u0[1]; \
        e0 += bk2[2] * u0[2]; e1 += bk2[3] * u0[3]; e0 += bk2[4] * u1[0]; e1 += bk2[5] * u1[1]; e0 += bk2[6] * u1[2]; e1 += bk2[7] * u1[3]; \
        e0 += bk2[8] * u2[0]; e1 += bk2[9] * u2[1]; e0 += bk2[10] * u2[2]; e1 += bk2[11] * u2[3]; e0 += bk2[12] * u3[0]; e1 += bk2[13] * u3[1]; e0 += bk2[14] * u3[2]; e1 += bk2[15] * u3[3]; \
        e0 += e1; \
        const float nr_ = ar * xr - ai * xi + e0.x, ni_ = ar * xi + ai * xr + e0.y; xr = nr_; xi = ni_; }

typedef float f32x16 __attribute__((ext_vector_type(16)));
__device__ __forceinline__ void s5_make_ef(bf16x8 (&Ef)[4], const float* TAB, const float* b_re, const float* b_im, int d, int g, int lane) {
    const int half = lane >> 5, l31 = lane & 31;
#pragma unroll
    for (int s2 = 0; s2 < 2; ++s2) { const int ps = 32 * s2 + l31;
        const f32x4 tt = *(const f32x4*)(TAB + ((size_t)((d * 64 + g) * 64 + ps)) * 8); const float kr = tt[2], ki = tt[3];
        const float* brp = b_re + ((size_t)(g * 64 + ps)) * 16 + 8 * half; const float* bip = b_im + ((size_t)(g * 64 + ps)) * 16 + 8 * half;
        const f32x4 r0 = *(const f32x4*)brp, r1 = *(const f32x4*)(brp + 4), i0 = *(const f32x4*)bip, i1 = *(const f32x4*)(bip + 4);
        v4u wr_, wi_;
        wr_.x = cvt_pk_bf16(kr * r0[0] - ki * i0[0], kr * r0[1] - ki * i0[1]); wr_.y = cvt_pk_bf16(kr * r0[2] - ki * i0[2], kr * r0[3] - ki * i0[3]);
        wr_.z = cvt_pk_bf16(kr * r1[0] - ki * i1[0], kr * r1[1] - ki * i1[1]); wr_.w = cvt_pk_bf16(kr * r1[2] - ki * i1[2], kr * r1[3] - ki * i1[3]);
        wi_.x = cvt_pk_bf16(kr * i0[0] + ki * r0[0], kr * i0[1] + ki * r0[1]); wi_.y = cvt_pk_bf16(kr * i0[2] + ki * r0[2], kr * i0[3] + ki * r0[3]);
        wi_.z = cvt_pk_bf16(kr * i1[0] + ki * r1[0], kr * i1[1] + ki * r1[1]); wi_.w = cvt_pk_bf16(kr * i1[2] + ki * r1[2], kr * i1[3] + ki * r1[3]);
        Ef[s2] = __builtin_bit_cast(bf16x8, wr_); Ef[2 + s2] = __builtin_bit_cast(bf16x8, wi_); }
}
#define S5_E_TILES(blk_) \
    const int tk_ = 16 * (blk_) + (l31 & 3) + 4 * (l31 >> 3); \
    const f32x4 ua_ = UL[tk_ * 4 + 2 * half], ub_ = UL[tk_ * 4 + 2 * half + 1]; \
    v4u aw_; aw_.x = cvt_pk_bf16(ua_[0], ua_[1]); aw_.y = cvt_pk_bf16(ua_[2], ua_[3]); aw_.z = cvt_pk_bf16(ub_[0], ub_[1]); aw_.w = cvt_pk_bf16(ub_[2], ub_[3]); \
    const bf16x8 Af_ = __builtin_bit_cast(bf16x8, aw_); \
    f32x16 zero16_; _Pragma("unroll") for (int q_ = 0; q_ < 16; ++q_) zero16_[q_] = 0.f; \
    const f32x16 D0 = __builtin_amdgcn_mfma_f32_32x32x16_bf16(Af_, Ef[0], zero16_, 0, 0, 0), D1 = __builtin_amdgcn_mfma_f32_32x32x16_bf16(Af_, Ef[1], zero16_, 0, 0, 0); \
    const f32x16 D2 = __builtin_amdgcn_mfma_f32_32x32x16_bf16(Af_, Ef[2], zero16_, 0, 0, 0), D3 = __builtin_amdgcn_mfma_f32_32x32x16_bf16(Af_, Ef[3], zero16_, 0, 0, 0);

__device__ __forceinline__ void s5_pass_a(LAS unsigned char* scr, int task, const float* TAB, const float* b_re, const float* b_im, const pg8::h16_t* UA, float* XEND, int lane) {
    const int c = task % NCHUNK; int r = task / NCHUNK; const int g = r & 63; r >>= 6; const int d = r & 1; const int b = r >> 1;
    const int half = lane >> 5, l31 = lane & 31;
    const f32x4 t0 = *(const f32x4*)(TAB + ((size_t)((d * 64 + g) * 64 + lane)) * 8); const float ar = t0[0], ai = t0[1];
    bf16x8 Ef[4]; s5_make_ef(Ef, TAB, b_re, b_im, d, g, lane);
    const int j0 = 64 * c;
    const int trow = (d == 0) ? (j0 + lane) : ((j0 < CTX_LEN ? 255 - j0 : 2559 - j0) - lane);
    const v4u* up = (const v4u*)(UA + ((size_t)(b * RPB + trow)) * D_A + g * 16);
    LAS f32x4* UL = (LAS f32x4*)scr;
#pragma unroll
    for (int q = 0; q < 2; ++q) { const v4u w = up[q]; const f32x2 p0 = pg8::unpk_f16(w.x), p1 = pg8::unpk_f16(w.y), p2 = pg8::unpk_f16(w.z), p3 = pg8::unpk_f16(w.w);
        UL[lane * 4 + 2 * q] = (f32x4){p0.x, p0.y, p1.x, p1.y}; UL[lane * 4 + 2 * q + 1] = (f32x4){p2.x, p2.y, p3.x, p3.y}; }
    LDS_WAIT(); asm volatile("" ::: "memory");
    float xr = 0.f, xi = 0.f;
#pragma unroll
    for (int i = 0; i < 4; ++i) {
        S5_E_TILES(i)
#pragma unroll
        for (int ss = 0; ss < 16; ++ss) { const float er = half ? D1[ss] : D0[ss], ei = half ? D3[ss] : D2[ss];
            const float nr_ = ar * xr - ai * xi + er, ni_ = ar * xi + ai * xr + ei; xr = nr_; xi = ni_; }
    }
    __hip_atomic_store((unsigned long long*)(XEND + ((size_t)task * 64 + lane) * 2), ((unsigned long long)__float_as_uint(xi) << 32) | (unsigned long long)__float_as_uint(xr), __ATOMIC_RELAXED, __HIP_MEMORY_SCOPE_AGENT);
    LDS_WAIT(); asm volatile("" ::: "memory");
}

__device__ __forceinline__ float gelu_tanh_f(float y) { const float z = 1.5957691216057308f * (y + 0.044715f * y * y * y); return y * sigmoid_f(z); }
__device__ __forceinline__ unsigned short f2bf_rne(float f) { unsigned u = __float_as_uint(f); return (unsigned short)((u + 0x7fffu + ((u >> 16) & 1u)) >> 16); }

__device__ __forceinline__ void s5_pass_c(LAS unsigned char* scr, int task, const float* TAB, const float* b_re, const float* b_im, const float* c_re, const float* c_im, const float* dskip,
                                          const pg8::h16_t* UA, const float* XEND, bf16* GA, int lane) {
    const int c = 4 + (task & 31), g = (task >> 5) & 63, b = task >> 11;
    const int r16 = lane & 15, q4 = lane >> 4;
    LAS f32x4* UL = (LAS f32x4*)scr;
    LAS unsigned char* XB = scr + 4096;
    const int row0 = b * RPB + 64 * c;
    { const v4u* up = (const v4u*)(UA + ((size_t)(row0 + lane)) * D_A + g * 16);
#pragma unroll
      for (int q = 0; q < 2; ++q) { const v4u w = up[q]; const f32x2 p0 = pg8::unpk_f16(w.x), p1 = pg8::unpk_f16(w.y), p2 = pg8::unpk_f16(w.z), p3 = pg8::unpk_f16(w.w);
          UL[lane * 4 + 2 * q] = (f32x4){p0.x, p0.y, p1.x, p1.y}; UL[lane * 4 + 2 * q + 1] = (f32x4){p2.x, p2.y, p3.x, p3.y}; } }
    bf16x8 Cf[4];
#pragma unroll
    for (int ks = 0; ks < 4; ++ks) { const int k0 = 32 * ks + 8 * q4; const bool im = (ks >= 2);
        const float* src = (im ? c_im : c_re) + ((size_t)(g * 16 + r16)) * 64 + (k0 & 63); const float sg = im ? -1.f : 1.f;
        const f32x4 a = *(const f32x4*)src, bb = *(const f32x4*)(src + 4);
        v4u w; w.x = cvt_pk_bf16(sg * a[0], sg * a[1]); w.y = cvt_pk_bf16(sg * a[2], sg * a[3]); w.z = cvt_pk_bf16(sg * bb[0], sg * bb[1]); w.w = cvt_pk_bf16(sg * bb[2], sg * bb[3]);
        Cf[ks] = __builtin_bit_cast(bf16x8, w); }
    f32x4 ya[4];
#pragma unroll
    for (int i = 0; i < 4; ++i) ya[i] = (f32x4){0.f, 0.f, 0.f, 0.f};
    LDS_WAIT(); asm volatile("" ::: "memory");
    const int half = lane >> 5, l31 = lane & 31;
#pragma unroll
    for (int d = 0; d < 2; ++d) {
        float ar, ai, a64r, a64i;
        { const f32x4 t0 = *(const f32x4*)(TAB + ((size_t)((d * 64 + g) * 64 + lane)) * 8), t1 = *(const f32x4*)(TAB + ((size_t)((d * 64 + g) * 64 + lane)) * 8 + 4);
          ar = t0[0]; ai = t0[1]; a64r = t1[0]; a64i = t1[1]; }
        bf16x8 Ef[4]; s5_make_ef(Ef, TAB, b_re, b_im, d, g, lane);
        const int nprev = (d == 0) ? c : (39 - c);
        const f32x2* xe = (const f32x2*)(XEND + ((size_t)(((b * 2 + d) * 64 + g) * NCHUNK)) * 128) + lane;
        float xr = 0.f, xi = 0.f;
#pragma unroll 8
        for (int cc = 0; cc < nprev; ++cc) { const f32x2 e = xe[cc * 64]; const float nr_ = a64r * xr - a64i * xi + e.x, ni_ = a64r * xi + a64i * xr + e.y; xr = nr_; xi = ni_; }
#pragma unroll
        for (int ii = 0; ii < 4; ++ii) {
            const int i = (d == 0) ? ii : (3 - ii);
            S5_E_TILES(i)
#pragma unroll
            for (int ss = 0; ss < 16; ++ss) {
                const int s16 = (d == 0) ? ss : (15 - ss);
                const float er = half ? D1[s16] : D0[s16], ei = half ? D3[s16] : D2[s16];
                const float nr_ = ar * xr - ai * xi + er, ni_ = ar * xi + ai * xr + ei; xr = nr_; xi = ni_;
                *(LAS unsigned short*)(XB + s16 * 272 + 2 * lane) = f2bf_rne(xr);
                *(LAS unsigned short*)(XB + s16 * 272 + 128 + 2 * lane) = f2bf_rne(xi);
            }
            LDS_WAIT(); asm volatile("" ::: "memory");
#pragma unroll
            for (int ks = 0; ks < 4; ++ks) { const bf16x8 Bf = *(const LAS bf16x8*)(XB + r16 * 272 + 64 * ks + 16 * q4);
                ya[i] = __builtin_amdgcn_mfma_f32_16x16x32_bf16(Cf[ks], Bf, ya[i], 0, 0, 0); }
            LDS_WAIT(); asm volatile("" ::: "memory");
        }
    }
    const f32x4 dk = *(const f32x4*)(dskip + g * 16 + 4 * q4);
#pragma unroll
    for (int i = 0; i < 4; ++i) { const int tl = 16 * i + r16; const f32x4 u4 = UL[tl * 4 + q4];
        const f32x4 y = ya[i] + dk * u4;
        v2u w; w.x = cvt_pk_bf16(gelu_tanh_f(y[0]), gelu_tanh_f(y[1])); w.y = cvt_pk_bf16(gelu_tanh_f(y[2]), gelu_tanh_f(y[3]));
        *(GAS v2u*)(GA + ((size_t)(row0 + tl)) * D_A + g * 16 + 4 * q4) = w; }
    LDS_WAIT(); asm volatile("" ::: "memory");
}

__device__ __forceinline__ int hg_row(int b, int dir, int j) {
    const int jf = dir ? (j < CTX_LEN ? (CTX_LEN - 1 - j) : (2559 - j)) : j;
    int t = jf; if (jf >= CTX_LEN) { const int jj = jf - CTX_LEN; t = CTX_LEN + (jj & 31) * 64 + (jj >> 5); }
    return b * RPB + t;
}
constexpr int HG_TOT = 0, HG_DEC = 8192, HG_ROWS = 8704, HG_QS = 9216, HG_KS = 26624, HG_QB = 44032, HG_K2T = 61440, HG_VT = 79872, HG_P = 98304;
__device__ __forceinline__ void hgrn2_unit(LAS unsigned char* lds, int unit, const bf16* Q, const bf16* V, const pg8::h16_t* LFF, const pg8::h16_t* LFB, bf16* OHG, int tid) {
    const int b = unit >> 5, head = (unit >> 1) & 15, dir = unit & 1;
    const pg8::h16_t* LF = dir ? LFB : LFF;
    bf16* O = OHG + (size_t)dir * RT * D_B;
    const int lane = tid & 63, w = __builtin_amdgcn_readfirstlane(tid >> 6), kp = lane, tq = w, r16 = lane & 15, q4 = lane >> 4;
    const int colb = head * 128;
    LAS float* TOT = (LAS float*)(lds + HG_TOT); LAS float* DEC = (LAS float*)(lds + HG_DEC); LAS int* ROWS = (LAS int*)(lds + HG_ROWS); LAS float* EREF = (LAS float*)(lds + HG_QB);
    f32x4 S[8];
#pragma unroll
    for (int i = 0; i < 8; ++i) S[i] = (f32x4){0.f, 0.f, 0.f, 0.f};
    f32x2 lf[8]; unsigned qv[8], vv[8]; int rows[8];
#pragma unroll
    for (int i = 0; i < 8; ++i) { rows[i] = hg_row(b, dir, 8 * tq + i); const size_t o = (size_t)rows[i] * D_B + colb + 2 * kp;
        lf[i] = pg8::unpk_f16(*(const GAS unsigned*)(LF + o)); qv[i] = *(const GAS unsigned*)(Q + o); vv[i] = *(const GAS unsigned*)(V + o); }
    { float s0 = 0.f, s1 = 0.f;
#pragma unroll
      for (int i = 0; i < 8; ++i) { s0 += lf[i].x; s1 += lf[i].y; }
      *(LAS f32x2*)(TOT + tq * 128 + 2 * kp) = (f32x2){s0, s1}; }
    LDS_WAIT(); __builtin_amdgcn_s_barrier(); asm volatile("" ::: "memory");
    for (int c = 0; c < NCHUNK; ++c) {
        const LAS float* TC = TOT + (c & 1) * 1024;
        float off0 = 0.f, off1 = 0.f, ref0 = 0.f, ref1 = 0.f, all0 = 0.f, all1 = 0.f;
#pragma unroll
        for (int t2 = 0; t2 < 8; ++t2) { const f32x2 tt = *(const LAS f32x2*)(TC + t2 * 128 + 2 * kp);
            if (t2 < tq) { off0 += tt.x; off1 += tt.y; } if (t2 < 4) { ref0 += tt.x; ref1 += tt.y; } all0 += tt.x; all1 += tt.y; }
        const bool outp = (c >= 4);
        float k20[8], k21[8];
        { float b0 = off0, b1 = off1; const float ca0 = __expf(all0 - ref0), ca1 = __expf(all1 - ref1);
#pragma unroll
          for (int i = 0; i < 8; ++i) {
            b0 += lf[i].x; b1 += lf[i].y;
            const float kk0 = 1.0f - __expf(lf[i].x), kk1 = 1.0f - __expf(lf[i].y);
            const float ks0 = kk0 * __expf(ref0 - b0), ks1 = kk1 * __expf(ref1 - b1);
            k20[i] = ks0 * ca0; k21[i] = ks1 * ca1;
            if (outp) { const float q0 = bf_lo(qv[i]), q1 = bf_hi(qv[i]); const int t = 8 * tq + i;
                *(LAS unsigned*)(lds + HG_QS + t * 272 + 4 * kp) = cvt_pk_bf16(q0 * __expf(b0 - ref0), q1 * __expf(b1 - ref1));
                *(LAS unsigned*)(lds + HG_KS + t * 272 + 4 * kp) = cvt_pk_bf16(ks0, ks1); }
          } }
        { v4u a, bq; a.x = cvt_pk_bf16(k20[0], k20[1]); a.y = cvt_pk_bf16(k20[2], k20[3]); a.z = cvt_pk_bf16(k20[4], k20[5]); a.w = cvt_pk_bf16(k20[6], k20[7]);
          bq.x = cvt_pk_bf16(k21[0], k21[1]); bq.y = cvt_pk_bf16(k21[2], k21[3]); bq.z = cvt_pk_bf16(k21[4], k21[5]); bq.w = cvt_pk_bf16(k21[6], k21[7]);
          *(LAS v4u*)(lds + HG_K2T + (2 * kp) * 144 + 16 * tq) = a; *(LAS v4u*)(lds + HG_K2T + (2 * kp + 1) * 144 + 16 * tq) = bq;
          v4u lo, hi;
          lo.x = __builtin_amdgcn_perm(vv[1], vv[0], 0x05040100u); lo.y = __builtin_amdgcn_perm(vv[3], vv[2], 0x05040100u); lo.z = __builtin_amdgcn_perm(vv[5], vv[4], 0x05040100u); lo.w = __builtin_amdgcn_perm(vv[7], vv[6], 0x05040100u);
          hi.x = __builtin_amdgcn_perm(vv[1], vv[0], 0x07060302u); hi.y = __builtin_amdgcn_perm(vv[3], vv[2], 0x07060302u); hi.z = __builtin_amdgcn_perm(vv[5], vv[4], 0x07060302u); hi.w = __builtin_amdgcn_perm(vv[7], vv[6], 0x07060302u);
          *(LAS v4u*)(lds + HG_VT + (2 * kp) * 144 + 16 * tq) = lo; *(LAS v4u*)(lds + HG_VT + (2 * kp + 1) * 144 + 16 * tq) = hi; }
        if (tq == 0) { *(LAS f32x2*)(DEC + 2 * kp) = (f32x2){__expf(all0), __expf(all1)}; *(LAS f32x2*)(EREF + 2 * kp) = (f32x2){__expf(ref0), __expf(ref1)}; }
        if (kp == 0) {
#pragma unroll
            for (int i = 0; i < 8; ++i) ROWS[8 * tq + i] = rows[i]; }
        if (c + 1 < NCHUNK) {
#pragma unroll
            for (int i = 0; i < 8; ++i) { rows[i] = hg_row(b, dir, 64 * (c + 1) + 8 * tq + i); const size_t o = (size_t)rows[i] * D_B + colb + 2 * kp;
                lf[i] = pg8::unpk_f16(*(const GAS unsigned*)(LF + o)); qv[i] = *(const GAS unsigned*)(Q + o); vv[i] = *(const GAS unsigned*)(V + o); } }
        LDS_WAIT(); __builtin_amdgcn_s_barrier(); asm volatile("" ::: "memory");
        bf16x8 Vf[2];
#pragma unroll
        for (int ks2 = 0; ks2 < 2; ++ks2) Vf[ks2] = *(const LAS bf16x8*)(lds + HG_VT + (16 * w + r16) * 144 + 64 * ks2 + 16 * q4);
        f32x4 oacc[4]; int orow[4][4];
#pragma unroll
        for (int ti = 0; ti < 4; ++ti) oacc[ti] = (f32x4){0.f, 0.f, 0.f, 0.f};
        if (outp) {
            bf16x8 Af[4], Bf[2][4];
#pragma unroll
            for (int ks = 0; ks < 4; ++ks) Af[ks] = *(const LAS bf16x8*)(lds + HG_KS + (16 * (w >> 1) + r16) * 272 + 64 * ks + 16 * q4);
#pragma unroll
            for (int tsel = 0; tsel < 2; ++tsel) { const int ti = 2 * (w & 1) + tsel;
#pragma unroll
                for (int ks = 0; ks < 4; ++ks) Bf[tsel][ks] = *(const LAS bf16x8*)(lds + HG_QS + (16 * ti + r16) * 272 + 64 * ks + 16 * q4); }
#pragma unroll
            for (int ti = 0; ti < 4; ++ti) { typedef int i32x4 __attribute__((ext_vector_type(4))); const i32x4 rr = *(const LAS i32x4*)(ROWS + 16 * ti + 4 * q4);
                orow[ti][0] = rr.x; orow[ti][1] = rr.y; orow[ti][2] = rr.z; orow[ti][3] = rr.w; }
#pragma unroll
            for (int tsel = 0; tsel < 2; ++tsel) { const int idx = 2 * w + tsel, si = idx >> 2, ti = idx & 3;
                f32x4 dacc = (f32x4){0.f, 0.f, 0.f, 0.f};
#pragma unroll
                for (int ks = 0; ks < 4; ++ks) dacc = __builtin_amdgcn_mfma_f32_16x16x32_bf16(Af[ks], Bf[tsel][ks], dacc, 0, 0, 0);
                const int t = 16 * ti + r16, s0 = 16 * si + 4 * q4;
#pragma unroll
                for (int j = 0; j < 4; ++j) if (s0 + j > t) dacc[j] = 0.f;
                v2u pw; pw.x = cvt_pk_bf16(dacc[0], dacc[1]); pw.y = cvt_pk_bf16(dacc[2], dacc[3]);
                *(LAS v2u*)(lds + HG_P + t * 144 + 2 * s0) = pw; }
            v2u alo[4][4], ahi[4][4]; f32x4 er[8];
#pragma unroll
            for (int kt = 0; kt < 8; ++kt) er[kt] = *(const LAS f32x4*)(EREF + 16 * kt + 4 * q4);
#pragma unroll
            for (int ks = 0; ks < 4; ++ks)
#pragma unroll
                for (int ti = 0; ti < 4; ++ti) { alo[ks][ti] = *(const LAS v2u*)(lds + HG_QS + (16 * ti + r16) * 272 + 64 * ks + 8 * q4);
                    ahi[ks][ti] = *(const LAS v2u*)(lds + HG_QS + (16 * ti + r16) * 272 + 64 * ks + 32 + 8 * q4); }
#pragma unroll
            for (int ks = 0; ks < 4; ++ks) { const f32x4 s0 = S[2 * ks] * er[2 * ks], s1 = S[2 * ks + 1] * er[2 * ks + 1];
                v4u sw; sw.x = cvt_pk_bf16(s0[0], s0[1]); sw.y = cvt_pk_bf16(s0[2], s0[3]); sw.z = cvt_pk_bf16(s1[0], s1[1]); sw.w = cvt_pk_bf16(s1[2], s1[3]);
                const bf16x8 Sf = __builtin_bit_cast(bf16x8, sw);
#pragma unroll
                for (int ti = 0; ti < 4; ++ti) { v4u aw; aw.x = alo[ks][ti].x; aw.y = alo[ks][ti].y; aw.z = ahi[ks][ti].x; aw.w = ahi[ks][ti].y;
                    oacc[ti] = __builtin_amdgcn_mfma_f32_16x16x32_bf16(__builtin_bit_cast(bf16x8, aw), Sf, oacc[ti], 0, 0, 0); } }
        }
        { bf16x8 Kf[8][2]; f32x4 dc[8];
#pragma unroll
          for (int kt = 0; kt < 8; ++kt) { dc[kt] = *(const LAS f32x4*)(DEC + 16 * kt + 4 * q4);
#pragma unroll
              for (int ks2 = 0; ks2 < 2; ++ks2) Kf[kt][ks2] = *(const LAS bf16x8*)(lds + HG_K2T + (16 * kt + r16) * 144 + 64 * ks2 + 16 * q4); }
#pragma unroll
          for (int kt = 0; kt < 8; ++kt) { S[kt] = S[kt] * dc[kt];
#pragma unroll
              for (int ks2 = 0; ks2 < 2; ++ks2) S[kt] = __builtin_amdgcn_mfma_f32_16x16x32_bf16(Kf[kt][ks2], Vf[ks2], S[kt], 0, 0, 0); } }
        if (c + 1 < NCHUNK) { float s0 = 0.f, s1 = 0.f;
#pragma unroll
            for (int i = 0; i < 8; ++i) { s0 += lf[i].x; s1 += lf[i].y; }
            *(LAS f32x2*)(TOT + ((c + 1) & 1) * 1024 + tq * 128 + 2 * kp) = (f32x2){s0, s1}; }
        LDS_WAIT(); __builtin_amdgcn_s_barrier(); asm volatile("" ::: "memory");
        if (outp) {
            bf16x8 Pf[4][2];
#pragma unroll
            for (int ti = 0; ti < 4; ++ti)
#pragma unroll
                for (int ks2 = 0; ks2 < 2; ++ks2) Pf[ti][ks2] = *(const LAS bf16x8*)(lds + HG_P + (16 * ti + r16) * 144 + 64 * ks2 + 16 * q4);
#pragma unroll
            for (int ti = 0; ti < 4; ++ti)
#pragma unroll
                for (int ks2 = 0; ks2 < 2; ++ks2) oacc[ti] = __builtin_amdgcn_mfma_f32_16x16x32_bf16(Pf[ti][ks2], Vf[ks2], oacc[ti], 0, 0, 0);
#pragma unroll
            for (int ti = 0; ti < 4; ++ti)
#pragma unroll
                for (int j = 0; j < 4; ++j) O[(size_t)orow[ti][j] * D_B + colb + 16 * w + r16] = (bf16)(cvt_pk_bf16(oacc[ti][j], 0.f) & 0xffffu);
        }
    }
    LDS_WAIT(); __builtin_amdgcn_s_barrier(); asm volatile("" ::: "memory");
}
__device__ __forceinline__ void hg_finalize_row(int lr, const bf16* OHG, const bf16* OG, const float* gn, bf16* YB, int lane) {
    const int row = (lr >> 11) * RPB + CTX_LEN + (lr & 2047);
    const size_t o = (size_t)row * D_B + 2 * lane;
    unsigned a[16], bq[16], og[16];
#pragma unroll
    for (int h = 0; h < 16; ++h) { a[h] = *(const GAS unsigned*)(OHG + o + h * 128); bq[h] = *(const GAS unsigned*)(OHG + (size_t)RT * D_B + o + h * 128); og[h] = *(const GAS unsigned*)(OG + o + h * 128); }
#pragma unroll
    for (int h = 0; h < 16; ++h) { const float o0 = bf_lo(a[h]) + bf_lo(bq[h]), o1 = bf_hi(a[h]) + bf_hi(bq[h]);
        const float r = 1.0f / sqrtf(wave_sum(o0 * o0 + o1 * o1) * (1.f / 128.f) + EPS);
        const f32x2 g = *(const GAS f32x2*)(gn + h * 128 + 2 * lane);
        *(GAS unsigned*)(YB + (size_t)row * pg8::DY + 2 * lane + h * 128) = cvt_pk_bf16(o0 * r * g.x * silu_f(bf_lo(og[h])), o1 * r * g.y * silu_f(bf_hi(og[h])));
    }
}

constexpr int ITB_WIN = 3 * IT_FF, ITB_GLU = ITB_WIN + IT_WIN, ITB_FF2 = ITB_GLU + IT_GLU + IT_PA + IT_PB + IT_OUT;
constexpr int TAIL2_ITEMS = 30912, TAIL5_ITEMS = 3000;
constexpr int CONV6_ITEMS = 24000;
constexpr int P0_HOLE = ITB_WIN, P0_ITEMS = T_ITEMS - IT_FF - TAIL2_ITEMS - CONV6_ITEMS;
static_assert(ITB_FF2 + 3 * IT_FF == T_ITEMS, "item list");
__device__ __forceinline__ ItemDesc item_desc(const Args& args, unsigned char* ws, int it) {
    int r = it;
    if (r < IT_FF) return make_item(args.in[I_W1A], D_MODEL, D_FF, (bf16*)(ws + WS_W13A), 1, r); r -= IT_FF;
    if (r < IT_FF) return make_item(args.in[I_W3A], D_MODEL, D_FF, (bf16*)(ws + WS_W13A), 2, r); r -= IT_FF;
    if (r < IT_FF) return make_item(args.in[I_W2A], D_FF, D_MODEL, (bf16*)(ws + WS_W2A), 0, r, D_FFP); r -= IT_FF;
    if (r < IT_WIN) return make_item(args.in[I_WIN], D_MODEL, N_IN, (bf16*)(ws + WS_WIN), 3, r); r -= IT_WIN;
    if (r < IT_GLU) return make_item(args.in[I_WGLU], D_A, D_A, (bf16*)(ws + WS_WGLU), 0, r); r -= IT_GLU;
    if (r < IT_PA) return make_item(args.in[I_WPA], D_A, D_MODEL, (bf16*)(ws + WS_WP) + D_B, 0, r, pg8::DY); r -= IT_PA;
    if (r < IT_PB) return make_item(args.in[I_WPB], D_B, D_MODEL, (bf16*)(ws + WS_WP), 0, r, pg8::DY); r -= IT_PB;
    if (r < IT_OUT) return make_item(args.in[I_WOUT], D_MODEL, D_MODEL, (bf16*)(ws + WS_WOUT), 0, r); r -= IT_OUT;
    if (r < IT_FF) return make_item(args.in[I_W1B], D_MODEL, D_FF, (bf16*)(ws + WS_W13B), 1, r); r -= IT_FF;
    if (r < IT_FF) return make_item(args.in[I_W3B], D_MODEL, D_FF, (bf16*)(ws + WS_W13B), 2, r); r -= IT_FF;
    return make_item(args.in[I_W2B], D_FF, D_MODEL, (bf16*)(ws + WS_W2B), 0, r, D_FFP);
}
__device__ __forceinline__ void convert_range(const Args& args, unsigned char* ws, int first, int end, int step, LAS float* s, int lane, int hole_at = 0x7fffffff, int hole_len = 0) {
    if (first >= end) return;
    ItemDesc d0 = item_desc(args, ws, first < hole_at ? first : first + hole_len), d1 = d0; f32x4 va[8], vb[8]; item_load(d0, va, lane);
    if (first + step < end) { const int n1 = first + step; d1 = item_desc(args, ws, n1 < hole_at ? n1 : n1 + hole_len); item_load(d1, vb, lane); }
    else {
#pragma unroll
        for (int i = 0; i < 8; ++i) vb[i] = va[i]; }
    for (int it = first; it < end; it += step) {
        const int n2 = it + 2 * step; ItemDesc d2 = d1; f32x4 vc[8];
        if (n2 < end) { d2 = item_desc(args, ws, n2 < hole_at ? n2 : n2 + hole_len); item_load(d2, vc, lane); }
        else {
#pragma unroll
            for (int i = 0; i < 8; ++i) vc[i] = vb[i]; }
        item_store(d0, va, s, lane);
        d0 = d1; d1 = d2;
#pragma unroll
        for (int i = 0; i < 8; ++i) { va[i] = vb[i]; vb[i] = vc[i]; }
    }
}
__device__ __forceinline__ void tail_convert(const Args& args, unsigned char* ws, int begin, int end, int first_block, int G, int bx, int wave, LAS float* s) {
    int tl = threadIdx.x; asm volatile("" : "+v"(tl));
    if (first_block >= G) { convert_range(args, ws, begin + bx * NWAVES + wave, end, G * NWAVES, s, tl & 63); return; }
    if (bx < first_block) return;
    convert_range(args, ws, begin + (bx - first_block) * NWAVES + wave, end, (G - first_block) * NWAVES, s, tl & 63);
}

__global__ void __launch_bounds__(NWAVES * 64, 2) fwd_kernel(Args args) {
    extern __shared__ __attribute__((aligned(16))) unsigned char lds_raw[];
    LAS unsigned char* lds = (LAS unsigned char*)lds_raw;
    volatile LAS unsigned* MISC = (volatile LAS unsigned*)(lds + MISC_OFF);
    const int tid = threadIdx.x, wave = __builtin_amdgcn_readfirstlane(tid >> 6);
#define PHASE_LANE() int tidp = threadIdx.x; asm volatile("" : "+v"(tidp)); const int lane = tidp & 63; (void)lane
    const int G = gridDim.x, bx = blockIdx.x;
    const int vcu = (G % 8 == 0) ? (bx % 8) * (G / 8) + bx / 8 : bx;
    const int gw = vcu * NWAVES + wave, NGW = G * NWAVES;
    unsigned char* ws = args.ws;
    gu32* ctl = (gu32*)(ws + WS_CTL);
    for (int u = tid; u < (LDS_BYTES - LDSCTL_OFF) / 4; u += NWAVES * 64) ((LAS unsigned*)(lds + LDSCTL_OFF))[u] = 0u;
    __syncthreads();
    XcdBarrier bar = xcd_barrier_post((unsigned*)(ctl + CW_BAR), MISC + 8);
    LAS unsigned char* scr = lds + RING_OFF + wave * 16384;

    float* MODP = (float*)(ws + WS_MODP); float* MOD = (float*)(ws + WS_MOD); float* TAB = (float*)(ws + WS_TAB); float* LBT = (float*)(ws + WS_TAB + 512 * 1024);
    bf16* W13A = (bf16*)(ws + WS_W13A); bf16* W2A = (bf16*)(ws + WS_W2A); bf16* WIN = (bf16*)(ws + WS_WIN); bf16* WGLU = (bf16*)(ws + WS_WGLU); bf16* WPA = (bf16*)(ws + WS_WPA);
    bf16* WPB = (bf16*)(ws + WS_WPB); bf16* WOUT = (bf16*)(ws + WS_WOUT); bf16* W13B = (bf16*)(ws + WS_W13B); bf16* W2B = (bf16*)(ws + WS_W2B);
    bf16* ZN = (bf16*)(ws + WS_ZN); bf16* HID = (bf16*)(ws + WS_HID); pg8::h16_t* HB = (pg8::h16_t*)(ws + WS_H); pg8::h16_t* UA = (pg8::h16_t*)(ws + WS_UA);
    bf16* QB_ = (bf16*)(ws + WS_Q); bf16* VB_ = (bf16*)(ws + WS_V); bf16* OGB = (bf16*)(ws + WS_OG); pg8::h16_t* LFF = (pg8::h16_t*)(ws + WS_LFF); pg8::h16_t* LFB = (pg8::h16_t*)(ws + WS_LFB);
    bf16* SGA = (bf16*)(ws + WS_SGA); bf16* SGB = (bf16*)(ws + WS_SGB); float* XEND = (float*)(ws + WS_XEND); bf16* GA = (bf16*)(ws + WS_GA); bf16* YY = (bf16*)(ws + WS_Y); bf16* WP = (bf16*)(ws + WS_WP);
    bf16* OHG = (bf16*)(ws + WS_OHG); float* PT = (float*)(ws + WS_PT); bf16* MRG = (bf16*)(ws + WS_MRG);

    {
        PHASE_LANE();
        for (int idx = bx * (NWAVES * 64) + tidp; idx < 8192 + 4096; idx += G * NWAVES * 64) {
            if (idx < 8192) s5_table_entry(args.in[I_LAMRE], args.in[I_LAMIM], args.in[I_LOGDT], TAB, idx);
            else { const int j = idx - 8192, d = j >> 11, cc = j & 2047; const float l0 = args.in[I_LBLOG][(d * 2 + 0) * D_B + cc], l1 = args.in[I_LBLOG][(d * 2 + 1) * D_B + cc]; LBT[j] = 1.0f / (1.0f + expf(l1 - l0)); }
        }
        if (NGW > ADA_TASKS) {
            int per = (P0_ITEMS + ADA_TASKS * 64 + NGW - 1) / NGW; if (per < 64) per = 64;
            const int a = per - 64, s1 = (a * NGW < P0_ITEMS) ? a * NGW : P0_ITEMS;
            convert_range(args, ws, gw, s1, NGW, (LAS float*)scr, lane, P0_HOLE, TAIL2_ITEMS);
            if (gw < ADA_TASKS) p0_ada_task(args.in[I_C], args.in[I_CCTX], args.in[I_WADA], MODP, gw, (LAS float*)scr, lane);
            else convert_range(args, ws, s1 + (gw - ADA_TASKS), P0_ITEMS, NGW - ADA_TASKS, (LAS float*)scr, lane, P0_HOLE, TAIL2_ITEMS);
        } else {
            for (int t = gw; t < ADA_TASKS; t += NGW) p0_ada_task(args.in[I_C], args.in[I_CCTX], args.in[I_WADA], MODP, t, (LAS float*)scr, lane);
            convert_range(args, ws, gw, P0_ITEMS, NGW, (LAS float*)scr, lane, P0_HOLE, TAIL2_ITEMS);
        }
    }
    xcd_barrier(bar);
    { PHASE_LANE();
    for (int idx = bx * (NWAVES * 64) + tidp; idx < 5 * NMODC_; idx += G * NWAVES * 64) {
        float s = args.in[I_BADA][idx % NMODC_];
#pragma unroll
        for (int k = 0; k < ADA_KS; ++k) s += MODP[(size_t)k * 5 * NMODC_ + idx];
        MOD[idx] = s;
    } }
    xcd_barrier(bar);
    { PHASE_LANE();
    for (int m = gw; m < RT; m += NGW) { const int b = m / RPB, t = m - b * RPB; const bool isctx = t < CTX_LEN;
        const float* src = isctx ? args.in[I_CTX] + ((size_t)b * CTX_LEN + t) * D_MODEL : args.in[I_X] + ((size_t)b * SEQ + (t - CTX_LEN)) * D_MODEL;
        const float* mv = MOD + (size_t)(isctx ? 4 : b) * NMODC_;
        norm_mod_row(src, args.in[I_NORM1], mv + 0 * D_MODEL, mv + 1 * D_MODEL, ZN + (size_t)m * D_MODEL, lane); } }
    xcd_barrier(bar);
    { pg8::Gemm g{ZN, W13A, RT, 2 * D_FF, D_MODEL}; pg8::TileOrder S; S.init(36, 86, G, bx, 0); pg8::EpiSwiGLU E{HID, D_FFP};
      pg8::gemm_phase<pg8::EpiSwiGLU, pg8::TileOrder, true, true>(lds + RING_OFF, g, S, E); }
    tail_convert(args, ws, ITB_WIN, ITB_WIN + TAIL2_ITEMS, (36 * 86) % 256, G, bx, wave, (LAS float*)scr);
    xcd_barrier(bar);
    { pg8::Gemm g{HID, W2A, RT, D_MODEL, D_FF, D_FFP}; pg8::DownSplitOrder S; S.init(G, bx); pg8::EpiDown1 E{{args.in[I_X], args.in[I_CTX], HB, nullptr, MOD, 2, 0.5f}, (pg8::h16_t*)PT};
      pg8::gemm_phase<pg8::EpiDown1, pg8::DownSplitOrder, true, true>(lds + RING_OFF, g, S, E); }
    xcd_barrier(bar);
    { PHASE_LANE();
    for (int m = gw; m < RT; m += NGW) { const int b = m / RPB, t = m - b * RPB; const bool isctx = t < CTX_LEN;
        const float* mv = MOD + (size_t)(isctx ? 4 : b) * NMODC_;
        int ln = lane; asm volatile("" : "+v"(ln));
        if (isctx) norm_mod_row_part(args.in[I_CTX] + ((size_t)b * CTX_LEN + t) * D_MODEL, (const pg8::h16_t*)PT + ((size_t)b * CTX_LEN + t) * D_MODEL, mv + 2 * D_MODEL, args.in[I_NORMMIX], mv + 3 * D_MODEL, mv + 4 * D_MODEL, ZN + (size_t)m * D_MODEL, ln);
        else norm_mod_row_h(HB + (size_t)m * D_MODEL, args.in[I_NORMMIX], mv + 3 * D_MODEL, mv + 4 * D_MODEL, ZN + (size_t)m * D_MODEL, ln);
    } }
    xcd_barrier(bar);
    { pg8::Gemm g{ZN, WIN, RT, N_IN, D_MODEL}; pg8::TileOrder2 S; S.init(28, 48, G, bx); pg8::EpiWin E{UA, QB_, LFF, SGA, LBT};
      pg8::gemm_phase<pg8::EpiWin, pg8::TileOrder2, true, true>(lds + RING_OFF, g, S, E); }
    tail_convert(args, ws, T_ITEMS - IT_FF, T_ITEMS - IT_FF + TAIL5_ITEMS, (36 * 28 + 32 * 48) % 256, G, bx, wave, (LAS float*)scr);
    xcd_barrier(bar);
    { PHASE_LANE();
      constexpr int NTA = BATCH * 2 * S5_G * NCHUNK, NTC = BATCH * S5_G * 32;
      const bool hgblk = (G > 128) && (bx < 128);
      const unsigned nprod = (G > 128) ? (unsigned)(G - 128) : (unsigned)G;
      for (int u = bx; u < 128; u += G) hgrn2_unit(lds + RING_OFF, u, QB_, VB_, LFF, LFB, OHG, tidp);
      if (!hgblk) {
          for (;;) {
              int base = 0; if (lane == 0) base = (int)__hip_atomic_fetch_add((unsigned*)(ctl + CW_QUEUE), 4u, RLX_AGENT);
              base = __builtin_amdgcn_readfirstlane(base);
              if (base >= NTA) break;
#pragma unroll 1
              for (int t = base; t < base + 4; ++t) s5_pass_a(scr, t, TAB, args.in[I_BRE], args.in[I_BIM], UA, XEND, lane);
          }
          asm volatile("s_waitcnt vmcnt(0)" ::: "memory");
          __syncthreads();
          if (tidp == 0) (void)__hip_atomic_fetch_add((unsigned*)(ctl + CW_DONE), 1u, RLX_AGENT);
      }
      if (tidp == 0) { unsigned sp = 0;
          while (__hip_atomic_load((unsigned*)(ctl + CW_DONE), RLX_AGENT) < nprod) { __builtin_amdgcn_s_sleep(8);
              if ((++sp & 255u) == 0u) { if (xb_ld((unsigned*)(ctl + CW_BAR) + XB_TMO)) break; if (sp > (1u << 20)) { atomicAdd((unsigned*)(ctl + CW_BAR) + XB_TMO, 1u); break; } } }
          __builtin_amdgcn_fence(__ATOMIC_ACQUIRE, "agent");
          asm volatile("s_waitcnt vmcnt(0)" ::: "memory"); }
      __syncthreads();
      for (;;) {
          int base = 0; if (lane == 0) base = (int)__hip_atomic_fetch_add((unsigned*)(ctl + CW_QUEUE2), 2u, RLX_AGENT);
          base = __builtin_amdgcn_readfirstlane(base);
          if (base >= NTC) break;
#pragma unroll 1
          for (int t = base; t < base + 2; ++t) s5_pass_c(scr, t, TAB, args.in[I_BRE], args.in[I_BIM], args.in[I_CRE], args.in[I_CIM], args.in[I_S5D], UA, XEND, GA, lane);
      }
      for (;;) {
          int base = 0; if (lane == 0) base = (int)__hip_atomic_fetch_add((unsigned*)(ctl + CW_QUEUE3), 8u, RLX_AGENT);
          base = __builtin_amdgcn_readfirstlane(base);
          if (base >= CONV6_ITEMS) break;
          const int i0 = T_ITEMS - IT_FF - CONV6_ITEMS + base;
          convert_range(args, ws, i0, i0 + 8, 1, (LAS float*)scr, lane);
      }
    }
    xcd_barrier(bar);
    const bool glu_split = (G == 256);
    if (glu_split && bx < 128) {
      pg8::Gemm g{GA, WGLU, RT, D_A, D_A}; pg8::TileOrder S; S.init(32, 4, 128, bx, 1); pg8::EpiGlu E{GA, YY + D_B};
      pg8::gemm_phase<pg8::EpiGlu, pg8::TileOrder, true, true>(lds + RING_OFF, g, S, E);
    } else { PHASE_LANE();
    const int gw7 = glu_split ? (bx - 128) * NWAVES + wave : gw, ngw7 = glu_split ? NGW - 128 * NWAVES : NGW;
    for (int t = gw7; t < BATCH * SEQ; t += ngw7) hg_finalize_row(t, OHG, OGB, args.in[I_HGNORM], YY, lane);
    }
    xcd_barrier(bar);
    if (!glu_split) { pg8::Gemm g{GA, WGLU, RT, D_A, D_A}; pg8::TileOrder S; S.init(32, 4, G, bx, 1); pg8::EpiGlu E{GA, YY + D_B};
      pg8::gemm_phase<pg8::EpiGlu, pg8::TileOrder, true, true>(lds + RING_OFF, g, S, E); xcd_barrier(bar); }
    { pg8::Gemm g{YY, WP, RT, D_MODEL, D_B + D_A}; pg8::TileOrder S; S.init(32, 16, G, bx, 1); pg8::EpiMerge E{SGA, SGB, MRG};
      pg8::gemm_phase<pg8::EpiMerge, pg8::TileOrder, true, true>(lds + RING_OFF, g, S, E); }
    xcd_barrier(bar);
    { pg8::Gemm g{MRG, WOUT, RT, D_MODEL, D_MODEL}; pg8::TileOrder S; S.init(32, 16, G, bx, 1); pg8::EpiResid<1, 0> E{nullptr, nullptr, HB, nullptr, MOD, 5, 1.0f};
      pg8::gemm_phase<pg8::EpiResid<1, 0>, pg8::TileOrder, true, true>(lds + RING_OFF, g, S, E); }
    xcd_barrier(bar);
    { PHASE_LANE();
    for (int lr = gw; lr < BATCH * SEQ; lr += NGW) { const int b = lr >> 11, m = b * RPB + CTX_LEN + (lr & 2047);
        const float* mv = MOD + (size_t)b * NMODC_;
        norm_mod_row_h(HB + (size_t)m * D_MODEL, args.in[I_NORM2], mv + 6 * D_MODEL, mv + 7 * D_MODEL, ZN + (size_t)m * D_MODEL, lane); } }
    xcd_barrier(bar);
    { pg8::Gemm g{ZN, W13B, RT, 2 * D_FF, D_MODEL}; pg8::TileOrder S; S.init(32, 86, G, bx, 1); pg8::EpiSwiGLU E{HID, D_FFP};
      pg8::gemm_phase<pg8::EpiSwiGLU, pg8::TileOrder, true, true>(lds + RING_OFF, g, S, E); }
    tail_convert(args, ws, T_ITEMS - IT_FF + TAIL5_ITEMS, T_ITEMS, (32 * 86) % 256, G, bx, wave, (LAS float*)scr);
    xcd_barrier(bar);
    { pg8::Gemm g{HID, W2B, RT, D_MODEL, D_FF, D_FFP}; pg8::HalfRowsOrder S; S.init(G, bx); pg8::EpiResid<1, 0> E{nullptr, nullptr, HB, nullptr, MOD, 8, 0.5f};
      pg8::gemm_phase<pg8::EpiResid<1, 0>, pg8::HalfRowsOrder, true, true>(lds + RING_OFF, g, S, E); }
    xcd_barrier(bar);
    { PHASE_LANE();
    const bool tmo_set = __hip_atomic_load((unsigned*)(ctl + CW_BAR) + XB_TMO, RLX_AGENT) != 0u;
    for (int lr = gw; lr < BATCH * SEQ; lr += NGW) { norm_final_row_h(HB + ((size_t)(lr >> 11) * RPB + CTX_LEN + (lr & 2047)) * D_MODEL, args.out + (size_t)lr * D_MODEL, args.in[I_NORMF], lane);
        if (tmo_set) { GAS f32x4* xr = (GAS f32x4*)(args.out + (size_t)lr * D_MODEL) + lane;
#pragma unroll
            for (int j = 0; j < 16; ++j) xr[64 * j] = (f32x4){1e30f, 1e30f, 1e30f, 1e30f}; } } }
}

extern "C" void kernel_launch(void* const* d_in, const int* in_sizes, int n_in, void* d_out, int out_size, void* d_ws, size_t ws_size, hipStream_t stream) {
    static int grid = 0;
    if (grid == 0) {
        if (n_in != 31 || out_size != BATCH * SEQ * D_MODEL || ws_size < WS_END) { fprintf(stderr, "kernel_launch: unexpected shapes (n_in %d, out %d, ws %zu)\n", n_in, out_size, ws_size); grid = -1; return; }
        int dev = 0, cus = 0, per_cu = 0;
        if (hipGetDevice(&dev) != hipSuccess || hipDeviceGetAttribute(&cus, hipDeviceAttributeMultiprocessorCount, dev) != hipSuccess) { grid = -1; return; }
        if (hipFuncSetAttribute((const void*)fwd_kernel, hipFuncAttributeMaxDynamicSharedMemorySize, LDS_BYTES) != hipSuccess) { fprintf(stderr, "kernel_launch: hipFuncSetAttribute failed\n"); grid = -1; return; }
        if (hipOccupancyMaxActiveBlocksPerMultiprocessor(&per_cu, (const void*)fwd_kernel, NWAVES * 64, LDS_BYTES) != hipSuccess || per_cu < 1)
            fprintf(stderr, "kernel_launch: note: occupancy query reports %d workgroups per CU\n", per_cu);
        (void)hipGetLastError();
        grid = cus;
    }
    if (grid < 0) return;
    if (hipMemsetAsync((char*)d_ws + WS_CTL, 0, CTL_ZERO_BYTES, stream) != hipSuccess) { fprintf(stderr, "kernel_launch: memset failed\n"); return; }
    Args a{};
    for (int i = 0; i < 31; ++i) a.in[i] = (const float*)d_in[i];
    a.out = (float*)d_out; a.ws = (unsigned char*)d_ws;
    hipLaunchKernelGGL(fwd_kernel, dim3(grid), dim3(NWAVES * 64), LDS_BYTES, stream, a);
    const hipError_t le = hipPeekAtLastError();
    if (le != hipSuccess) fprintf(stderr, "kernel_launch: launch failed: %s\n", hipGetErrorName(le));
}
```
